# Optimizing an MI355X kernel written in HIP

```python
import math
import jax, jax.numpy as jnp
from jax import lax
import numpy as np

D_MODEL = 1024
BATCH = 4
SEQ = 4096
DEPTH = 4

MIX_WIDTH = D_MODEL
DA_WIDTH = MIX_WIDTH // 2
SC_WIDTH = MIX_WIDTH // 4
LRU_WIDTH = MIX_WIDTH - DA_WIDTH - SC_WIDTH

DA_HEAD_DIM = 64
DA_HEADS = DA_WIDTH // (2 * DA_HEAD_DIM)
Q_BLOCK = 128
NUM_BUCKETS = 32
MAX_DISTANCE = 128
SUBLN_EPS = 1e-5

SC_KERNEL = 3

LRU_BLOCKS = 4
LRU_BLOCK = LRU_WIDTH // LRU_BLOCKS
LRU_CONV = 4
LRU_C = 8.0

D_FF = 2816
RMS_EPS = 1e-6
NEG_INF = -1e30

IN_SPLIT_WIDTHS = (DA_WIDTH, DA_WIDTH, DA_WIDTH,
                   SC_WIDTH, SC_WIDTH, SC_WIDTH,
                   LRU_WIDTH, LRU_WIDTH)
IN_WIDTH = sum(IN_SPLIT_WIDTHS)
IN_SPLIT_POINTS = tuple(int(v) for v in np.cumsum(IN_SPLIT_WIDTHS)[:-1])

kernel_name = "hymba_diffattn_shortconv_rglru_macaron"


def rms_norm(x, g, eps=RMS_EPS):
    xf = x.astype(jnp.float32)
    y = xf * lax.rsqrt(jnp.mean(xf * xf, axis=-1, keepdims=True) + eps)
    return (y * g.astype(jnp.float32)).astype(x.dtype)


def swiglu(x, w_gate, w_up, w_down):
    return (jax.nn.silu(x @ w_gate) * (x @ w_up)) @ w_down


def causal_dwconv(x, w):
    K = w.shape[0]
    S = x.shape[1]
    xp = jnp.pad(x, ((0, 0), (K - 1, 0), (0, 0)))
    return sum(xp[:, k:k + S] * w[k] for k in range(K))


def t5_bucket(n):
    max_exact = NUM_BUCKETS // 2
    nf = jnp.maximum(n, 1).astype(jnp.float32)
    large = max_exact + (jnp.log(nf / max_exact) / math.log(MAX_DISTANCE / max_exact)
                         * (NUM_BUCKETS - max_exact)).astype(jnp.int32)
    large = jnp.minimum(large, NUM_BUCKETS - 1)
    return jnp.where(n < max_exact, n, large)


def diff_attention(q, k, v, lq1, lk1, lq2, lk2, subln_g, rel_bias, lam_init):
    B, S, _ = q.shape
    nblk = S // Q_BLOCK
    q = q.reshape(B, S, DA_HEADS, 2, DA_HEAD_DIM) * (DA_HEAD_DIM ** -0.5)
    k = k.reshape(B, S, DA_HEADS, 2, DA_HEAD_DIM)
    v = v.reshape(B, S, DA_HEADS, 2 * DA_HEAD_DIM)
    f32 = jnp.float32
    lam = (jnp.exp(jnp.sum(lq1.astype(f32) * lk1.astype(f32)))
           - jnp.exp(jnp.sum(lq2.astype(f32) * lk2.astype(f32))) + lam_init)
    k_pos = jnp.arange(S)
    q_blocks = jnp.moveaxis(q.reshape(B, nblk, Q_BLOCK, DA_HEADS, 2, DA_HEAD_DIM), 1, 0)

    def block(args):
        qb, start = args
        q_pos = start + jnp.arange(Q_BLOCK)
        dist = q_pos[:, None] - k_pos[None, :]
        bias = rel_bias[t5_bucket(jnp.maximum(dist, 0))]
        bias = bias.reshape(Q_BLOCK, S, DA_HEADS, 2).transpose(2, 3, 0, 1).astype(f32)
        logits = jnp.einsum('bqhmd,bkhmd->bhmqk', qb, k).astype(f32) + bias
        logits = jnp.where(dist >= 0, logits, NEG_INF)
        p = jax.nn.softmax(logits, axis=-1)
        attn = p[:, :, 0] - lam * p[:, :, 1]
        return jnp.einsum('bhqk,bkhe->bqhe', attn.astype(v.dtype), v)

    starts = jnp.arange(nblk) * Q_BLOCK
    o = lax.map(block, (q_blocks, starts))
    o = jnp.moveaxis(o, 0, 1).reshape(B, S, DA_HEADS, 2 * DA_HEAD_DIM)
    o = rms_norm(o, subln_g, SUBLN_EPS) * (1.0 - lam_init)
    return o.reshape(B, S, DA_WIDTH)


def block_diag_linear(x, w, b):
    B, S, _ = x.shape
    xb = x.reshape(B, S, LRU_BLOCKS, LRU_BLOCK)
    y = jnp.einsum('bsni,nij->bsnj', xb, w) + b
    return y.reshape(B, S, LRU_WIDTH)


def rg_lru(x, wa, ba, wx, bx, lam):
    f32 = jnp.float32
    r = jax.nn.sigmoid(block_diag_linear(x, wa, ba)).astype(f32)
    i = jax.nn.sigmoid(block_diag_linear(x, wx, bx)).astype(f32)
    log_a = -LRU_C * r * jax.nn.softplus(-lam.astype(f32))
    a = jnp.exp(log_a)
    mult = jnp.sqrt(-jnp.expm1(2.0 * log_a))
    b = mult * (i * x.astype(f32))

    def combine(e, l):
        return (e[0] * l[0], l[0] * e[1] + l[1])

    _, h = lax.associative_scan(combine, (a, b), axis=1)
    return h.astype(x.dtype)


def setup_inputs(seed: int = 0) -> dict:
    key = jax.random.key(seed)
    ks = iter(jax.random.split(key, 40))
    f32 = jnp.float32

    def nrm(shape, fan_in):
        return jax.random.normal(next(ks), shape, f32) * fan_in ** -0.5

    def gain(shape):
        return 1.0 + 0.02 * jax.random.normal(next(ks), shape, f32)

    def small(shape, s):
        return s * jax.random.normal(next(ks), shape, f32)

    u = jax.random.uniform(next(ks), (DEPTH, LRU_WIDTH), f32, minval=0.9, maxval=0.999)
    a0 = u ** (1.0 / LRU_C)
    lru_lambda = jnp.log(a0) - jnp.log1p(-a0)

    return {
        "x": jax.random.normal(next(ks), (BATCH, SEQ, D_MODEL), f32),
        "rel_bias": small((NUM_BUCKETS, 2 * DA_HEADS), 0.5),
        "ffn1_norm": gain((DEPTH, D_MODEL)),
        "ffn1_gate": nrm((DEPTH, D_MODEL, D_FF), D_MODEL),
        "ffn1_up": nrm((DEPTH, D_MODEL, D_FF), D_MODEL),
        "ffn1_down": nrm((DEPTH, D_FF, D_MODEL), D_FF),
        "mix_norm": gain((DEPTH, D_MODEL)),
        "w_in": nrm((DEPTH, D_MODEL, IN_WIDTH), D_MODEL),
        "w_out": nrm((DEPTH, MIX_WIDTH, D_MODEL), MIX_WIDTH),
        "lam_q1": small((DEPTH, DA_HEAD_DIM), 0.1),
        "lam_k1": small((DEPTH, DA_HEAD_DIM), 0.1),
        "lam_q2": small((DEPTH, DA_HEAD_DIM), 0.1),
        "lam_k2": small((DEPTH, DA_HEAD_DIM), 0.1),
        "subln_gain": gain((DEPTH, 2 * DA_HEAD_DIM)),
        "sc_conv_w": nrm((DEPTH, SC_KERNEL, SC_WIDTH), SC_KERNEL),
        "lru_conv_w": nrm((DEPTH, LRU_CONV, LRU_WIDTH), LRU_CONV),
        "lru_conv_b": small((DEPTH, LRU_WIDTH), 0.01),
        "lru_wa": nrm((DEPTH, LRU_BLOCKS, LRU_BLOCK, LRU_BLOCK), LRU_BLOCK),
        "lru_ba": small((DEPTH, LRU_BLOCKS, LRU_BLOCK), 0.01),
        "lru_wx": nrm((DEPTH, LRU_BLOCKS, LRU_BLOCK, LRU_BLOCK), LRU_BLOCK),
        "lru_bx": small((DEPTH, LRU_BLOCKS, LRU_BLOCK), 0.01),
        "lru_lambda": lru_lambda,
        "ffn2_norm": gain((DEPTH, D_MODEL)),
        "ffn2_gate": nrm((DEPTH, D_MODEL, D_FF), D_MODEL),
        "ffn2_up": nrm((DEPTH, D_MODEL, D_FF), D_MODEL),
        "ffn2_down": nrm((DEPTH, D_FF, D_MODEL), D_FF),
        "final_norm": gain((D_MODEL,)),
    }


def reference(x, rel_bias, ffn1_norm, ffn1_gate, ffn1_up, ffn1_down, mix_norm, w_in, w_out,
              lam_q1, lam_k1, lam_q2, lam_k2, subln_gain, sc_conv_w, lru_conv_w, lru_conv_b,
              lru_wa, lru_ba, lru_wx, lru_bx, lru_lambda, ffn2_norm, ffn2_gate, ffn2_up,
              ffn2_down, final_norm):
    for l in range(DEPTH):
        h = x + 0.5 * swiglu(rms_norm(x, ffn1_norm[l]), ffn1_gate[l], ffn1_up[l], ffn1_down[l])

        u = rms_norm(h, mix_norm[l])
        z = u @ w_in[l]
        q, k, v, sc_b, sc_c, sc_x, lru_x, lru_g = jnp.split(z, IN_SPLIT_POINTS, axis=-1)

        lam_init = 0.8 - 0.6 * math.exp(-0.3 * l)
        y_da = diff_attention(q, k, v, lam_q1[l], lam_k1[l], lam_q2[l], lam_k2[l],
                              subln_gain[l], rel_bias, lam_init)
        y_sc = sc_b * causal_dwconv(sc_c * sc_x, sc_conv_w[l])
        xr = causal_dwconv(lru_x, lru_conv_w[l]) + lru_conv_b[l]
        y_lru = jax.nn.gelu(lru_g) * rg_lru(xr, lru_wa[l], lru_ba[l], lru_wx[l], lru_bx[l],
                                            lru_lambda[l])

        h = h + jnp.concatenate([y_da, y_sc, y_lru], axis=-1) @ w_out[l]

        x = h + 0.5 * swiglu(rms_norm(h, ffn2_norm[l]), ffn2_gate[l], ffn2_up[l], ffn2_down[l])
    return rms_norm(x, final_norm)
```

```cpp
#include <hip/hip_runtime.h>
#include <hip/hip_cooperative_groups.h>
#include <cstdio>
#include <cstdint>
#include <cmath>
namespace cg = cooperative_groups;
#ifndef PG8_WGM
#define PG8_WGM 8
#endif
__device__ __forceinline__ float shx(float v, int m) { int ln; asm volatile("v_mbcnt_lo_u32_b32 %0, -1, 0\n\tv_mbcnt_hi_u32_b32 %0, -1, %0" : "=v"(ln)); return __builtin_bit_cast(float, __builtin_amdgcn_ds_bpermute((ln ^ m) << 2, __builtin_bit_cast(int, v))); }
namespace pg8 {
#define PG8_LAS __attribute__((address_space(3)))
typedef unsigned short bf16_t;
typedef short bf16x8 __attribute__((ext_vector_type(8)));
typedef float f32x4 __attribute__((ext_vector_type(4)));
typedef unsigned u32x4 __attribute__((ext_vector_type(4)));
constexpr int BM = 256, BK = 64, HALF = 128, HTB = HALF * BK * 2  , STAGE_BYTES = 8 * HTB, NXCD = 8, WGM = PG8_WGM;

__host__ __device__ __forceinline__ int lds_byte(int r, int c) { const int st = (r >> 4) * 2 + (c >> 5), rr = r & 15, cc = c & 31, ob = rr * 64 + cc * 2; return st * 1024 + (ob ^ (((ob >> 9) & 1) << 5)); }
__host__ __device__ __forceinline__ void stage_rc(int b, int& R, int& C) { const int st = b / 1024, sb = b % 1024, swz = sb ^ (((sb >> 9) & 1) << 5); R = (st >> 1) * 16 + swz / 64; C = (st & 1) * 32 + (swz % 64) / 2; }
__host__ __device__ __forceinline__ int perm32(int rho) { const int n = rho >> 4, i = rho & 15; return 8 * (i >> 2) + 4 * n + (i & 3); }

struct Unit { int pm, pn; };
struct Gemm { const bf16_t* A; const bf16_t* Bt; int M, N, K; };

struct StaticOrder {
    int nM, nN, nwg, G, c;
    __host__ __device__ void init(int M, int N, int G_, int c_) { nM = M / BM; nN = N / BM; nwg = nM * nN; G = G_; c = c_; }
    __host__ __device__ bool next(int i, Unit& u) const {
        const long L = (long)i * G + c; if (L >= nwg) return false;
        int wgid = (int)L; { const int q = nwg / NXCD, r = nwg % NXCD, xcd = wgid % NXCD, off = wgid / NXCD; wgid = (xcd < r ? xcd * (q + 1) : r * (q + 1) + (xcd - r) * q) + off; }
        const int nig = WGM * nN, gid = wgid / nig, fm = gid * WGM, gsz = (nM - fm) < WGM ? (nM - fm) : WGM;
        u.pm = fm + ((wgid % nig) % gsz); u.pn = (wgid % nig) / gsz; return true;
    }
    __device__ __forceinline__ void a_ready(const Unit&) const {}
    __device__ __forceinline__ void done(const Unit&) const {}
};

__device__ __forceinline__ unsigned cvt_pk_bf16(float lo, float hi) { unsigned r; asm volatile("v_cvt_pk_bf16_f32 %0, %1, %2" : "=v"(r) : "v"(lo), "v"(hi)); return r; }
typedef float f32x2 __attribute__((ext_vector_type(2)));
typedef unsigned u32x2 __attribute__((ext_vector_type(2)));
#define PG8_ST16_WT(w, rs, off) __builtin_amdgcn_raw_buffer_store_b128((w), (rs), (unsigned)(off), 0, 16)
#define PG8_RSRC(p, bytes) __builtin_amdgcn_make_buffer_rsrc((void*)(p), 0, (int)(bytes), 0x00020000)
__device__ __forceinline__ float row_rstd(const float* ss, int row) {
    const f32x4 s4 = *(const f32x4*)(ss + (size_t)row * 4);
    return __builtin_amdgcn_rsqf(((s4[0] + s4[1]) + (s4[2] + s4[3])) * (1.0f / 1024.0f) + 1e-6f);
}
__device__ __forceinline__ float silu_mul(float g, float u) {
    const float e = __builtin_amdgcn_exp2f(-g * 1.4426950408889634f);
    return g * __builtin_amdgcn_rcpf(1.0f + e) * u;
}
struct EpiSwiglu {
    static constexpr bool PERM = true, AFTER_DRAIN = false, ROWTAB = true;
    struct Pre { int unused; };
    bf16_t* O; int ldc; const float* ss;
    __device__ __forceinline__ void operator()(const f32x4 (&acc)[2][2][4][2], const Unit& u, int wr, int wc, int fr, int fq, const PG8_LAS float* tab) const {
        { int ln_; asm volatile("v_mbcnt_lo_u32_b32 %0, -1, 0\n\tv_mbcnt_hi_u32_b32 %0, -1, %0" : "=v"(ln_)); fr = ln_ & 15; fq = ln_ >> 4; }
        const int row0 = u.pm * BM + wr * 64 + fr; const int col0 = u.pn * 128 + wc * 32 + 8 * fq;
#pragma unroll
        for (int ai = 0; ai < 2; ++ai)
#pragma unroll
            for (int m = 0; m < 4; ++m) {
                const int row = row0 + ai * HALF + m * 16; const f32x4 s4 = *(const PG8_LAS f32x4*)(tab + (ai * HALF + wr * 64 + m * 16 + fr) * 4); const float rs = __builtin_amdgcn_rsqf(((s4[0] + s4[1]) + (s4[2] + s4[3])) * (1.0f / 1024.0f) + 1e-6f);
                const f32x4 g0 = acc[ai][0][m][0] * rs, g1 = acc[ai][0][m][1] * rs, u0 = acc[ai][1][m][0] * rs, u1 = acc[ai][1][m][1] * rs;
                u32x4 w;
                w.x = cvt_pk_bf16(silu_mul(g0[0], u0[0]), silu_mul(g0[1], u0[1])); w.y = cvt_pk_bf16(silu_mul(g0[2], u0[2]), silu_mul(g0[3], u0[3]));
                w.z = cvt_pk_bf16(silu_mul(g1[0], u1[0]), silu_mul(g1[1], u1[1])); w.w = cvt_pk_bf16(silu_mul(g1[2], u1[2]), silu_mul(g1[3], u1[3]));
                PG8_ST16_WT(w, PG8_RSRC(O, 16384u * 2816u * 2u), ((unsigned)row * (unsigned)ldc + (unsigned)col0) * 2u);
            }
    }
};
struct EpiZ {
    static constexpr bool PERM = true, AFTER_DRAIN = false, ROWTAB = true;
    struct Pre { int unused; };
    bf16_t* O; int ldc; const float* ss; float qscale;
    __device__ __forceinline__ void operator()(const f32x4 (&acc)[2][2][4][2], const Unit& u, int wr, int wc, int fr, int fq, const PG8_LAS float* tab) const {
        { int ln_; asm volatile("v_mbcnt_lo_u32_b32 %0, -1, 0\n\tv_mbcnt_hi_u32_b32 %0, -1, %0" : "=v"(ln_)); fr = ln_ & 15; fq = ln_ >> 4; }
        const int row0 = u.pm * BM + wr * 64 + fr; const int col0 = u.pn * BM + wc * 32 + 8 * fq;
        const float sc = (u.pn < 2) ? qscale : 1.0f;
#pragma unroll
        for (int ai = 0; ai < 2; ++ai)
#pragma unroll
            for (int m = 0; m < 4; ++m) {
                const int row = row0 + ai * HALF + m * 16; const f32x4 s4 = *(const PG8_LAS f32x4*)(tab + (ai * HALF + wr * 64 + m * 16 + fr) * 4); const float rs = __builtin_amdgcn_rsqf(((s4[0] + s4[1]) + (s4[2] + s4[3])) * (1.0f / 1024.0f) + 1e-6f) * sc;
#pragma unroll
                for (int bj = 0; bj < 2; ++bj) {
                    const f32x4 v0 = acc[ai][bj][m][0] * rs, v1 = acc[ai][bj][m][1] * rs;
                    u32x4 w; w.x = cvt_pk_bf16(v0[0], v0[1]); w.y = cvt_pk_bf16(v0[2], v0[3]); w.z = cvt_pk_bf16(v1[0], v1[1]); w.w = cvt_pk_bf16(v1[2], v1[3]);
                    PG8_ST16_WT(w, PG8_RSRC(O, 16384u * 2816u * 2u), ((unsigned)row * (unsigned)ldc + (unsigned)(col0 + bj * HALF)) * 2u);
                }
            }
    }
};
struct EpiRes {
    static constexpr bool PERM = false, AFTER_DRAIN = true, ROWTAB = false;
    const float* base; float* out; bf16_t* xb; float* ss; float alpha;
    struct Pre { int unused; };
    __device__ __forceinline__ void prefetch(Pre&, const Unit&, int, int, int, int) const {}
    __device__ __forceinline__ void fused(f32x4 (&acc)[2][2][4][2], const Unit& u, int wr, int wc, int fr, int fq, PG8_LAS unsigned char* lds, int wid, int lane, const Pre&) const {
        PG8_LAS float* P = (PG8_LAS float*)lds;
        const int col0 = u.pn * BM + wc * 32 + 4 * fq;
#pragma unroll
        for (int ai = 0; ai < 2; ++ai)
#pragma unroll
            for (int m = 0; m < 4; ++m) {
                const int r = ai * HALF + wr * 64 + m * 16 + fr; const size_t off = (size_t)(u.pm * BM + r) * 1024 + col0; float s = 0.f;
                f32x4 bb[2][2];
#pragma unroll
                for (int bj = 0; bj < 2; ++bj)
#pragma unroll
                    for (int n = 0; n < 2; ++n) bb[bj][n] = *(const f32x4*)(base + off + bj * HALF + n * 16);
#pragma unroll
                for (int bj = 0; bj < 2; ++bj)
#pragma unroll
                    for (int n = 0; n < 2; ++n) {
                        const f32x4 o = bb[bj][n] + acc[ai][bj][m][n] * alpha;
                        *(f32x4*)(out + off + bj * HALF + n * 16) = o;
                        u32x2 w; w.x = cvt_pk_bf16(o[0], o[1]); w.y = cvt_pk_bf16(o[2], o[3]);
                        *(u32x2*)(xb + off + bj * HALF + n * 16) = w;
                        s += (o[0] * o[0] + o[1] * o[1]) + (o[2] * o[2] + o[3] * o[3]);
                    }
                s += shx(s, 16); s += shx(s, 32);
                if (fq == 0) P[r * 4 + wc] = s;
            }
        asm volatile("s_waitcnt lgkmcnt(0)" ::: "memory"); __builtin_amdgcn_s_barrier(); asm volatile("" ::: "memory");
        const int tid = wid * 64 + lane;
        if (tid < 256) {
            const f32x4 p = *(const PG8_LAS f32x4*)(P + tid * 4);
            const float t = (p[0] + p[1]) + (p[2] + p[3]);
            __hip_atomic_store((unsigned*)ss + ((size_t)(u.pm * BM + tid) * 4 + u.pn), __float_as_uint(t), __ATOMIC_RELAXED, __HIP_MEMORY_SCOPE_AGENT);
        }
        asm volatile("s_waitcnt lgkmcnt(0)" ::: "memory"); __builtin_amdgcn_s_barrier(); asm volatile("" ::: "memory");
    }
};
struct EpiRes16 {
    static constexpr bool PERM = true, AFTER_DRAIN = true, ROWTAB = false;
    bf16_t* xb; float* ss; float alpha;
    struct Pre { u32x4 bb[2][4][2]; };
    __device__ __forceinline__ void prefetch(Pre& p, const Unit& u, int wr, int wc, int fr, int fq) const {
        const int col0 = u.pn * BM + wc * 32 + 8 * fq;
#pragma unroll
        for (int ai = 0; ai < 2; ++ai)
#pragma unroll
            for (int m = 0; m < 4; ++m)
#pragma unroll
                for (int bj = 0; bj < 2; ++bj) p.bb[ai][m][bj] = *(const u32x4*)(xb + (size_t)(u.pm * BM + ai * HALF + wr * 64 + m * 16 + fr) * 1024 + col0 + bj * HALF);
    }
    __device__ __forceinline__ void fused(f32x4 (&acc)[2][2][4][2], const Unit& u, int wr, int wc, int fr, int fq, PG8_LAS unsigned char* lds, int wid, int lane, const Pre& p) const {
        PG8_LAS float* P = (PG8_LAS float*)lds;
        const int col0 = u.pn * BM + wc * 32 + 8 * fq;
#pragma unroll
        for (int ai = 0; ai < 2; ++ai)
#pragma unroll
            for (int m = 0; m < 4; ++m) {
                const int r = ai * HALF + wr * 64 + m * 16 + fr; float s = 0.f;
#pragma unroll
                for (int bj = 0; bj < 2; ++bj) {
                    const f32x4 a0 = acc[ai][bj][m][0] * alpha, a1 = acc[ai][bj][m][1] * alpha; const u32x4 b = p.bb[ai][m][bj];
                    float o[8];
                    o[0] = __uint_as_float(b.x << 16) + a0[0]; o[1] = __uint_as_float(b.x & 0xffff0000u) + a0[1]; o[2] = __uint_as_float(b.y << 16) + a0[2]; o[3] = __uint_as_float(b.y & 0xffff0000u) + a0[3];
                    o[4] = __uint_as_float(b.z << 16) + a1[0]; o[5] = __uint_as_float(b.z & 0xffff0000u) + a1[1]; o[6] = __uint_as_float(b.w << 16) + a1[2]; o[7] = __uint_as_float(b.w & 0xffff0000u) + a1[3];
                    u32x4 w; w.x = cvt_pk_bf16(o[0], o[1]); w.y = cvt_pk_bf16(o[2], o[3]); w.z = cvt_pk_bf16(o[4], o[5]); w.w = cvt_pk_bf16(o[6], o[7]);
                    PG8_ST16_WT(w, PG8_RSRC(xb, 16384u * 1024u * 2u), ((unsigned)(u.pm * BM + r) * 1024u + (unsigned)(col0 + bj * HALF)) * 2u);
#pragma unroll
                    for (int e = 0; e < 8; ++e) s += o[e] * o[e];
                }
                s += shx(s, 16); s += shx(s, 32);
                if (fq == 0) P[r * 4 + wc] = s;
            }
        asm volatile("s_waitcnt lgkmcnt(0)" ::: "memory"); __builtin_amdgcn_s_barrier(); asm volatile("" ::: "memory");
        const int tid = wid * 64 + lane;
        if (tid < 256) {
            const f32x4 p = *(const PG8_LAS f32x4*)(P + tid * 4);
            const float t = (p[0] + p[1]) + (p[2] + p[3]);
            __hip_atomic_store((unsigned*)ss + ((size_t)(u.pm * BM + tid) * 4 + u.pn), __float_as_uint(t), __ATOMIC_RELAXED, __HIP_MEMORY_SCOPE_AGENT);
        }
        asm volatile("s_waitcnt lgkmcnt(0)" ::: "memory"); __builtin_amdgcn_s_barrier(); asm volatile("" ::: "memory");
    }
};
template <class Epi, class Sched, bool ALIGN_EPI = false, bool SP2 = false>
__device__ __forceinline__ void gemm_phase(PG8_LAS unsigned char* lds, const Gemm g, const Sched& S, const Epi& E) {
    int tid_ = threadIdx.x; asm volatile("" : "+v"(tid_));
    const int tid = tid_, wid = __builtin_amdgcn_readfirstlane(tid >> 6), lane = tid & 63, wr = wid >> 2, wc = wid & 3, fr = lane & 15, fq = lane >> 4;
    const int K = g.K, nt = K / BK;
    unsigned voffA[2], voffB[2];
#pragma unroll
    for (int i = 0; i < 2; ++i) { int R, C; stage_rc(tid * 16 + i * 8192, R, C); const int Rb = Epi::PERM ? ((R & ~31) + perm32(R & 31)) : R;
        voffA[i] = (unsigned)(R * K + C) * 2u; voffB[i] = (unsigned)(Rb * K + C) * 2u; }
    const size_t kstep = (size_t)(BK * 2);
    const size_t hstep = (size_t)HALF * K * 2;
    const size_t tstep = 2 * hstep;
    const unsigned ldsw = (unsigned)wid * 1024u;
    const int aoff = lds_byte(wr * 64 + fr, fq * 8), boff = lds_byte(wc * 32 + fr, fq * 8);
#define PG8_SA(b, h) (((b) * 2 + (h)) * HTB)
#define PG8_SB(b, h) ((4 + (b) * 2 + (h)) * HTB)
#define PG8_STAGE(bufoff, gbase, voff) do { _Pragma("unroll") for (int _i = 0; _i < 2; ++_i) \
        __builtin_amdgcn_global_load_lds((const unsigned*)((const char*)(gbase) + (voff)[_i]), (PG8_LAS unsigned*)(lds + (bufoff) + ldsw + _i * 8192), 16, 0, 0); } while (0)
#define PG8_LDA(dst, b, h) do { _Pragma("unroll") for (int m = 0; m < 4; ++m) _Pragma("unroll") for (int k = 0; k < 2; ++k) dst[m][k] = *(const PG8_LAS bf16x8*)(lds + PG8_SA(b, h) + aoff + m * 2048 + k * 1024); } while (0)
#define PG8_LDB(dst, b, h) do { _Pragma("unroll") for (int n = 0; n < 2; ++n) _Pragma("unroll") for (int k = 0; k < 2; ++k) dst[n][k] = *(const PG8_LAS bf16x8*)(lds + PG8_SB(b, h) + boff + n * 2048 + k * 1024); } while (0)
#define PG8_MMA(ai, bj, At, Bt) do { __builtin_amdgcn_s_setprio(1); _Pragma("unroll") for (int m = 0; m < 4; ++m) _Pragma("unroll") for (int n = 0; n < 2; ++n) _Pragma("unroll") for (int k = 0; k < 2; ++k) \
        acc[ai][bj][m][n] = __builtin_amdgcn_mfma_f32_16x16x32_bf16(Bt[n][k], At[m][k], acc[ai][bj][m][n], 0, 0, 0); __builtin_amdgcn_s_setprio(0); } while (0)
#define PG8_WAIT_V(n) asm volatile("s_waitcnt vmcnt(" #n ")" ::: "memory")
#define PG8_WAIT_L(n) asm volatile("s_waitcnt lgkmcnt(" #n ")" ::: "memory")
#define PG8_BAR __builtin_amdgcn_s_barrier()
#define PG8_SCHED __builtin_amdgcn_sched_barrier(0)
    Unit cur, nxt; int ui = 0;
    if (!S.next(0, cur)) return;
    f32x4 acc[2][2][4][2];
#pragma unroll
    for (int a = 0; a < 2; ++a)
#pragma unroll
        for (int b = 0; b < 2; ++b)
#pragma unroll
            for (int m = 0; m < 4; ++m)
#pragma unroll
                for (int n = 0; n < 2; ++n) acc[a][b][m][n] = (f32x4){0.f, 0.f, 0.f, 0.f};
    bf16x8 At[4][2], B0[2][2], B1[2][2];
    const char* cA = (const char*)g.A + (size_t)cur.pm * tstep; const char* cB = (const char*)g.Bt + (size_t)cur.pn * tstep;
    S.a_ready(cur);
    if constexpr (SP2) {
        PG8_STAGE(PG8_SB(0, 0), cB, voffB); PG8_STAGE(PG8_SB(0, 1), cB + hstep, voffB); PG8_STAGE(PG8_SA(0, 0), cA, voffA); PG8_STAGE(PG8_SA(0, 1), cA + hstep, voffA);
        if (wr == 1) PG8_BAR;
        PG8_WAIT_V(2); PG8_BAR;
        PG8_STAGE(PG8_SB(1, 0), cB + kstep, voffB); PG8_STAGE(PG8_SA(1, 0), cA + kstep, voffA); PG8_STAGE(PG8_SB(1, 1), cB + hstep + kstep, voffB);
        PG8_WAIT_V(6); PG8_BAR;
    } else {
        PG8_STAGE(PG8_SB(0, 0), cB, voffB); PG8_STAGE(PG8_SA(0, 0), cA, voffA); PG8_STAGE(PG8_SB(0, 1), cB + hstep, voffB); PG8_STAGE(PG8_SA(0, 1), cA + hstep, voffA);
        if (wr == 1) PG8_BAR;
        PG8_WAIT_V(4); PG8_BAR;
        PG8_STAGE(PG8_SB(1, 0), cB + kstep, voffB); PG8_STAGE(PG8_SA(1, 0), cA + kstep, voffA); PG8_STAGE(PG8_SB(1, 1), cB + hstep + kstep, voffB);
        PG8_WAIT_V(6); PG8_BAR;
    }
    for (;;) {
        const bool has_next = S.next(ui + 1, nxt);
        const char* nA = has_next ? (const char*)g.A + (size_t)nxt.pm * tstep : cA; const char* nB = has_next ? (const char*)g.Bt + (size_t)nxt.pn * tstep : cB;
        for (int t = 0; t < nt; t += 2) {
            const bool last = (t == nt - 2);

            const char* a1 = cA + (size_t)(t + 1) * kstep;
            const char* a2 = last ? nA : cA + (size_t)(t + 2) * kstep; const char* b2 = last ? nB : cB + (size_t)(t + 2) * kstep;
            const char* a3 = a2 + kstep; const char* b3 = b2 + kstep;
            if (last && has_next) S.a_ready(nxt);
            if constexpr (SP2) {
            PG8_LDB(B0, 0, 0); PG8_LDB(B1, 0, 1); PG8_SCHED; PG8_LDA(At, 0, 0); PG8_STAGE(PG8_SA(1, 1), a1 + hstep, voffA);
            PG8_WAIT_V(8); PG8_WAIT_L(0); PG8_BAR; PG8_MMA(0, 0, At, B0); PG8_MMA(0, 1, At, B1); PG8_BAR; PG8_SCHED;
            PG8_LDA(At, 0, 1); PG8_STAGE(PG8_SB(0, 0), b2, voffB); PG8_STAGE(PG8_SB(0, 1), b2 + hstep, voffB); PG8_STAGE(PG8_SA(0, 0), a2, voffA);
            PG8_WAIT_V(8); PG8_WAIT_L(0); PG8_BAR; PG8_MMA(1, 0, At, B0); PG8_MMA(1, 1, At, B1); PG8_BAR; PG8_SCHED;
            PG8_LDB(B0, 1, 0); PG8_LDB(B1, 1, 1); PG8_SCHED; PG8_LDA(At, 1, 0); PG8_STAGE(PG8_SA(0, 1), a2 + hstep, voffA);
            PG8_WAIT_V(8); PG8_WAIT_L(0); PG8_BAR; PG8_MMA(0, 0, At, B0); PG8_MMA(0, 1, At, B1); PG8_BAR; PG8_SCHED;
            PG8_LDA(At, 1, 1); PG8_STAGE(PG8_SB(1, 0), b3, voffB); PG8_STAGE(PG8_SB(1, 1), b3 + hstep, voffB); PG8_STAGE(PG8_SA(1, 0), a3, voffA);
            PG8_WAIT_V(8); PG8_WAIT_L(0); PG8_BAR; PG8_MMA(1, 0, At, B0); PG8_MMA(1, 1, At, B1); PG8_BAR; PG8_SCHED;
            } else {
            PG8_LDB(B0, 0, 0); PG8_SCHED; PG8_LDA(At, 0, 0); PG8_STAGE(PG8_SA(1, 1), a1 + hstep, voffA);
            PG8_WAIT_L(8); PG8_BAR; PG8_WAIT_L(0); PG8_MMA(0, 0, At, B0); PG8_BAR; PG8_SCHED;
            PG8_LDB(B1, 0, 1); PG8_STAGE(PG8_SB(0, 0), b2, voffB);
            PG8_BAR; PG8_WAIT_L(0); PG8_MMA(0, 1, At, B1); PG8_BAR;
            PG8_LDA(At, 0, 1); PG8_STAGE(PG8_SA(0, 0), a2, voffA);
            PG8_BAR; PG8_WAIT_L(0); PG8_MMA(1, 0, At, B0); PG8_BAR; PG8_SCHED;
            PG8_STAGE(PG8_SB(0, 1), b2 + hstep, voffB);
            PG8_WAIT_V(6); PG8_BAR; PG8_MMA(1, 1, At, B1); PG8_BAR;
            PG8_LDB(B0, 1, 0); PG8_SCHED; PG8_LDA(At, 1, 0); PG8_STAGE(PG8_SA(0, 1), a2 + hstep, voffA);
            PG8_WAIT_L(8); PG8_BAR; PG8_WAIT_L(0); PG8_MMA(0, 0, At, B0); PG8_BAR; PG8_SCHED;
            PG8_LDB(B1, 1, 1); PG8_STAGE(PG8_SB(1, 0), b3, voffB);
            PG8_BAR; PG8_WAIT_L(0); PG8_MMA(0, 1, At, B1); PG8_BAR;
            PG8_LDA(At, 1, 1); PG8_STAGE(PG8_SA(1, 0), a3, voffA);
            PG8_BAR; PG8_WAIT_L(0); PG8_MMA(1, 0, At, B0); PG8_BAR; PG8_SCHED;
            PG8_STAGE(PG8_SB(1, 1), b3 + hstep, voffB);
            PG8_WAIT_V(6); PG8_BAR; PG8_MMA(1, 1, At, B1); PG8_BAR;
            }
            if constexpr (Epi::ROWTAB) { if (t == 0 && wid < 4) {
                int ln_; asm volatile("v_mbcnt_lo_u32_b32 %0, -1, 0\n\tv_mbcnt_hi_u32_b32 %0, -1, %0" : "=v"(ln_)); const unsigned voff = (unsigned)(ln_ + wid * 64) * 16u; const char* sb = (const char*)E.ss + (size_t)cur.pm * 4096;
                const unsigned ldst = (unsigned)__builtin_amdgcn_readfirstlane((int)(unsigned)(size_t)(lds + STAGE_BYTES) + wid * 1024); unsigned keep;
                asm volatile("s_mov_b32 %0, m0\n\ts_mov_b32 m0, %3\n\ts_nop 0\n\tglobal_load_lds_dwordx4 %1, %2\n\ts_mov_b32 m0, %0" : "=&s"(keep) : "v"(voff), "s"(sb), "s"(ldst) : "memory"); } }
        }
        if constexpr (ALIGN_EPI) { if (wr == 0) PG8_BAR; }
        if constexpr (!Epi::AFTER_DRAIN) { if constexpr (Epi::ROWTAB) E(acc, cur, wr, wc, fr, fq, (const PG8_LAS float*)(lds + STAGE_BYTES)); else E(acc, cur, wr, wc, fr, fq); S.done(cur); }
        if (!has_next) break;
#pragma unroll
        for (int a = 0; a < 2; ++a)
#pragma unroll
            for (int b = 0; b < 2; ++b)
#pragma unroll
                for (int m = 0; m < 4; ++m)
#pragma unroll
                    for (int n = 0; n < 2; ++n) acc[a][b][m][n] = (f32x4){0.f, 0.f, 0.f, 0.f};
        cur = nxt; cA = nA; cB = nB; ++ui;
        if constexpr (ALIGN_EPI) { if (wr == 1) PG8_BAR; }
    }
    typename Epi::Pre epre;
    if constexpr (Epi::AFTER_DRAIN) E.prefetch(epre, cur, wr, wc, fr, fq);
    PG8_WAIT_V(0);
    if constexpr (!ALIGN_EPI) { if (wr == 0) PG8_BAR; }
    PG8_BAR;
    if constexpr (Epi::AFTER_DRAIN) { E.fused(acc, cur, wr, wc, fr, fq, lds, wid, lane, epre); S.done(cur); }
#undef PG8_SA
#undef PG8_SB
#undef PG8_STAGE
#undef PG8_LDA
#undef PG8_LDB
#undef PG8_MMA
#undef PG8_WAIT_V
#undef PG8_WAIT_L
#undef PG8_BAR
#undef PG8_SCHED
}
}
#include <hip/hip_bf16.h>
#include <cmath>
namespace attn_body {
using bf16=__hip_bfloat16;
using bf16x8=__attribute__((ext_vector_type(8)))short;
using s16x4=__attribute__((ext_vector_type(4)))short;
using f32x16=__attribute__((ext_vector_type(16)))float;
using u32x4=__attribute__((ext_vector_type(4)))unsigned;
constexpr int BATCH=4,NHEAD=16,SEQ=4096,D=64,DM=2816,OP=1024;
constexpr int NW=8,QBLK=32,QB=QBLK*NW,KVBLK=64,NQB=SEQ/QB;
constexpr int ATTN_PITCH=DM, ATTN_UNIT_ROWS=QB;
__device__ __forceinline__ int crow(int r,int hi){return (r&3)+8*(r>>2)+4*hi;}
#define SBAR() __builtin_amdgcn_sched_barrier(0)
typedef __attribute__((address_space(3))) const float* lds_cfptr;
__device__ __forceinline__ void cmask(f32x16&p0,f32x16&p1,int jb,int qrel,int hi,lds_cfptr bt){
  const float NEG=-INFINITY; const int d00=qrel-(64*jb+4*hi);
  #pragma unroll
  for(int r=0;r<16;++r){const int d0=d00-((r&3)+8*(r>>2)), d1=d0-32;
    p0[r]+=bt[d0<0?0:d0]; p1[r]+=bt[d1<0?0:d1]; if(d0<0)p0[r]=NEG; if(d1<0)p1[r]=NEG;
    if((r&3)==3)__builtin_amdgcn_sched_barrier(0);}
}

constexpr int NSLOT=3, SLOTB=8192;
constexpr int LDS_K=0, LDS_V=NSLOT*SLOTB, LDS_WS=2*NSLOT*SLOTB, LDS_OST=LDS_WS+NW*64*4, LDS_BT=LDS_OST+NW*4096, LDS_BYTES=LDS_BT+1536;
constexpr float C2=0.125f*1.4426950408889634f;
__device__ __forceinline__ void glds16(const void*gsrc,unsigned lds_dst){unsigned keep;
  asm volatile("s_mov_b32 %0, m0\n\ts_mov_b32 m0, %2\n\ts_nop 0\n\tglobal_load_lds_dwordx4 %1, off\n\ts_mov_b32 m0, %0":"=&s"(keep):"v"(gsrc),"s"(lds_dst):"memory");}
__device__ __forceinline__ float max3f(float a,float b,float c){float r;asm("v_max3_f32 %0, %1, %2, %3":"=v"(r):"v"(a),"v"(b),"v"(c));return r;}
__device__ __forceinline__ float max2f(float a,float b){float r;asm("v_max_f32_e32 %0, %1, %2":"=v"(r):"v"(a),"v"(b));return r;}
__device__ __forceinline__ float fadd_s(float a,float b){float r;asm("v_add_f32_e32 %0, %1, %2":"=v"(r):"v"(a),"v"(b));return r;}
__device__ __forceinline__ float fsub_s(float a,float b){float r;asm("v_sub_f32_e32 %0, %1, %2":"=v"(r):"v"(a),"v"(b));return r;}
typedef float f32x2_t __attribute__((ext_vector_type(2))); typedef __bf16 bf16x2_t __attribute__((ext_vector_type(2)));
__device__ __forceinline__ unsigned cvtpk_s(float lo,float hi){f32x2_t v={lo,hi};bf16x2_t b=__builtin_convertvector(v,bf16x2_t);return __builtin_bit_cast(unsigned,b);}
#define WAIT_BAR(N) asm volatile("s_waitcnt vmcnt(" #N ") lgkmcnt(0)\n\ts_barrier":::"memory")

__device__ __forceinline__ void qkt(f32x16&p0,f32x16&p1,const char*Kslot,const bf16x8*qr,const f32x16&negm,int r32,int hi){
  const char*kb=Kslot+hi*1024+r32*16;
  #pragma unroll
  for(int d0=0;d0<4;++d0){
    const bf16x8 b0=*reinterpret_cast<const bf16x8*>(kb+d0*2048);
    const bf16x8 b1=*reinterpret_cast<const bf16x8*>(kb+d0*2048+512);
    if(d0==0){p0=__builtin_amdgcn_mfma_f32_32x32x16_bf16(b0,qr[0],negm,0,0,0);p1=__builtin_amdgcn_mfma_f32_32x32x16_bf16(b1,qr[0],negm,0,0,0);}
    else{p0=__builtin_amdgcn_mfma_f32_32x32x16_bf16(b0,qr[d0],p0,0,0,0);p1=__builtin_amdgcn_mfma_f32_32x32x16_bf16(b1,qr[d0],p1,0,0,0);}}
}
typedef __attribute__((address_space(3))) const char* lds_cptr;
typedef short v4i16_t __attribute__((ext_vector_type(4)));
__device__ __forceinline__ void kload8(bf16x8*kf,lds_cptr kp){
  kf[0]=*(const __attribute__((address_space(3))) bf16x8*)(kp);      kf[1]=*(const __attribute__((address_space(3))) bf16x8*)(kp+512);
  kf[2]=*(const __attribute__((address_space(3))) bf16x8*)(kp+2048); kf[3]=*(const __attribute__((address_space(3))) bf16x8*)(kp+2560);
  kf[4]=*(const __attribute__((address_space(3))) bf16x8*)(kp+4096); kf[5]=*(const __attribute__((address_space(3))) bf16x8*)(kp+4608);
  kf[6]=*(const __attribute__((address_space(3))) bf16x8*)(kp+6144); kf[7]=*(const __attribute__((address_space(3))) bf16x8*)(kp+6656);
}
__device__ __forceinline__ void kload2(bf16x8*kf,lds_cptr kp,int j){ kf[2*j]=*(const __attribute__((address_space(3))) bf16x8*)(kp+j*2048); kf[2*j+1]=*(const __attribute__((address_space(3))) bf16x8*)(kp+j*2048+512); }
__device__ __forceinline__ s16x4 vtr(lds_cptr p){ return __builtin_bit_cast(s16x4,__builtin_amdgcn_ds_read_tr16_b64_v4i16((__attribute__((address_space(3))) v4i16_t*)p)); }
__device__ __forceinline__ float rowmax(const f32x16&p0,const f32x16&p1){
  float a=max3f(p0[0],p0[1],p1[0]),b=max3f(p0[2],p0[3],p1[1]);a=max3f(a,p1[2],p1[3]);
  #pragma unroll
  for(int r=4;r<16;r+=4){a=max3f(a,p0[r],p0[r+1]);b=max3f(b,p0[r+2],p0[r+3]);a=max3f(a,p1[r],p1[r+1]);b=max3f(b,p1[r+2],p1[r+3]);}
  const float m=max2f(a,b);
  auto rr=__builtin_amdgcn_permlane32_swap(__float_as_uint(m),__float_as_uint(m),false,false);
  return max2f(__uint_as_float(rr[0]),__uint_as_float(rr[1]));
}
__device__ __forceinline__ void pv(f32x16*o,int vb,bf16x8 pa0,bf16x8 pa1,bf16x8 pa2,bf16x8 pa3){
  #pragma unroll
  for(int d0=0;d0<2;++d0){s16x4 lo[4],hi[4];
    #pragma unroll
    for(int ks=0;ks<4;++ks){
      asm volatile("ds_read_b64_tr_b16 %0,%1 offset:%c2":"=&v"(lo[ks]):"v"(vb),"i"(d0*4096+ks*1024):"memory");
      asm volatile("ds_read_b64_tr_b16 %0,%1 offset:%c2":"=&v"(hi[ks]):"v"(vb),"i"(d0*4096+ks*1024+512):"memory");}
    asm volatile("s_waitcnt lgkmcnt(0)":::"memory");SBAR();
    #define PK(k) (bf16x8){lo[k][0],lo[k][1],lo[k][2],lo[k][3],hi[k][0],hi[k][1],hi[k][2],hi[k][3]}
    o[d0]=__builtin_amdgcn_mfma_f32_32x32x16_bf16(pa0,PK(0),o[d0],0,0,0);
    o[d0]=__builtin_amdgcn_mfma_f32_32x32x16_bf16(pa1,PK(1),o[d0],0,0,0);
    o[d0]=__builtin_amdgcn_mfma_f32_32x32x16_bf16(pa2,PK(2),o[d0],0,0,0);
    o[d0]=__builtin_amdgcn_mfma_f32_32x32x16_bf16(pa3,PK(3),o[d0],0,0,0);
    #undef PK
  }
}

#ifndef ATTN_STORE16
#define ATTN_STORE16(p,v) (*(u32x4*)(p)=(v))
#endif
template<int THRL> __device__ __forceinline__ void attn_unit(int b,int g,int qb,const bf16*__restrict__ Zb,bf16*O,const float*__restrict__ btab,char*shm){
  int tid_=threadIdx.x; asm volatile("":"+v"(tid_)); const int tid=tid_,lane=tid&63,r32=lane&31,hi=lane>>5; const int wid=__builtin_amdgcn_readfirstlane(tid>>6);
  const long rowbase=(long)b*SEQ; const int q0=qb*QB;
  const int hm=g>>1;
  const float btv=(tid<384)?btab[hm*384+tid]:0.f;
  const bf16*Qw=Zb+(rowbase+q0+wid*QBLK)*DM+hm*D;
  const bf16*Kh=Zb+rowbase*DM+512+hm*D,*Vh=Zb+rowbase*DM+1024+(g>>2)*128+(g&1)*64;
  const unsigned lds0=(unsigned)(uintptr_t)shm;
  float*wsf=(float*)(shm+LDS_WS)+wid*64;
  const bf16*ksrc=Kh+(long)lane*DM+wid*8;
  const bf16*vsrc=Vh+(long)(16*(wid&3)+(lane>>2))*DM+(wid>>2)*32+(lane&3)*8;
  const unsigned kdst=lds0+LDS_K+wid*1024, vdst=lds0+LDS_V+wid*1024;
  #define DMA_K(t,slot) glds16(ksrc+(long)(t)*KVBLK*DM,(unsigned)__builtin_amdgcn_readfirstlane(kdst+(slot)))
  #define DMA_V(t,slot) glds16(vsrc+(long)(t)*KVBLK*DM,(unsigned)__builtin_amdgcn_readfirstlane(vdst+(slot)))
  const int vb0=(int)(lds0+LDS_V)+((lane>>4)&1)*32+(lane&3)*8+(4*hi+((lane&15)>>2))*64;
  const char*Kbase=shm+LDS_K; bf16x8 kf[8];
  const lds_cptr shm3=(lds_cptr)shm; const lds_cptr kp0=shm3+LDS_K+hi*1024+r32*16; const lds_cptr vp0=shm3+LDS_V+((lane>>4)&1)*32+(lane&3)*8+(4*hi+((lane&15)>>2))*64;
  const int NT=(q0+QB)/KVBLK;
  DMA_K(0,0);DMA_V(0,0);DMA_K(1,SLOTB);
  bf16x8 qr[4];
  #pragma unroll
  for(int d0=0;d0<4;++d0)qr[d0]=*reinterpret_cast<const bf16x8*>(&Qw[(long)r32*DM+d0*16+hi*8]);
  const lds_cfptr btl=(lds_cfptr)((lds_cptr)shm+LDS_BT); if(tid<384)((__attribute__((address_space(3))) float*)((__attribute__((address_space(3))) char*)shm+LDS_BT))[tid]=btv;
  float mhat=0.f,l_reg=0.f;f32x16 o[2];o[0]=f32x16{};o[1]=f32x16{};f32x16 negm=f32x16{};asm volatile("":"+v"(negm));
  const int qrel=wid*QBLK+r32;
  #define CMASK(P0,P1,t) do{int jb_=(t)-(NT-4); if(jb_>=-2)cmask(P0,P1,jb_,qrel,hi,btl);}while(0)
  bool resc=false;
  #define START(P0,P1) do{ const float rm=rowmax(P0,P1); resc=false; \
    { const float dl=rm; mhat=fadd_s(mhat,dl); \
      _Pragma("unroll") for(int r=0;r<16;++r){P0[r]=fsub_s(P0[r],dl);P1[r]=fsub_s(P1[r],dl);} \
      _Pragma("unroll") for(int r=0;r<16;++r)negm[r]=-mhat; asm volatile("":"+v"(negm)); } \
    _Pragma("unroll") for(int r=0;r<16;++r)P0[r]=__builtin_amdgcn_exp2f(P0[r]); }while(0)
  #define RESC() do{ if(resc){ asm volatile("s_waitcnt lgkmcnt(0)":::"memory"); \
      _Pragma("unroll") for(int d_=0;d_<2;++d_) _Pragma("unroll") for(int r=0;r<16;++r)o[d_][r]*=wsf[crow(r,hi)]; } }while(0)
  f32x16 pA0,pA1,pB0,pB1;
  int sl_prev=0,sl_cur=0,sl_next=SLOTB;
  #define ROT() do{sl_prev=sl_cur;sl_cur=sl_next;sl_next=(sl_next==(NSLOT-1)*SLOTB)?0:sl_next+SLOTB;}while(0)
  DMA_K(2,2*SLOTB);
  WAIT_BAR(3);
  qkt(pA0,pA1,Kbase,qr,negm,r32,hi);asm volatile("s_nop 15\n\ts_nop 7":"+v"(pA0),"+v"(pA1));CMASK(pA0,pA1,0);
  START(pA0,pA1);
  _Pragma("unroll") for(int r=0;r<16;++r)pA1[r]=__builtin_amdgcn_exp2f(pA1[r]);
  WAIT_BAR(0);
  DMA_K(3,0);DMA_V(1,SLOTB);
  ROT();
  kload8(kf,kp0+sl_cur);
  WAIT_BAR(2);
  s16x4 vlo[8],vhi[8]; u32x4 pw0,pw1,pw2,pw3;
  #define PKW(P,B) cvtpk_s(P[B],P[B+1])
  #define PAF(k) __builtin_bit_cast(bf16x8,pw##k)
  #define VFR(i) (bf16x8){vlo[i][0],vlo[i][1],vlo[i][2],vlo[i][3],vhi[i][0],vhi[i][1],vhi[i][2],vhi[i][3]}
  #define PIN(x) asm volatile("":"+v"(x))
  #define MX3(a,b,c) __builtin_fmaxf(__builtin_fmaxf((a),(b)),(c))
  #define GAPA(MF,A0,A1,A2,A3,W0,W1,PW) do{ MF; sacc+=A0; sacc+=A1; sacc+=A2; sacc+=A3; PIN(sacc); W0; W1; PIN(PW); SBAR(); }while(0)
  #define EX(v) __builtin_amdgcn_exp2f(v)
  #define GAPB(MF,X,B) do{ MF; X[B]=EX(X[B]); X[B+1]=EX(X[B+1]); X[B+2]=EX(X[B+2]); X[B+3]=EX(X[B+3]); PIN(X); SBAR(); }while(0)
  #define VRD(i) do{ vlo[i]=vtr(vp_+(((i)>>2)*4096+((i)&3)*1024)); vhi[i]=vtr(vp_+(((i)>>2)*4096+((i)&3)*1024+512)); }while(0)
  #define KRD(G,j) do{ if(G){ kload2(kf,kp0+sl_next,j); SBAR(); } }while(0)
  #define STEP(C0,C1,P0,P1,t,GK,GV,GL) do{ SBAR(); \
    const lds_cptr vp_=vp0+sl_prev; \
    VRD(0); SBAR(); float sacc=(P0[0]+P0[1]); \
    GAPA(C0=__builtin_amdgcn_mfma_f32_32x32x16_bf16(kf[0],qr[0],negm,0,0,0), P0[2],P0[3],P0[4],P0[5],     pw0[0]=PKW(P0,0), pw0[1]=PKW(P0,2), pw0); \
    VRD(4); SBAR(); GAPA(C1=__builtin_amdgcn_mfma_f32_32x32x16_bf16(kf[1],qr[0],negm,0,0,0), P0[6],P0[7],P0[8],P0[9],     pw0[2]=PKW(P0,4), pw0[3]=PKW(P0,6), pw0); \
    VRD(1); SBAR(); GAPA(C0=__builtin_amdgcn_mfma_f32_32x32x16_bf16(kf[2],qr[1],C0,0,0,0),   P0[10],P0[11],P0[12],P0[13], pw1[0]=PKW(P0,8), pw1[1]=PKW(P0,10), pw1); \
    VRD(5); SBAR(); GAPA(C1=__builtin_amdgcn_mfma_f32_32x32x16_bf16(kf[3],qr[1],C1,0,0,0),   P0[14],P0[15],P1[0],P1[1],   pw1[2]=PKW(P0,12),pw1[3]=PKW(P0,14), pw1); \
    VRD(2); SBAR(); GAPA(C0=__builtin_amdgcn_mfma_f32_32x32x16_bf16(kf[4],qr[2],C0,0,0,0),   P1[2],P1[3],P1[4],P1[5],     pw2[0]=PKW(P1,0), pw2[1]=PKW(P1,2), pw2); \
    VRD(6); SBAR(); GAPA(C1=__builtin_amdgcn_mfma_f32_32x32x16_bf16(kf[5],qr[2],C1,0,0,0),   P1[6],P1[7],P1[8],P1[9],     pw2[2]=PKW(P1,4), pw2[3]=PKW(P1,6), pw2); \
    VRD(3); SBAR(); GAPA(C0=__builtin_amdgcn_mfma_f32_32x32x16_bf16(kf[6],qr[3],C0,0,0,0),   P1[10],P1[11],P1[12],P1[13], pw3[0]=PKW(P1,8), pw3[1]=PKW(P1,10), pw3); \
    VRD(7); SBAR(); GAPA(C1=__builtin_amdgcn_mfma_f32_32x32x16_bf16(kf[7],qr[3],C1,0,0,0),   P1[14],P1[15],0.f,0.f,       pw3[2]=PKW(P1,12),pw3[3]=PKW(P1,14), pw3); \
    l_reg+=sacc; \
    if(GK){DMA_K((t)+3,sl_cur);} if(GV){DMA_V((t)+1,sl_next);} \
    CMASK(C0,C1,t); \
    { float a=MX3(C0[0],C0[1],C1[0]),b=MX3(C0[2],C0[3],C1[1]); a=MX3(a,C1[2],C1[3]); \
      _Pragma("unroll") for(int r=4;r<16;r+=4){a=MX3(a,C0[r],C0[r+1]);b=MX3(b,C0[r+2],C0[r+3]);a=MX3(a,C1[r],C1[r+1]);b=MX3(b,C1[r+2],C1[r+3]);} \
      float rm=__builtin_fmaxf(a,b); { auto rr=__builtin_amdgcn_permlane32_swap(__float_as_uint(rm),__float_as_uint(rm),false,false); rm=__builtin_fmaxf(__uint_as_float(rr[0]),__uint_as_float(rr[1])); } \
      resc=false; \
      if(__builtin_expect(__any(rm>(float)THRL),0)){ const float dl=__builtin_fmaxf(rm,0.f); mhat+=dl; \
        _Pragma("unroll") for(int r=0;r<16;++r){C0[r]-=dl;C1[r]-=dl;} \
        _Pragma("unroll") for(int r=0;r<16;++r)negm[r]=-mhat; asm volatile("":"+v"(negm)); \
        const float f=__builtin_amdgcn_exp2f(-dl); l_reg*=f; if(hi==0)wsf[r32]=f; resc=true; } } \
    SBAR(); \
    GAPB(o[0]=__builtin_amdgcn_mfma_f32_32x32x16_bf16(PAF(0),VFR(0),o[0],0,0,0), C0,0); \
    GAPB(o[1]=__builtin_amdgcn_mfma_f32_32x32x16_bf16(PAF(0),VFR(4),o[1],0,0,0), C0,4); \
    KRD(GL,0); GAPB(o[0]=__builtin_amdgcn_mfma_f32_32x32x16_bf16(PAF(1),VFR(1),o[0],0,0,0), C0,8); \
    KRD(GL,1); GAPB(o[1]=__builtin_amdgcn_mfma_f32_32x32x16_bf16(PAF(1),VFR(5),o[1],0,0,0), C0,12); \
    KRD(GL,2); GAPB(o[0]=__builtin_amdgcn_mfma_f32_32x32x16_bf16(PAF(2),VFR(2),o[0],0,0,0), C1,0); \
    KRD(GL,3); GAPB(o[1]=__builtin_amdgcn_mfma_f32_32x32x16_bf16(PAF(2),VFR(6),o[1],0,0,0), C1,4); \
    GAPB(o[0]=__builtin_amdgcn_mfma_f32_32x32x16_bf16(PAF(3),VFR(3),o[0],0,0,0), C1,8); \
    GAPB(o[1]=__builtin_amdgcn_mfma_f32_32x32x16_bf16(PAF(3),VFR(7),o[1],0,0,0), C1,12); \
    }while(0)
  int t=1;
  #undef CMASK
  #define CMASK(P0,P1,t) do{int jb_=(t)-(NT-4); if(jb_>=-2)cmask(P0,P1,jb_,qrel,hi,btl);}while(0)
  for(;t+5<NT;t+=2){
    STEP(pB0,pB1,pA0,pA1,t,true,true,true);     WAIT_BAR(2); RESC(); ROT();
    STEP(pA0,pA1,pB0,pB1,t+1,true,true,true);   WAIT_BAR(2); RESC(); ROT();
  }
  #undef CMASK
  #define CMASK(P0,P1,t) do{int jb_=(t)-(NT-4); if(jb_>=-2)cmask(P0,P1,jb_,qrel,hi,btl);}while(0)
  #define ENDW(tt) do{ if((tt)+3<NT){WAIT_BAR(2);} else if((tt)+2<NT){WAIT_BAR(1);} else {WAIT_BAR(0);} }while(0)
  for(;t+1<NT;t+=2){
    STEP(pB0,pB1,pA0,pA1,t,(t+3<NT),(t+1<NT),(t+1<NT));       ENDW(t);   RESC(); ROT();
    STEP(pA0,pA1,pB0,pB1,t+1,(t+4<NT),(t+2<NT),(t+2<NT));     ENDW(t+1); RESC(); ROT();
  }
  STEP(pB0,pB1,pA0,pA1,NT-1,false,false,false); RESC();
  { float sacc=pB0[0]+pB0[1]; _Pragma("unroll") for(int r=2;r<16;++r)sacc+=pB0[r]; _Pragma("unroll") for(int r=0;r<16;++r)sacc+=pB1[r]; l_reg+=sacc;
    pw0=(u32x4){PKW(pB0,0),PKW(pB0,2),PKW(pB0,4),PKW(pB0,6)};pw1=(u32x4){PKW(pB0,8),PKW(pB0,10),PKW(pB0,12),PKW(pB0,14)};pw2=(u32x4){PKW(pB1,0),PKW(pB1,2),PKW(pB1,4),PKW(pB1,6)};pw3=(u32x4){PKW(pB1,8),PKW(pB1,10),PKW(pB1,12),PKW(pB1,14)};
    SBAR(); pv(o,vb0+sl_cur,PAF(0),PAF(1),PAF(2),PAF(3)); }
  #undef PKW
  #undef PAF
  #undef VFR
  #undef PIN
  #undef MX3
  #undef GAPA
  #undef GAPB
  #undef EX
  #undef VRD
  #undef KRD
  #undef STEP
  #undef ENDW
  {auto rr=__builtin_amdgcn_permlane32_swap(__float_as_uint(l_reg),__float_as_uint(l_reg),false,false);l_reg=__uint_as_float(rr[0])+__uint_as_float(rr[1]);}
  if(hi==0)wsf[32+r32]=l_reg;asm volatile("s_waitcnt lgkmcnt(0)":::"memory");
  float rli[16];
  #pragma unroll
  for(int r=0;r<16;++r)rli[r]=__builtin_amdgcn_rcpf(wsf[32+crow(r,hi)]);
  bf16*Ow=O+(rowbase+q0+wid*QBLK)*OP+g*D;
  { bf16*stg=(bf16*)(shm+LDS_OST)+wid*2048;
    #pragma unroll
    for(int r=0;r<16;++r){const int orow=crow(r,hi);
      #pragma unroll
      for(int d0=0;d0<2;++d0)stg[orow*64+d0*32+r32]=__float2bfloat16(o[d0][r]*rli[r]);}
    asm volatile("s_waitcnt lgkmcnt(0)":::"memory");
    #pragma unroll
    for(int i=0;i<4;++i){const int row=i*8+(lane>>3),ch=lane&7; const u32x4 v=*(const u32x4*)(stg+row*64+ch*8); ATTN_STORE16(Ow+(long)row*OP+ch*8,v);} }
  asm volatile("s_waitcnt lgkmcnt(0)\n\ts_barrier":::"memory");
  #undef DMA_K
  #undef DMA_V
  #undef CMASK
  #undef START
  #undef RESC
  #undef ROT
}
constexpr int ATTN_LDS_BYTES=LDS_BYTES;
struct AttnTensors { const bf16* Z; bf16* O; const float* btab; };
struct AttnUnit { int bh; int qb; };
struct StaticOrder {
  int vcu;
  __device__ __forceinline__ explicit StaticOrder(int grid,int block):vcu((block%8)*(grid/8)+block/8){}
  __device__ __forceinline__ bool next(int i,AttnUnit&u)const{ if(i>=4)return false; const int s=vcu&3; u.bh=vcu>>2; u.qb=(i==0)?15-s:(i==1)?8+s:(i==2)?7-s:s; return true; }
  __device__ __forceinline__ void a_ready(const AttnUnit&)const{}
  __device__ __forceinline__ void done(const AttnUnit&)const{}
};
template<class Sched,int THRL=8> __device__ __forceinline__ void attn_phase(char*lds,const AttnTensors&T,const Sched&S){
  AttnUnit u;
  for(int i=0;S.next(i,u);++i){ S.a_ready(u); attn_unit<THRL>(u.bh/NHEAD,u.bh%NHEAD,u.qb,T.Z,T.O,T.btab,lds); S.done(u); }
}
#undef SBAR
#undef WAIT_BAR
}
namespace attn128 {
using bf16=__hip_bfloat16;
using bf16x8=__attribute__((ext_vector_type(8)))short;
using s16x4=__attribute__((ext_vector_type(4)))short;
using f32x16=__attribute__((ext_vector_type(16)))float;
using u32x4=__attribute__((ext_vector_type(4)))unsigned;
constexpr int BATCH=4,NHEAD=16,SEQ=4096,D=64,DM=2816,OP=1024;
constexpr int NW=8,QBLK=32,QB=QBLK*NW,KVBLK=64,NQB=SEQ/QB;
constexpr int ATTN_PITCH=DM, ATTN_UNIT_ROWS=QB;
__device__ __forceinline__ int crow(int r,int hi){return (r&3)+8*(r>>2)+4*hi;}
#define SBAR() __builtin_amdgcn_sched_barrier(0)
typedef __attribute__((address_space(3))) const float* lds_cfptr;
__device__ __forceinline__ void cmask(f32x16&p0,f32x16&p1,int jb,int qrel,int hi,lds_cfptr bt){
  const float NEG=-INFINITY; const int d00=qrel-(64*jb+4*hi);
  #pragma unroll
  for(int r=0;r<16;++r){const int d0=d00-((r&3)+8*(r>>2)), d1=d0-32;
    p0[r]+=bt[d0<0?0:d0]; p1[r]+=bt[d1<0?0:d1]; if(d0<0)p0[r]=NEG; if(d1<0)p1[r]=NEG;
    if((r&3)==3)__builtin_amdgcn_sched_barrier(0);}
}

constexpr int NSLOT=3, SLOTB=8192;
constexpr int LDS_K=0, LDS_V=NSLOT*SLOTB, LDS_WS=3*NSLOT*SLOTB, LDS_OST=LDS_WS+NW*64*4, LDS_BT=LDS_OST+NW*4096, LDS_BYTES=LDS_BT+1536;
constexpr float C2=0.125f*1.4426950408889634f;
__device__ __forceinline__ void glds16(const void*gsrc,unsigned lds_dst){unsigned keep;
  asm volatile("s_mov_b32 %0, m0\n\ts_mov_b32 m0, %2\n\ts_nop 0\n\tglobal_load_lds_dwordx4 %1, off\n\ts_mov_b32 m0, %0":"=&s"(keep):"v"(gsrc),"s"(lds_dst):"memory");}
__device__ __forceinline__ float max3f(float a,float b,float c){float r;asm("v_max3_f32 %0, %1, %2, %3":"=v"(r):"v"(a),"v"(b),"v"(c));return r;}
__device__ __forceinline__ float max2f(float a,float b){float r;asm("v_max_f32_e32 %0, %1, %2":"=v"(r):"v"(a),"v"(b));return r;}
__device__ __forceinline__ float fadd_s(float a,float b){float r;asm("v_add_f32_e32 %0, %1, %2":"=v"(r):"v"(a),"v"(b));return r;}
__device__ __forceinline__ float fsub_s(float a,float b){float r;asm("v_sub_f32_e32 %0, %1, %2":"=v"(r):"v"(a),"v"(b));return r;}
typedef float f32x2_t __attribute__((ext_vector_type(2))); typedef __bf16 bf16x2_t __attribute__((ext_vector_type(2)));
__device__ __forceinline__ unsigned cvtpk_s(float lo,float hi){f32x2_t v={lo,hi};bf16x2_t b=__builtin_convertvector(v,bf16x2_t);return __builtin_bit_cast(unsigned,b);}
#define WAIT_BAR(N) asm volatile("s_waitcnt vmcnt(" #N ") lgkmcnt(0)\n\ts_barrier":::"memory")

__device__ __forceinline__ void qkt(f32x16&p0,f32x16&p1,const char*Kslot,const bf16x8*qr,int r32,int hi){
  const char*kb=Kslot+hi*1024+r32*16;
  #pragma unroll
  for(int d0=0;d0<4;++d0){
    const bf16x8 b0=*reinterpret_cast<const bf16x8*>(kb+d0*2048);
    const bf16x8 b1=*reinterpret_cast<const bf16x8*>(kb+d0*2048+512);
    if(d0==0){p0=__builtin_amdgcn_mfma_f32_32x32x16_bf16(b0,qr[0],f32x16{},0,0,0);p1=__builtin_amdgcn_mfma_f32_32x32x16_bf16(b1,qr[0],f32x16{},0,0,0);}
    else{p0=__builtin_amdgcn_mfma_f32_32x32x16_bf16(b0,qr[d0],p0,0,0,0);p1=__builtin_amdgcn_mfma_f32_32x32x16_bf16(b1,qr[d0],p1,0,0,0);}}
}
typedef __attribute__((address_space(3))) const char* lds_cptr;
typedef short v4i16_t __attribute__((ext_vector_type(4)));
__device__ __forceinline__ void kload8(bf16x8*kf,lds_cptr kp){
  kf[0]=*(const __attribute__((address_space(3))) bf16x8*)(kp);      kf[1]=*(const __attribute__((address_space(3))) bf16x8*)(kp+512);
  kf[2]=*(const __attribute__((address_space(3))) bf16x8*)(kp+2048); kf[3]=*(const __attribute__((address_space(3))) bf16x8*)(kp+2560);
  kf[4]=*(const __attribute__((address_space(3))) bf16x8*)(kp+4096); kf[5]=*(const __attribute__((address_space(3))) bf16x8*)(kp+4608);
  kf[6]=*(const __attribute__((address_space(3))) bf16x8*)(kp+6144); kf[7]=*(const __attribute__((address_space(3))) bf16x8*)(kp+6656);
}
__device__ __forceinline__ void kload2(bf16x8*kf,lds_cptr kp,int j){ kf[2*j]=*(const __attribute__((address_space(3))) bf16x8*)(kp+j*2048); kf[2*j+1]=*(const __attribute__((address_space(3))) bf16x8*)(kp+j*2048+512); }
__device__ __forceinline__ s16x4 vtr(lds_cptr p){ return __builtin_bit_cast(s16x4,__builtin_amdgcn_ds_read_tr16_b64_v4i16((__attribute__((address_space(3))) v4i16_t*)p)); }
__device__ __forceinline__ float rowmax(const f32x16&p0,const f32x16&p1){
  float a=max3f(p0[0],p0[1],p1[0]),b=max3f(p0[2],p0[3],p1[1]);a=max3f(a,p1[2],p1[3]);
  #pragma unroll
  for(int r=4;r<16;r+=4){a=max3f(a,p0[r],p0[r+1]);b=max3f(b,p0[r+2],p0[r+3]);a=max3f(a,p1[r],p1[r+1]);b=max3f(b,p1[r+2],p1[r+3]);}
  const float m=max2f(a,b);
  auto rr=__builtin_amdgcn_permlane32_swap(__float_as_uint(m),__float_as_uint(m),false,false);
  return max2f(__uint_as_float(rr[0]),__uint_as_float(rr[1]));
}
__device__ __forceinline__ void pv(f32x16*o,int vb,bf16x8 pa0,bf16x8 pa1,bf16x8 pa2,bf16x8 pa3){
  #pragma unroll
  for(int d0=0;d0<4;++d0){s16x4 lo[4],hi[4];
    #pragma unroll
    for(int ks=0;ks<4;++ks){
      asm volatile("ds_read_b64_tr_b16 %0,%1 offset:%c2":"=&v"(lo[ks]):"v"(vb),"i"(d0*4096+ks*1024):"memory");
      asm volatile("ds_read_b64_tr_b16 %0,%1 offset:%c2":"=&v"(hi[ks]):"v"(vb),"i"(d0*4096+ks*1024+512):"memory");}
    asm volatile("s_waitcnt lgkmcnt(0)":::"memory");SBAR();
    #define PK(k) (bf16x8){lo[k][0],lo[k][1],lo[k][2],lo[k][3],hi[k][0],hi[k][1],hi[k][2],hi[k][3]}
    o[d0]=__builtin_amdgcn_mfma_f32_32x32x16_bf16(pa0,PK(0),o[d0],0,0,0);
    o[d0]=__builtin_amdgcn_mfma_f32_32x32x16_bf16(pa1,PK(1),o[d0],0,0,0);
    o[d0]=__builtin_amdgcn_mfma_f32_32x32x16_bf16(pa2,PK(2),o[d0],0,0,0);
    o[d0]=__builtin_amdgcn_mfma_f32_32x32x16_bf16(pa3,PK(3),o[d0],0,0,0);
    #undef PK
  }
}

#undef ATTN_STORE16
#define ATTN_STORE16(p,v) __builtin_amdgcn_raw_buffer_store_b128((v), __builtin_amdgcn_make_buffer_rsrc((void*)O, 0, 32 << 20, 0x00020000), (unsigned)((const char*)(p) - (const char*)O), 0, 16)
template<int THRL> __device__ __forceinline__ void attn_unit(int b,int hm,int qb,const bf16*__restrict__ Zb,bf16*O,const float*__restrict__ btab,char*shm){
  int tid_=threadIdx.x; asm volatile("":"+v"(tid_)); const int tid=tid_,lane=tid&63,r32=lane&31,hi=lane>>5; const int wid=__builtin_amdgcn_readfirstlane(tid>>6);
  const long rowbase=(long)b*SEQ; const int q0=qb*QB;
  const float btv=(tid<384)?btab[hm*384+tid]:0.f;
  const bf16*Qw=Zb+(rowbase+q0+wid*QBLK)*DM+hm*D;
  const bf16*Kh=Zb+rowbase*DM+512+hm*D,*Vh=Zb+rowbase*DM+1024+(hm>>1)*128;
  const unsigned lds0=(unsigned)(uintptr_t)shm;
  float*wsf=(float*)(shm+LDS_WS)+wid*64;
  const bf16*ksrc=Kh+(long)lane*DM+wid*8;
  const bf16*vsrc=Vh+(long)(16*(wid&3)+(lane>>2))*DM+(wid>>2)*32+(lane&3)*8;
  const unsigned kdst=lds0+LDS_K+wid*1024, vdst=lds0+LDS_V+wid*1024;
  #define DMA_K(t,slot) glds16(ksrc+(long)(t)*KVBLK*DM,(unsigned)__builtin_amdgcn_readfirstlane(kdst+(slot)))
  #define DMA_V(t,slot) do{ glds16(vsrc+(long)(t)*KVBLK*DM,(unsigned)__builtin_amdgcn_readfirstlane(vdst+2*(slot))); glds16(vsrc+(long)(t)*KVBLK*DM+64,(unsigned)__builtin_amdgcn_readfirstlane(vdst+2*(slot)+8192)); }while(0)
  const int vb0=(int)(lds0+LDS_V)+((lane>>4)&1)*32+(lane&3)*8+(4*hi+((lane&15)>>2))*64;
  const char*Kbase=shm+LDS_K; bf16x8 kf[8];
  const lds_cptr shm3=(lds_cptr)shm; const lds_cptr kp0=shm3+LDS_K+hi*1024+r32*16; const lds_cptr vp0=shm3+LDS_V+((lane>>4)&1)*32+(lane&3)*8+(4*hi+((lane&15)>>2))*64;
  const int NT=(q0+QB)/KVBLK;
  DMA_K(0,0);DMA_V(0,0);DMA_K(1,SLOTB);
  bf16x8 qr[4];
  #pragma unroll
  for(int d0=0;d0<4;++d0)qr[d0]=*reinterpret_cast<const bf16x8*>(&Qw[(long)r32*DM+d0*16+hi*8]);
  const lds_cfptr btl=(lds_cfptr)((lds_cptr)shm+LDS_BT); if(tid<384)((__attribute__((address_space(3))) float*)((__attribute__((address_space(3))) char*)shm+LDS_BT))[tid]=btv;
  float mhat=0.f,l_reg=0.f;f32x16 o[4];o[0]=f32x16{};o[1]=f32x16{};o[2]=f32x16{};o[3]=f32x16{};
  const int qrel=wid*QBLK+r32;
  #define CMASK(P0,P1,t) do{int jb_=(t)-(NT-4); if(jb_>=-2)cmask(P0,P1,jb_,qrel,hi,btl);}while(0)
  bool resc=false;
  #define START(P0,P1) do{ const float rm=rowmax(P0,P1); resc=false; mhat=rm; \
    _Pragma("unroll") for(int r=0;r<16;++r)P0[r]=__builtin_amdgcn_exp2f(P0[r]-mhat); }while(0)
  #define RESC() do{ if(resc){ asm volatile("s_waitcnt lgkmcnt(0)":::"memory"); \
      _Pragma("unroll") for(int d_=0;d_<4;++d_) _Pragma("unroll") for(int r=0;r<16;++r)o[d_][r]*=wsf[crow(r,hi)]; } }while(0)
  f32x16 pA0,pA1,pB0,pB1;
  int sl_prev=0,sl_cur=0,sl_next=SLOTB;
  #define ROT() do{sl_prev=sl_cur;sl_cur=sl_next;sl_next=(sl_next==(NSLOT-1)*SLOTB)?0:sl_next+SLOTB;}while(0)
  DMA_K(2,2*SLOTB);
  WAIT_BAR(4);
  qkt(pA0,pA1,Kbase,qr,r32,hi);asm volatile("s_nop 15\n\ts_nop 7":"+v"(pA0),"+v"(pA1));CMASK(pA0,pA1,0);
  START(pA0,pA1);
  _Pragma("unroll") for(int r=0;r<16;++r)pA1[r]=__builtin_amdgcn_exp2f(pA1[r]-mhat);
  WAIT_BAR(0);
  DMA_K(3,0);DMA_V(1,SLOTB);
  ROT();
  kload8(kf,kp0+sl_cur);
  WAIT_BAR(3);
  s16x4 vlo[8],vhi[8]; u32x4 pw0,pw1,pw2,pw3;
  #define PKW(P,B) cvtpk_s(P[B],P[B+1])
  #define PAF(k) __builtin_bit_cast(bf16x8,pw##k)
  #define VFR(i) (bf16x8){vlo[i][0],vlo[i][1],vlo[i][2],vlo[i][3],vhi[i][0],vhi[i][1],vhi[i][2],vhi[i][3]}
  #define PIN(x) asm volatile("":"+v"(x))
  #define MX3(a,b,c) __builtin_fmaxf(__builtin_fmaxf((a),(b)),(c))
  #define GAPA(MF,A0,A1,A2,A3,W0,W1,PW) do{ MF; sacc+=A0; sacc+=A1; sacc+=A2; sacc+=A3; PIN(sacc); W0; W1; PIN(PW); SBAR(); }while(0)
  #define EX(v) __builtin_amdgcn_exp2f(v)
  #define GAPB(MF,X,B) do{ MF; X[B]=EX(X[B]-mhat); X[B+1]=EX(X[B+1]-mhat); X[B+2]=EX(X[B+2]-mhat); X[B+3]=EX(X[B+3]-mhat); PIN(X); SBAR(); }while(0)
  #define VRD2(i) do{ vlo[i]=vtr(vp_+(8192+((i)>>2)*4096+((i)&3)*1024)); vhi[i]=vtr(vp_+(8192+((i)>>2)*4096+((i)&3)*1024+512)); SBAR(); }while(0)
  #define GAPE(MF,X,B) do{ MF; X[B]=EX(X[B]-mhat); X[B+1]=EX(X[B+1]-mhat); PIN(X); SBAR(); }while(0)
  #define VRD(i) do{ vlo[i]=vtr(vp_+(((i)>>2)*4096+((i)&3)*1024)); vhi[i]=vtr(vp_+(((i)>>2)*4096+((i)&3)*1024+512)); }while(0)
  #define KRD(G,j) do{ if(G){ kload2(kf,kp0+sl_next,j); SBAR(); } }while(0)
  #define STEP(C0,C1,P0,P1,t,GK,GV,GL) do{ SBAR(); \
    const lds_cptr vp_=vp0+2*sl_prev; \
    VRD(0); SBAR(); float sacc=(P0[0]+P0[1]); \
    GAPA(C0=__builtin_amdgcn_mfma_f32_32x32x16_bf16(kf[0],qr[0],f32x16{},0,0,0), P0[2],P0[3],P0[4],P0[5],     pw0[0]=PKW(P0,0), pw0[1]=PKW(P0,2), pw0); \
    VRD(4); SBAR(); GAPA(C1=__builtin_amdgcn_mfma_f32_32x32x16_bf16(kf[1],qr[0],f32x16{},0,0,0), P0[6],P0[7],P0[8],P0[9],     pw0[2]=PKW(P0,4), pw0[3]=PKW(P0,6), pw0); \
    VRD(1); SBAR(); GAPA(C0=__builtin_amdgcn_mfma_f32_32x32x16_bf16(kf[2],qr[1],C0,0,0,0),   P0[10],P0[11],P0[12],P0[13], pw1[0]=PKW(P0,8), pw1[1]=PKW(P0,10), pw1); \
    VRD(5); SBAR(); GAPA(C1=__builtin_amdgcn_mfma_f32_32x32x16_bf16(kf[3],qr[1],C1,0,0,0),   P0[14],P0[15],P1[0],P1[1],   pw1[2]=PKW(P0,12),pw1[3]=PKW(P0,14), pw1); \
    VRD(2); SBAR(); GAPA(C0=__builtin_amdgcn_mfma_f32_32x32x16_bf16(kf[4],qr[2],C0,0,0,0),   P1[2],P1[3],P1[4],P1[5],     pw2[0]=PKW(P1,0), pw2[1]=PKW(P1,2), pw2); \
    VRD(6); SBAR(); GAPA(C1=__builtin_amdgcn_mfma_f32_32x32x16_bf16(kf[5],qr[2],C1,0,0,0),   P1[6],P1[7],P1[8],P1[9],     pw2[2]=PKW(P1,4), pw2[3]=PKW(P1,6), pw2); \
    VRD(3); SBAR(); GAPA(C0=__builtin_amdgcn_mfma_f32_32x32x16_bf16(kf[6],qr[3],C0,0,0,0),   P1[10],P1[11],P1[12],P1[13], pw3[0]=PKW(P1,8), pw3[1]=PKW(P1,10), pw3); \
    VRD(7); SBAR(); GAPA(C1=__builtin_amdgcn_mfma_f32_32x32x16_bf16(kf[7],qr[3],C1,0,0,0),   P1[14],P1[15],0.f,0.f,       pw3[2]=PKW(P1,12),pw3[3]=PKW(P1,14), pw3); \
    l_reg+=sacc; \
    if(GK){DMA_K((t)+3,sl_cur);} if(GV){DMA_V((t)+1,sl_next);} \
    CMASK(C0,C1,t); \
    { float a=MX3(C0[0],C0[1],C1[0]),b=MX3(C0[2],C0[3],C1[1]); a=MX3(a,C1[2],C1[3]); \
      _Pragma("unroll") for(int r=4;r<16;r+=4){a=MX3(a,C0[r],C0[r+1]);b=MX3(b,C0[r+2],C0[r+3]);a=MX3(a,C1[r],C1[r+1]);b=MX3(b,C1[r+2],C1[r+3]);} \
      float rm=__builtin_fmaxf(a,b); { auto rr=__builtin_amdgcn_permlane32_swap(__float_as_uint(rm),__float_as_uint(rm),false,false); rm=__builtin_fmaxf(__uint_as_float(rr[0]),__uint_as_float(rr[1])); } \
      resc=false; \
      rm-=mhat; \
      if(__builtin_expect(__any(rm>(float)THRL),0)){ const float dl=__builtin_fmaxf(rm,0.f); mhat+=dl; \
        const float f=__builtin_amdgcn_exp2f(-dl); l_reg*=f; if(hi==0)wsf[r32]=f; resc=true; } } \
    SBAR(); \
    GAPE(o[0]=__builtin_amdgcn_mfma_f32_32x32x16_bf16(PAF(0),VFR(0),o[0],0,0,0), C0,0); VRD2(0); \
    GAPE(o[1]=__builtin_amdgcn_mfma_f32_32x32x16_bf16(PAF(0),VFR(4),o[1],0,0,0), C0,2); VRD2(4); \
    GAPE(o[0]=__builtin_amdgcn_mfma_f32_32x32x16_bf16(PAF(1),VFR(1),o[0],0,0,0), C0,4); VRD2(1); \
    GAPE(o[1]=__builtin_amdgcn_mfma_f32_32x32x16_bf16(PAF(1),VFR(5),o[1],0,0,0), C0,6); VRD2(5); \
    GAPE(o[0]=__builtin_amdgcn_mfma_f32_32x32x16_bf16(PAF(2),VFR(2),o[0],0,0,0), C0,8); VRD2(2); \
    GAPE(o[1]=__builtin_amdgcn_mfma_f32_32x32x16_bf16(PAF(2),VFR(6),o[1],0,0,0), C0,10); VRD2(6); \
    GAPE(o[0]=__builtin_amdgcn_mfma_f32_32x32x16_bf16(PAF(3),VFR(3),o[0],0,0,0), C0,12); VRD2(3); \
    GAPE(o[1]=__builtin_amdgcn_mfma_f32_32x32x16_bf16(PAF(3),VFR(7),o[1],0,0,0), C0,14); VRD2(7); \
    KRD(GL,0); GAPE(o[2]=__builtin_amdgcn_mfma_f32_32x32x16_bf16(PAF(0),VFR(0),o[2],0,0,0), C1,0); \
    KRD(GL,1); GAPE(o[3]=__builtin_amdgcn_mfma_f32_32x32x16_bf16(PAF(0),VFR(4),o[3],0,0,0), C1,2); \
    KRD(GL,2); GAPE(o[2]=__builtin_amdgcn_mfma_f32_32x32x16_bf16(PAF(1),VFR(1),o[2],0,0,0), C1,4); \
    KRD(GL,3); GAPE(o[3]=__builtin_amdgcn_mfma_f32_32x32x16_bf16(PAF(1),VFR(5),o[3],0,0,0), C1,6); \
    GAPE(o[2]=__builtin_amdgcn_mfma_f32_32x32x16_bf16(PAF(2),VFR(2),o[2],0,0,0), C1,8); \
    GAPE(o[3]=__builtin_amdgcn_mfma_f32_32x32x16_bf16(PAF(2),VFR(6),o[3],0,0,0), C1,10); \
    GAPE(o[2]=__builtin_amdgcn_mfma_f32_32x32x16_bf16(PAF(3),VFR(3),o[2],0,0,0), C1,12); \
    GAPE(o[3]=__builtin_amdgcn_mfma_f32_32x32x16_bf16(PAF(3),VFR(7),o[3],0,0,0), C1,14); \
    }while(0)
  int t=1;
  #undef CMASK
  #define CMASK(P0,P1,t) do{int jb_=(t)-(NT-4); if(jb_>=-2)cmask(P0,P1,jb_,qrel,hi,btl);}while(0)
  for(;t+5<NT;t+=2){
    STEP(pB0,pB1,pA0,pA1,t,true,true,true);     WAIT_BAR(3); RESC(); ROT();
    STEP(pA0,pA1,pB0,pB1,t+1,true,true,true);   WAIT_BAR(3); RESC(); ROT();
  }
  #undef CMASK
  #define CMASK(P0,P1,t) do{int jb_=(t)-(NT-4); if(jb_>=-2)cmask(P0,P1,jb_,qrel,hi,btl);}while(0)
  #define ENDW(tt) do{ if((tt)+3<NT){WAIT_BAR(3);} else if((tt)+2<NT){WAIT_BAR(2);} else {WAIT_BAR(0);} }while(0)
  for(;t+1<NT;t+=2){
    STEP(pB0,pB1,pA0,pA1,t,(t+3<NT),(t+1<NT),(t+1<NT));       ENDW(t);   RESC(); ROT();
    STEP(pA0,pA1,pB0,pB1,t+1,(t+4<NT),(t+2<NT),(t+2<NT));     ENDW(t+1); RESC(); ROT();
  }
  STEP(pB0,pB1,pA0,pA1,NT-1,false,false,false); RESC();
  { float sacc=pB0[0]+pB0[1]; _Pragma("unroll") for(int r=2;r<16;++r)sacc+=pB0[r]; _Pragma("unroll") for(int r=0;r<16;++r)sacc+=pB1[r]; l_reg+=sacc;
    pw0=(u32x4){PKW(pB0,0),PKW(pB0,2),PKW(pB0,4),PKW(pB0,6)};pw1=(u32x4){PKW(pB0,8),PKW(pB0,10),PKW(pB0,12),PKW(pB0,14)};pw2=(u32x4){PKW(pB1,0),PKW(pB1,2),PKW(pB1,4),PKW(pB1,6)};pw3=(u32x4){PKW(pB1,8),PKW(pB1,10),PKW(pB1,12),PKW(pB1,14)};
    SBAR(); pv(o,vb0+2*sl_cur,PAF(0),PAF(1),PAF(2),PAF(3)); }
  #undef PKW
  #undef PAF
  #undef VFR
  #undef PIN
  #undef MX3
  #undef GAPA
  #undef GAPB
  #undef EX
  #undef VRD
  #undef VRD2
  #undef GAPE
  #undef KRD
  #undef STEP
  #undef ENDW
  {auto rr=__builtin_amdgcn_permlane32_swap(__float_as_uint(l_reg),__float_as_uint(l_reg),false,false);l_reg=__uint_as_float(rr[0])+__uint_as_float(rr[1]);}
  if(hi==0)wsf[32+r32]=l_reg;asm volatile("s_waitcnt lgkmcnt(0)":::"memory");
  float rli[16];
  #pragma unroll
  for(int r=0;r<16;++r)rli[r]=__builtin_amdgcn_rcpf(wsf[32+crow(r,hi)]);
  bf16*Ow=O+(rowbase+q0+wid*QBLK)*OP+hm*128;
  { bf16*stg=(bf16*)(shm+LDS_OST)+wid*2048;
    #pragma unroll
    for(int hf=0;hf<2;++hf){
      #pragma unroll
      for(int r=0;r<16;++r){const int orow=crow(r,hi);
        #pragma unroll
        for(int d0=0;d0<2;++d0)stg[orow*64+d0*32+r32]=__float2bfloat16(o[2*hf+d0][r]*rli[r]);}
      asm volatile("s_waitcnt lgkmcnt(0)":::"memory");
      #pragma unroll
      for(int i=0;i<4;++i){const int row=i*8+(lane>>3),ch=lane&7; const u32x4 v=*(const u32x4*)(stg+row*64+ch*8); ATTN_STORE16(Ow+(long)row*OP+hf*64+ch*8,v);}
      asm volatile("s_waitcnt lgkmcnt(0)":::"memory"); } }
  asm volatile("s_waitcnt lgkmcnt(0)\n\ts_barrier":::"memory");
  #undef DMA_K
  #undef DMA_V
  #undef CMASK
  #undef START
  #undef RESC
  #undef ROT
}
constexpr int ATTN_LDS_BYTES=LDS_BYTES;
struct AttnTensors { const bf16* Z; bf16* O; const float* btab; };
struct AttnUnit { int bh; int qb; };
struct StaticOrder {
  int vcu;
  __device__ __forceinline__ explicit StaticOrder(int grid,int block):vcu((block%8)*(grid/8)+block/8){}
  __device__ __forceinline__ bool next(int i,AttnUnit&u)const{ if(i>=2)return false; const int s=vcu&7; u.bh=vcu>>3; u.qb=(i==0)?15-s:s; return true; }
  __device__ __forceinline__ void a_ready(const AttnUnit&)const{}
  __device__ __forceinline__ void done(const AttnUnit&)const{}
};
template<class Sched,int THRL=8> __device__ __forceinline__ void attn_phase(char*lds,const AttnTensors&T,const Sched&S){
  AttnUnit u;
  for(int i=0;S.next(i,u);++i){ S.a_ready(u); attn_unit<THRL>(u.bh>>3,u.bh&7,u.qb,T.Z,T.O,T.btab,lds); S.done(u); }
}
#undef SBAR
#undef WAIT_BAR
}
namespace swa {
constexpr float THR = 8.f; constexpr bool WSKIP = false;
constexpr float SCALE = 0.6931471805599453f;
constexpr int D = 128, DK = 64, ZPITCH = 2816, OPITCH = 1024;
constexpr int NW = 8, QBLK = 32, KVBLK = 64, QB = NW * QBLK;
constexpr int SHM_V = KVBLK * D * 2, SHM_K = KVBLK * DK * 2;
constexpr int LDS_BT = 2 * SHM_V + 2 * SHM_K + NW * 64 * 4, LDS_BYTES = LDS_BT + 1536;

using bf16 = __hip_bfloat16;
typedef __attribute__((address_space(3))) const float* lds_cfptr;
typedef short bf16x8 __attribute__((ext_vector_type(8)));
typedef short s16x4 __attribute__((ext_vector_type(4)));
typedef float f32x16 __attribute__((ext_vector_type(16)));
typedef float f32x4 __attribute__((ext_vector_type(4)));
typedef unsigned u32x4 __attribute__((ext_vector_type(4)));
template <class A, class Bt> struct same_t { static constexpr bool v = false; };
template <class A> struct same_t<A, A> { static constexpr bool v = true; };

#define KSWZ(row, colB) ((row) * 128 + ((colB) ^ ((((row) >> 1) & 7) << 4)))
#define SBAR() __builtin_amdgcn_sched_barrier(0)
__device__ __forceinline__ int v_st(int k, int c) { const int kk = (k & ~0xC) | ((k & 4) << 1) | ((k & 8) >> 1); return ((kk >> 3) * 4 + (c >> 5)) * 512 + ((kk & 7) * 32 + (c & 31)) * 2; }
__device__ __forceinline__ int v_rd_base(int lane) { return ((lane & 3) << 3) | (((lane >> 2) & 3) << 6) | (((lane >> 4) & 1) << 5) | (((lane >> 5) & 1) << 8); }
constexpr int v_rd_off(int d0, int ks, int half) { return d0 * 512 + ks * 4096 + half * 2048; }
__device__ __forceinline__ int crow(int r, int hi) { return (r & 3) + 8 * (r >> 2) + 4 * hi; }
__device__ __forceinline__ unsigned cvtpk(float lo, float hi) {
    unsigned r; asm volatile("v_cvt_pk_bf16_f32 %0, %1, %2" : "=v"(r) : "v"(lo), "v"(hi)); return r;
}
__device__ __forceinline__ bf16x8 pack8(f32x4 a, f32x4 b) {
    u32x4 w = {cvtpk(a[0], a[1]), cvtpk(a[2], a[3]), cvtpk(b[0], b[1]), cvtpk(b[2], b[3])};
    return *reinterpret_cast<bf16x8*>(&w);
}
template <class T> __device__ __forceinline__ bf16x8 load8(const T* p) {
    if constexpr (same_t<T, float>::v) { return pack8(*(const f32x4*)p, *(const f32x4*)(p + 4)); }
    else { return *reinterpret_cast<const bf16x8*>(p); }
}
__device__ __forceinline__ void mask_tile(f32x16& p0, f32x16& p1, int dq, lds_cfptr bt) {
    const float NEG = -__builtin_inff();
#pragma unroll
    for (int r = 0; r < 16; ++r) {
        const int c = (r & 3) + 8 * (r >> 2); const int d0 = dq - c, d1 = d0 - 32;
        p0[r] += bt[d0 < 0 ? 0 : d0]; p1[r] += bt[d1 < 0 ? 0 : d1];
        if (d0 < 0) p0[r] = NEG; if (d1 < 0) p1[r] = NEG;
        if ((r & 3) == 3) __builtin_amdgcn_sched_barrier(0);
    }
}
__device__ __forceinline__ void partialSM(f32x16& p0, f32x16& p1, float& m_reg, float& mn, float& alpha) {
    float pmax = p0[0]; for (int r = 1; r < 16; ++r) pmax = fmaxf(pmax, p0[r]); for (int r = 0; r < 16; ++r) pmax = fmaxf(pmax, p1[r]);
    { auto rr = __builtin_amdgcn_permlane32_swap(__float_as_uint(pmax), __float_as_uint(pmax), false, false);
      pmax = fmaxf(__uint_as_float(rr[0]), __uint_as_float(rr[1])); }
    constexpr float C2 = 1.4426950408889634f * SCALE;
    if (__builtin_expect(__all((pmax - m_reg) * SCALE <= THR), 1)) { mn = m_reg; alpha = 1.f; }
    else { mn = fmaxf(m_reg, pmax); alpha = __builtin_amdgcn_exp2f((m_reg - mn) * C2); m_reg = mn; }
    const float mnL = -mn * C2;
    for (int r = 0; r < 16; ++r) p0[r] = fmaf(p0[r], C2, mnL); for (int r = 0; r < 16; ++r) p1[r] = fmaf(p1[r], C2, mnL);
    for (int r = 0; r < 16; ++r) p0[r] = __builtin_amdgcn_exp2f(p0[r]);
}
__device__ __forceinline__ void finishSM(f32x16& p0, f32x16& p1, float alpha, float& l_reg, bf16x8& pa0, bf16x8& pa1, bf16x8& pa2, bf16x8& pa3) {
    for (int r = 0; r < 16; ++r) p1[r] = __builtin_amdgcn_exp2f(p1[r]);
    float ps = 0; for (int r = 0; r < 16; ++r) ps += p0[r]; for (int r = 0; r < 16; ++r) ps += p1[r];
    { auto rr = __builtin_amdgcn_permlane32_swap(__float_as_uint(ps), __float_as_uint(ps), false, false);
      ps = __uint_as_float(rr[0]) + __uint_as_float(rr[1]); }
    l_reg = l_reg * alpha + ps;
#define PK4(P, B_, OUT) do { unsigned a0 = cvtpk(P[B_+0], P[B_+1]), a1 = cvtpk(P[B_+2], P[B_+3]);                          \
        unsigned b0 = cvtpk(P[B_+4], P[B_+5]), b1 = cvtpk(P[B_+6], P[B_+7]);                                             \
        auto r0 = __builtin_amdgcn_permlane32_swap(a0, b0, false, false); auto r1 = __builtin_amdgcn_permlane32_swap(a1, b1, false, false); \
        u32x4 w = {r0[0], r1[0], r0[1], r1[1]}; OUT = *reinterpret_cast<bf16x8*>(&w); } while (0)
    PK4(p0, 0, pa0); PK4(p0, 8, pa1); PK4(p1, 0, pa2); PK4(p1, 8, pa3);
#undef PK4
}
template <int KB, bool SK>
__device__ __forceinline__ void qkt(f32x16& p0, f32x16& p1, const char* K_lds, int r32, int hi, const bf16x8* qr, bool act) {
    if (SK && !act) { const float NEG = -__builtin_inff();
#pragma unroll
        for (int r = 0; r < 16; ++r) { p0[r] = NEG; p1[r] = NEG; } return; }
    p0 = f32x16{}; p1 = f32x16{};
    const char* kb[4];
#pragma unroll
    for (int dd = 0; dd < 4; ++dd) kb[dd] = K_lds + KB * SHM_K + KSWZ(r32, (dd * 16 + hi * 8) * 2);
#pragma unroll
    for (int d0 = 0; d0 < 4; ++d0) { const char* a = kb[d0];
        bf16x8 b0 = *reinterpret_cast<const bf16x8*>(a);
        bf16x8 b1 = *reinterpret_cast<const bf16x8*>(a + 32 * 128);
        p0 = __builtin_amdgcn_mfma_f32_32x32x16_bf16(b0, qr[d0], p0, 0, 0, 0);
        p1 = __builtin_amdgcn_mfma_f32_32x32x16_bf16(b1, qr[d0], p1, 0, 0, 0); }
}
typedef __attribute__((address_space(3))) const char* lds_cptr;
typedef short v4i16_t __attribute__((ext_vector_type(4)));
__device__ __forceinline__ s16x4 vtr(lds_cptr p) { return __builtin_bit_cast(s16x4, __builtin_amdgcn_ds_read_tr16_b64_v4i16((__attribute__((address_space(3))) v4i16_t*)p)); }
template <int VB, bool SK>
__device__ __forceinline__ void pv_tile(f32x16* o, lds_cptr vp, bf16x8 pa0, bf16x8 pa1, bf16x8 pa2, bf16x8 pa3, bool act) {
    if (SK && !act) return;
    s16x4 fa[8], fb[8];
#define PV_RD(F, d0) do { _Pragma("unroll") for (int ks = 0; ks < 4; ++ks) { F[2 * ks] = vtr(vp + (VB * SHM_V + (d0) * 512 + ks * 4096)); F[2 * ks + 1] = vtr(vp + (VB * SHM_V + (d0) * 512 + ks * 4096 + 2048)); } } while (0)
#define PV_FR(F, k) (bf16x8){F[2 * (k)][0], F[2 * (k)][1], F[2 * (k)][2], F[2 * (k)][3], F[2 * (k) + 1][0], F[2 * (k) + 1][1], F[2 * (k) + 1][2], F[2 * (k) + 1][3]}
#define PV_MF(O, F) do { O = __builtin_amdgcn_mfma_f32_32x32x16_bf16(pa0, PV_FR(F, 0), O, 0, 0, 0); O = __builtin_amdgcn_mfma_f32_32x32x16_bf16(pa1, PV_FR(F, 1), O, 0, 0, 0); \
                         O = __builtin_amdgcn_mfma_f32_32x32x16_bf16(pa2, PV_FR(F, 2), O, 0, 0, 0); O = __builtin_amdgcn_mfma_f32_32x32x16_bf16(pa3, PV_FR(F, 3), O, 0, 0, 0); } while (0)
    PV_RD(fa, 0); SBAR(); PV_RD(fb, 1); SBAR();
    PV_MF(o[0], fa); SBAR(); PV_RD(fa, 2); SBAR();
    PV_MF(o[1], fb); SBAR(); PV_RD(fb, 3); SBAR();
    PV_MF(o[2], fa); SBAR();
    PV_MF(o[3], fb);
#undef PV_RD
#undef PV_FR
#undef PV_MF
}

template <class TIn, class TOut> struct BlockRef { const TIn* Q; const TIn* K; const TIn* V; TOut* O; int P0; };
template <class TIn> struct Seam {
    bf16x8 qr[4];
    bf16x8 st_v0, st_v1, st_k0;
    bf16x8 sb_v0, sb_v1, sb_k0;
};
__device__ __forceinline__ int swa_jlo(int P0, int W) { const int lowk = P0 - W + 1; return lowk > 0 ? lowk / KVBLK : 0; }
#define ROW(p, k0, rr) ((p) + (size_t)((k0) + (rr)) * ZPITCH + sc)
#define ROWK(p, k0) ((p) + (size_t)((k0) + ksr) * ZPITCH + ksc)
#define VMW() asm volatile("s_waitcnt vmcnt(0)" ::: "memory")
#define VMWN(n) asm volatile("s_waitcnt vmcnt(%0)" :: "i"(n) : "memory")
#define SLOAD_H(Kp, Vp, k0) do { S.st_v0 = load8<TIn>(ROW(Vp, k0, sr)); S.st_v1 = load8<TIn>(ROW(Vp, k0, 32 + sr));              \
                         S.st_k0 = load8<TIn>(ROWK(Kp, k0)); } while (0)
#define SWRITE_HK(bf) do { *(bf16x8*)(K_lds + (bf) * SHM_K + kws) = S.st_k0; } while (0)
#define SWRITE_HV(bf) do { *(bf16x8*)(V_lds + (bf) * SHM_V + vst0) = S.st_v0; *(bf16x8*)(V_lds + (bf) * SHM_V + vst1) = S.st_v1; } while (0)
#define SWRITE_H(bf) do { SWRITE_HV(bf); SWRITE_HK(bf); } while (0)
#define SLOAD_HB(Kp, Vp, k0) do { S.sb_v0 = load8<TIn>(ROW(Vp, k0, sr)); S.sb_v1 = load8<TIn>(ROW(Vp, k0, 32 + sr)); S.sb_k0 = load8<TIn>(ROWK(Kp, k0)); } while (0)
#define SWRITE_HB(bf) do { *(bf16x8*)(V_lds + (bf) * SHM_V + vst0) = S.sb_v0; *(bf16x8*)(V_lds + (bf) * SHM_V + vst1) = S.sb_v1; *(bf16x8*)(K_lds + (bf) * SHM_K + kws) = S.sb_k0; } while (0)
template <class TIn, class TOut>
__device__ __forceinline__ void causal_swa_prime(const BlockRef<TIn, TOut>& cur, const float* btab_hm, char* lds, Seam<TIn>& S) {
    int tid_ = threadIdx.x; asm volatile("" : "+v"(tid_)); const int tid = tid_, wid = __builtin_amdgcn_readfirstlane(tid >> 6), lane = tid & 63, r32 = lane & 31, hi = lane >> 5;
    const int sr = tid >> 4, sc = (tid & 15) * 8, ksr = tid >> 3, ksc = (tid & 7) * 8, kws = KSWZ(ksr, ksc * 2); char* K_lds = lds + 2 * SHM_V;
    const int kb0 = 0;
    if (tid < 384) ((__attribute__((address_space(3))) float*)((__attribute__((address_space(3))) char*)lds + LDS_BT))[tid] = btab_hm[tid];
    for (int d0 = 0; d0 < 4; ++d0) S.qr[d0] = load8<TIn>(cur.Q + (size_t)(wid * QBLK + r32) * ZPITCH + d0 * 16 + hi * 8);
    SLOAD_H(cur.K, cur.V, kb0); VMW(); SWRITE_HK(0);
    __syncthreads();
}
template <class TIn, class TOut>
__device__ __forceinline__ void causal_swa_block(const BlockRef<TIn, TOut>& cur, const BlockRef<TIn, TOut>& nxt, int skv, char* lds, Seam<TIn>& S) {
    int tid_ = threadIdx.x; asm volatile("" : "+v"(tid_)); const int tid = tid_, wid = __builtin_amdgcn_readfirstlane(tid >> 6), lane = tid & 63, r32 = lane & 31, hi = lane >> 5;
    const int j_lo = 0;
    int j_hi = (cur.P0 + QB - 1) / KVBLK + 1; if (j_hi > skv / KVBLK) j_hi = skv / KVBLK;
    const int NT = j_hi - j_lo;
    const int kbn = 0;
    const int qlo = cur.P0 + wid * QBLK, qm = qlo + r32 - 4 * hi;
    char* V_lds = lds; char* K_lds = lds + 2 * SHM_V;
    float* ws = (float*)(lds + 2 * SHM_V + 2 * SHM_K) + wid * 64; float* li_l = ws, * al_l = ws + 32;
    const lds_cfptr btl = (lds_cfptr)((__attribute__((address_space(3))) const char*)lds + LDS_BT);
    float m_reg = -1e30f, l_reg = 0; f32x16 o[4] = {};
    const int sr = tid >> 4, sc = (tid & 15) * 8, vst0 = v_st(sr, sc), vst1 = v_st(32 + sr, sc);
    const int ksr = tid >> 3, ksc = (tid & 7) * 8, kws = KSWZ(ksr, ksc * 2);
    const lds_cptr vb0 = (lds_cptr)V_lds + v_rd_base(lane);
    const TIn* Kh = cur.K; const TIn* Vh = cur.V;
#define RESC(a) do { if (__any((a) < 1.f)) { if (hi == 0) al_l[r32] = (a); asm volatile("s_waitcnt lgkmcnt(0)" ::: "memory");              \
                     for (int d_ = 0; d_ < 4; ++d_) for (int r = 0; r < 16; ++r) o[d_][r] *= al_l[crow(r, hi)]; } } while (0)
#define KBASE(t) ((j_lo + (t)) * KVBLK)
#define ACT(t) true
#define MASKT(P0_, P1_, t) do { const int kb_ = KBASE(t); if (kb_ + KVBLK - 1 > qlo - 113) mask_tile(P0_, P1_, qm - kb_, btl); } while (0)
    constexpr int NQL = 4;
    constexpr bool SK = false;
#define SEAM_K0() do { VMWN(NQL); SWRITE_HK(0); SBAR(); } while (0)
    f32x16 pA0, pA1, pB0, pB1; float mnA, mnB, alA, alB; bf16x8 pa0, pa1, pa2, pa3;
    SWRITE_HV(0); SBAR();
    if (NT > 1) { SLOAD_H(Kh, Vh, KBASE(1)); SBAR(); if (NT > 2) { SLOAD_HB(Kh, Vh, KBASE(2)); } }
    SBAR(); qkt<0, SK>(pA0, pA1, K_lds, r32, hi, S.qr, ACT(0));
    MASKT(pA0, pA1, 0); partialSM(pA0, pA1, m_reg, mnA, alA);
    if (NT > 1) { if (NT > 2) { VMWN(3); } else { VMW(); } SWRITE_H(1); }
    __syncthreads();
#define HALF_STEP(PX0, PX1, mnX, alX, PY0, PY1, alY, t, KB, VB, SB, LD2, WR1) do {                                            \
        SBAR(); qkt<KB, SK>(PX0, PX1, K_lds, r32, hi, S.qr, ACT(t));                                             \
        finishSM(PY0, PY1, alY, l_reg, pa0, pa1, pa2, pa3); SBAR();                                                           \
        if ((t) + 2 < NT) { LD2(Kh, Vh, KBASE((t) + 2)); SBAR(); }                                                            \
        pv_tile<VB, SK>(o, vb0, pa0, pa1, pa2, pa3, ACT((t) - 1)); MASKT(PX0, PX1, (t)); partialSM(PX0, PX1, m_reg, mnX, alX);                                        \
        __syncthreads();                                                                                                      \
        if ((t) + 1 < NT) { if ((t) + 2 < NT) { VMWN(3); } else { VMW(); } WR1(SB); }                                          \
        RESC(alX); __syncthreads(); } while (0)
    for (int t = 1; t + 1 < NT; t += 2) {
        HALF_STEP(pB0, pB1, mnB, alB, pA0, pA1, alA, t, 1, 0, 0, SLOAD_H, SWRITE_HB);
        HALF_STEP(pA0, pA1, mnA, alA, pB0, pB1, alB, t + 1, 0, 1, 1, SLOAD_HB, SWRITE_H);
    }
    const bool even = (NT & 1) == 0;
    if (even) { SBAR(); qkt<1, SK>(pB0, pB1, K_lds, r32, hi, S.qr, ACT(NT - 1)); SBAR(); }
    { SLOAD_H(nxt.K, nxt.V, kbn); SBAR();
#pragma unroll
        for (int d0 = 0; d0 < 4; ++d0) S.qr[d0] = load8<TIn>(nxt.Q + (size_t)(wid * QBLK + r32) * ZPITCH + d0 * 16 + hi * 8); }
    SBAR();
    finishSM(pA0, pA1, alA, l_reg, pa0, pa1, pa2, pa3); SBAR();
    pv_tile<0, SK>(o, vb0, pa0, pa1, pa2, pa3, ACT(even ? NT - 2 : NT - 1));
    if (even) { MASKT(pB0, pB1, NT - 1); partialSM(pB0, pB1, m_reg, mnB, alB); __syncthreads(); RESC(alB);
        finishSM(pB0, pB1, alB, l_reg, pa0, pa1, pa2, pa3); SBAR(); pv_tile<1, SK>(o, vb0, pa0, pa1, pa2, pa3, ACT(NT - 1)); }
    SBAR(); SEAM_K0();
    if (hi == 0) li_l[r32] = l_reg; asm volatile("s_waitcnt lgkmcnt(0)" ::: "memory");
    float rli[16];
#pragma unroll
    for (int r = 0; r < 16; ++r) rli[r] = __builtin_amdgcn_rcpf(li_l[crow(r, hi)]);
    TOut* Ow = cur.O + (size_t)(wid * QBLK) * OPITCH;
#pragma unroll
    for (int r = 0; r < 16; ++r) { const int orow = crow(r, hi);
#pragma unroll
        for (int d0 = 0; d0 < 4; ++d0) { const float v = o[d0][r] * rli[r];
            const float vn = __shfl_xor(v, 1);
            if ((r32 & 1) == 0) *(unsigned*)(Ow + (size_t)orow * OPITCH + d0 * 32 + r32) = cvtpk(v, vn); } }
    __syncthreads();
#undef RESC
#undef KBASE
#undef ACT
#undef MASKT
#undef SEAM_K0
#undef HALF_STEP
}
#undef ROW
#undef ROWK
#undef VMW
#undef VMWN
#undef SLOAD_H
#undef SWRITE_HK
#undef SWRITE_HV
#undef SWRITE_H
#undef SLOAD_HB
#undef SWRITE_HB


__device__ __forceinline__ BlockRef<bf16, bf16> unit_ref(const bf16* Z, bf16* OB, int b, int hm, int qb) {
    BlockRef<bf16, bf16> r; const size_t row0 = (size_t)b * 4096;
    r.Q = Z + (row0 + (size_t)qb * QB) * ZPITCH + hm * DK; r.K = Z + row0 * ZPITCH + 512 + hm * DK; r.V = Z + row0 * ZPITCH + 1024 + (hm >> 1) * D;
    r.O = OB + (row0 + (size_t)qb * QB) * OPITCH + hm * D; r.P0 = qb * QB; return r;
}
__device__ __forceinline__ void attn_swa_phase(const bf16* Z, bf16* OB, const float* btab, char* lds, int G) {
    const int bx = blockIdx.x; const int vcu = (G % 8 == 0) ? (bx % 8) * (G / 8) + bx / 8 : bx;
    for (int L = vcu; L < 256; L += G) {
        const int bh = L >> 3, x = L & 7, b = bh >> 3, hm = bh & 7;
        const BlockRef<bf16, bf16> first = unit_ref(Z, OB, b, hm, 15 - x), second = unit_ref(Z, OB, b, hm, x);
        Seam<bf16> S;
        causal_swa_prime<bf16, bf16>(first, btab + hm * 384, lds, S);
        causal_swa_block<bf16, bf16>(first, second, 4096, lds, S);
        causal_swa_block<bf16, bf16>(second, second, 4096, lds, S);
    }
}

}
#ifndef PROBE_REP_MASK
#define PROBE_REP_MASK 0
#endif
#ifndef PROBE_EXTRA_SYNC
#define PROBE_EXTRA_SYNC 0
#endif
#ifndef PG8_ALIGN_MULTI
#define PG8_ALIGN_MULTI true
#endif
#ifndef HIDE_CONV
#define HIDE_CONV 1
#endif
#ifndef RES_BF16
#define RES_BF16 1
#endif
#ifndef USE_CG_SYNC
#define USE_CG_SYNC 0
#endif
#ifndef USE_ATTN128
#define USE_ATTN128 1
#endif
#ifndef USE_SWA_ATTN
#define USE_SWA_ATTN 1
#endif
#ifndef USE_NAIVE_ATTN
#define USE_NAIVE_ATTN 0
#endif
constexpr int NWAVES = 8, NTHR = 512;
constexpr int BATCH = 4, SEQ = 4096, DM = 1024, DEPTH = 4, DFF = 2816, INW = 2816, MTOK = BATCH * SEQ;
constexpr int ZP = 2816;
constexpr int ZQ = 0, ZK = 512, ZV = 1024, ZSB = 1536, ZSC = 1792, ZSX = 2048, ZLX = 2304, ZLG = 2560;
constexpr float LOG2E = 1.4426950408889634f;
constexpr float QSCALE = 0.125f * LOG2E;
constexpr int NCH = 64;

constexpr size_t MiB = 1u << 20;
constexpr size_t WS_LAM = 0;
constexpr size_t WS_BTAB = 4096;
constexpr size_t WS_PTOT = 64 * 1024;
constexpr size_t WS_HTOT = 320 * 1024;
constexpr size_t WS_SS = 640 * 1024;
constexpr size_t WS_BAR = 1 * MiB, BAR_BYTES = 16384;
constexpr size_t WS_W = 2 * MiB;
constexpr size_t WL_1C = 0, WL_1D = 11 * MiB, WL_IN = WL_1D + 11 * MiB / 2, WL_2C = WL_IN + 11 * MiB / 2, WL_2D = WL_2C + 11 * MiB, WL_OUT = WL_2D + 11 * MiB / 2, WL_STRIDE = WL_OUT + 2 * MiB;
static_assert(WL_STRIDE == 40 * MiB + MiB / 2, "layer weight stride");
constexpr size_t WS_XB = 164 * MiB, WS_ACT = 196 * MiB, WS_OB = 284 * MiB, WS_Y = 316 * MiB, WS_HL = 348 * MiB, WS_PL = 364 * MiB, WS_END = 380 * MiB;
static_assert(WS_W + 4 * WL_STRIDE <= WS_XB, "weights fit");

constexpr int RING_BYTES = 131072, LDS_BYTES = 147456, LDSCTL_OFF = LDS_BYTES - 256, MISC_OFF = LDSCTL_OFF + 64;

#define LAS __attribute__((address_space(3)))
typedef unsigned short bf16;
typedef unsigned v4u __attribute__((ext_vector_type(4)));
typedef unsigned v2u __attribute__((ext_vector_type(2)));
typedef float f32x4 __attribute__((ext_vector_type(4)));

__device__ __forceinline__ unsigned f2bf(float f) { unsigned u = __builtin_bit_cast(unsigned, f); return (u + 0x7fffu + ((u >> 16) & 1u)) >> 16; }
__device__ __forceinline__ unsigned pk2(float lo, float hi) { return f2bf(lo) | (f2bf(hi) << 16); }
__device__ __forceinline__ float bf2f(unsigned short b) { return __builtin_bit_cast(float, (unsigned)b << 16); }
__device__ __forceinline__ float bflo(unsigned w) { return __builtin_bit_cast(float, w << 16); }
__device__ __forceinline__ float bfhi(unsigned w) { return __builtin_bit_cast(float, w & 0xffff0000u); }
__device__ __forceinline__ float wave_sum(float v) {
#pragma unroll
    for (int o = 1; o < 64; o <<= 1) v += shx(v, o);
    return v;
}

#define XB_TMO      128
#define XB_XCNT(j)  (256  + 64 * (j))
#define XB_XSUB(j)  (1280 + 64 * (j))
#define XB_XGEN(j)  (2304 + 64 * (j))
#define XB_TOP      3328
#define XB_TOPGEN   3392
#define XCD_BAR_WORDS 3456
#define XB_SPIN_CAP (1u << 18)

__device__ __forceinline__ unsigned xb_ld(unsigned* p)              { return __hip_atomic_load(p, __ATOMIC_RELAXED, __HIP_MEMORY_SCOPE_AGENT); }
__device__ __forceinline__ unsigned xb_add(unsigned* p, unsigned v) { return __hip_atomic_fetch_add(p, v, __ATOMIC_RELAXED, __HIP_MEMORY_SCOPE_AGENT); }
__device__ __forceinline__ unsigned xb_xcc_id() { return (unsigned)__builtin_amdgcn_s_getreg((3 << 11) | 20) & 0xFu; }
#define XB_SPIN(cond, bar) do { unsigned _sp = 0; while (cond) { __builtin_amdgcn_s_sleep(1); \
    if ((++_sp & 255u) == 0u) { if (xb_ld(&(bar)[XB_TMO])) break; if (_sp > XB_SPIN_CAP) { atomicAdd(&(bar)[XB_TMO], 1u); break; } } } } while (0)

struct XcdBarrier {
    unsigned* bar; unsigned x;
    volatile LAS unsigned* st;
};

__device__ __forceinline__ XcdBarrier xcd_barrier_post(unsigned* bar, volatile LAS unsigned* st) {
    XcdBarrier b; b.bar = bar; b.x = xb_xcc_id(); b.st = st;
    if (threadIdx.x == 0) (void)xb_add(&bar[XB_XCNT(b.x)], 1u);
    return b;
}
__device__ __forceinline__ void xcd_barrier_complete(unsigned* bar, unsigned x, unsigned& nloc, unsigned& nx) {
    const unsigned G = gridDim.x * gridDim.y * gridDim.z;
    unsigned sum, cnt, mine, sp = 0u;
    for (;;) {
        sum = 0u; cnt = 0u; mine = 0u;
#pragma unroll
        for (unsigned j = 0; j < 16; ++j) { const unsigned c = xb_ld(&bar[XB_XCNT(j)]); sum += c; cnt += (c > 0u) ? 1u : 0u; mine = (j == x) ? c : mine; }
        if (sum == G) break;
        __builtin_amdgcn_s_sleep(1);
        if ((++sp & 255u) == 0u) { if (xb_ld(&bar[XB_TMO])) break; if (sp > XB_SPIN_CAP) { atomicAdd(&bar[XB_TMO], 1u); break; } }
    }
    nloc = mine > 0u ? mine : 1u; nx = cnt > 0u ? cnt : 1u;
}

__device__ __forceinline__ void xcd_barrier(const XcdBarrier& b) {
    asm volatile("s_waitcnt vmcnt(0)" ::: "memory");
    __syncthreads();
    if (threadIdx.x == 0) {
        unsigned* bar = b.bar;
        __builtin_amdgcn_s_waitcnt(0);
        unsigned nloc = b.st[0], nx = b.st[1];
        if (nloc == 0u) { xcd_barrier_complete(bar, b.x, nloc, nx); b.st[0] = nloc; b.st[1] = nx; }
        const unsigned old = xb_add(&bar[XB_XSUB(b.x)], 1u);
        const unsigned gen = old / nloc;
        if (old + 1u == (gen + 1u) * nloc) {
            __builtin_amdgcn_fence(__ATOMIC_RELEASE, "agent");
            asm volatile("s_waitcnt vmcnt(0)" ::: "memory");
            const unsigned og = xb_add(&bar[XB_TOP], 1u);
            const unsigned tg = og / nx;
            if (og + 1u == (tg + 1u) * nx) xb_add(&bar[XB_TOPGEN], 1u);
            else XB_SPIN(xb_ld(&bar[XB_TOPGEN]) == tg, bar);
            __builtin_amdgcn_fence(__ATOMIC_ACQUIRE, "agent");
            xb_add(&bar[XB_XGEN(b.x)], 1u);
            asm volatile("s_waitcnt vmcnt(0)" ::: "memory");
        } else {
            XB_SPIN(xb_ld(&bar[XB_XGEN(b.x)]) == gen, bar);
            __builtin_amdgcn_fence(__ATOMIC_ACQUIRE, "agent");
            asm volatile("s_waitcnt vmcnt(0)" ::: "memory");
        }
    }
    __syncthreads();
}

struct Args { const float* in[27]; float* out; unsigned char* ws; int ph_lo, ph_hi; };
typedef const __attribute__((address_space(4))) Args* ArgsP;
enum { I_X = 0, I_RELB, I_F1N, I_F1G, I_F1U, I_F1D, I_MIXN, I_WIN, I_WOUT, I_LQ1, I_LK1, I_LQ2, I_LK2, I_SUBG, I_SCW, I_LCW, I_LCB, I_WA, I_BA, I_WX, I_BX, I_LLAM, I_F2N, I_F2G, I_F2U, I_F2D, I_FIN };

struct TrItem { const float* W; const float* gain; bf16* WT; int K, N, k0, n0, drow0; };
__device__ __forceinline__ bool tr_item(ArgsP a, int it, TrItem& t) {
    constexpr int IT_BIG = 704, IT_OUT = 256, IT_LAYER = 7 * IT_BIG + IT_OUT;
    if (it >= DEPTH * IT_LAYER) return false;
    const int l = it / IT_LAYER, r = it % IT_LAYER;
    unsigned char* wl = a->ws + WS_W + (size_t)l * WL_STRIDE;
    const size_t wofs = (size_t)l * DM * DFF;
    int mode = 0, ii; t.gain = nullptr; t.K = DM; t.N = DFF;
    if (r >= 7 * IT_BIG) { t.W = a->in[I_WOUT] + (size_t)l * DM * DM; t.N = DM; t.WT = (bf16*)(wl + WL_OUT); ii = r - 7 * IT_BIG; }
    else {
        const int mat = r / IT_BIG; ii = r % IT_BIG;
        if (mat == 0)      { t.W = a->in[I_F1G] + wofs; t.gain = a->in[I_F1N] + l * DM; t.WT = (bf16*)(wl + WL_1C); mode = 1; }
        else if (mat == 1) { t.W = a->in[I_F1U] + wofs; t.gain = a->in[I_F1N] + l * DM; t.WT = (bf16*)(wl + WL_1C); mode = 2; }
        else if (mat == 2) { t.W = a->in[I_F1D] + wofs; t.K = DFF; t.N = DM; t.WT = (bf16*)(wl + WL_1D); }
        else if (mat == 3) { t.W = a->in[I_WIN] + wofs; t.gain = a->in[I_MIXN] + l * DM; t.WT = (bf16*)(wl + WL_IN); }
        else if (mat == 4) { t.W = a->in[I_F2G] + wofs; t.gain = a->in[I_F2N] + l * DM; t.WT = (bf16*)(wl + WL_2C); mode = 1; }
        else if (mat == 5) { t.W = a->in[I_F2U] + wofs; t.gain = a->in[I_F2N] + l * DM; t.WT = (bf16*)(wl + WL_2C); mode = 2; }
        else               { t.W = a->in[I_F2D] + wofs; t.K = DFF; t.N = DM; t.WT = (bf16*)(wl + WL_2D); }
    }
    const int nblk = t.N / 64, kb = ii / nblk, nb = ii % nblk; t.k0 = 64 * kb; t.n0 = 64 * nb;
    t.drow0 = (mode == 0) ? t.n0 : ((t.n0 >> 7) * 256 + (t.n0 & 127) + (mode == 2 ? 128 : 0));
    return true;
}

__device__ __forceinline__ void convert_items(ArgsP a, LAS unsigned char* lds, int it0, int it1, int w, int nw) {
    asm volatile("" : "+s"(a));
    int tid_ = threadIdx.x; asm volatile("" : "+v"(tid_)); const int tid = tid_, lane = tid & 63, wave = __builtin_amdgcn_readfirstlane(tid >> 6);
    LAS float* scr = (LAS float*)(lds + wave * 16640);
    static_assert(8 * 16640 <= LDSCTL_OFF, "conversion tiles vs LDS control words");
    TrItem cur, nxt; float v[64];
    int it = it0 + w;
    bool have = (it < it1) && tr_item(a, it, cur);
    if (have) {
#pragma unroll
        for (int i = 0; i < 64; ++i) v[i] = __builtin_nontemporal_load(cur.W + (size_t)(cur.k0 + i) * cur.N + cur.n0 + lane);
    }
    for (; have; it += nw) {
        if (cur.gain) {
#pragma unroll
            for (int i = 0; i < 64; ++i) scr[i * 65 + lane] = v[i] * cur.gain[cur.k0 + i];
        } else {
#pragma unroll
            for (int i = 0; i < 64; ++i) scr[i * 65 + lane] = v[i];
        }
        const bool hn = (it + nw < it1) && tr_item(a, it + nw, nxt);
        if (hn) {
#pragma unroll
            for (int i = 0; i < 64; ++i) v[i] = __builtin_nontemporal_load(nxt.W + (size_t)(nxt.k0 + i) * nxt.N + nxt.n0 + lane);
        }
        asm volatile("s_waitcnt lgkmcnt(0)" ::: "memory");
        const int c = lane & 7;
#pragma unroll
        for (int j = 0; j < 8; ++j) { const int n = (lane >> 3) + 8 * j; const LAS float* s = scr + (8 * c) * 65 + n;
            v4u o; o.x = pg8::cvt_pk_bf16(s[0 * 65], s[1 * 65]); o.y = pg8::cvt_pk_bf16(s[2 * 65], s[3 * 65]); o.z = pg8::cvt_pk_bf16(s[4 * 65], s[5 * 65]); o.w = pg8::cvt_pk_bf16(s[6 * 65], s[7 * 65]);
            *(v4u*)(cur.WT + (size_t)(cur.drow0 + n) * cur.K + cur.k0 + 8 * c) = o; }
        asm volatile("s_waitcnt lgkmcnt(0)" ::: "memory");
        cur = nxt; have = hn;
    }
}
constexpr int CONV_ITEMS_LAYER = 7 * 704 + 256;

__device__ __forceinline__ void prologue_phase(ArgsP a, LAS unsigned char* lds, int G) {
    asm volatile("" : "+s"(a));
    int tid_ = threadIdx.x; asm volatile("" : "+v"(tid_)); const int tid = tid_, lane = tid & 63, wave = __builtin_amdgcn_readfirstlane(tid >> 6);
    const int gw = blockIdx.x * NWAVES + wave, NGW = G * NWAVES;
    unsigned char* ws = a->ws;
    convert_items(a, lds, 0, (HIDE_CONV ? 1 : DEPTH) * CONV_ITEMS_LAYER, gw, NGW);
    const float* x = a->in[I_X]; bf16* XB = (bf16*)(ws + WS_XB); float* SS = (float*)(ws + WS_SS);
    for (int m = gw; m < MTOK; m += NGW) {
        const f32x4* xr = (const f32x4*)(x + (size_t)m * DM) + lane; float s = 0.f;
        unsigned long long* o8 = (unsigned long long*)(XB + (size_t)m * DM) + lane;
#pragma unroll
        for (int j = 0; j < 4; ++j) { const f32x4 v = xr[64 * j]; s += (v[0] * v[0] + v[1] * v[1]) + (v[2] * v[2] + v[3] * v[3]);
            o8[64 * j] = (unsigned long long)pk2(v[0], v[1]) | ((unsigned long long)pk2(v[2], v[3]) << 32); }
        s = wave_sum(s);
        if (lane < 4) SS[(size_t)m * 4 + lane] = (lane == 0) ? s : 0.f;
    }
    if (blockIdx.x == 0) {
        float* btab = (float*)(ws + WS_BTAB); const float* rb = a->in[I_RELB];
        for (int i = tid; i < 8 * 384; i += NTHR) { const int hm = i / 384, d = i % 384;
            int bk; if (d < 16) bk = d; else { bk = 16 + (int)(logf((float)d / 16.0f) / logf(8.0f) * 16.0f); bk = bk < 31 ? bk : 31; }
            btab[i] = (rb[bk * 8 + hm] - rb[31 * 8 + hm]) * LOG2E; }
        if (wave < DEPTH) { const int l = wave;
            const float s1 = wave_sum(a->in[I_LQ1][l * 64 + lane] * a->in[I_LK1][l * 64 + lane]);
            const float s2 = wave_sum(a->in[I_LQ2][l * 64 + lane] * a->in[I_LK2][l * 64 + lane]);
            const float lam_init = 0.8f - 0.6f * expf(-0.3f * (float)l);
            if (lane == 0) ((float*)(ws + WS_LAM))[l] = expf(s1) - expf(s2) + lam_init; }
    }
}

__device__ __forceinline__ void lru_local_phase(ArgsP a, LAS unsigned char* lds, int G, int l) {
    asm volatile("" : "+s"(a));
    int tid_ = threadIdx.x; asm volatile("" : "+v"(tid_)); const int tid = tid_, j = tid & 255, tg = tid >> 8, n = j >> 6, jj = j & 63;
    unsigned char* ws = a->ws;
    const bf16* Z = (const bf16*)(ws + WS_ACT);
    float* HL = (float*)(ws + WS_HL); float* PL = (float*)(ws + WS_PL); float* PT = (float*)(ws + WS_PTOT); float* HT = (float*)(ws + WS_HTOT);
    constexpr int XP = 264;
    LAS unsigned short* XH = (LAS unsigned short*)lds;
    LAS float* S0 = (LAS float*)(lds + 64 * XP * 2);
    const float* cw = a->in[I_LCW] + l * 4 * 256; const float cb = a->in[I_LCB][l * 256 + j];
    const float w0 = cw[j], w1 = cw[256 + j], w2 = cw[512 + j], w3 = cw[768 + j];
    const float* wa = a->in[I_WA] + ((size_t)l * 4 + n) * 4096 + jj; const float* wx = a->in[I_WX] + ((size_t)l * 4 + n) * 4096 + jj;
    const float ba = a->in[I_BA][l * 256 + j], bx = a->in[I_BX][l * 256 + j];
    const float lam = a->in[I_LLAM][l * 256 + j];
    const float sp8 = -8.0f * log1pf(expf(-lam));
    for (int it = blockIdx.x; it < BATCH * NCH; it += G) {
        const int b = it / NCH, c = it % NCH; const int t0 = c * 64 + tg * 32;
        const bf16* zx = Z + ((size_t)b * SEQ) * ZP + ZLX + j;
        __syncthreads();
        float xr[32];
        {
            float xm3 = (t0 >= 3) ? bf2f(zx[(size_t)(t0 - 3) * ZP]) : 0.f, xm2 = (t0 >= 2) ? bf2f(zx[(size_t)(t0 - 2) * ZP]) : 0.f, xm1 = (t0 >= 1) ? bf2f(zx[(size_t)(t0 - 1) * ZP]) : 0.f;
#pragma unroll
            for (int t = 0; t < 32; ++t) { const float x0 = bf2f(zx[(size_t)(t0 + t) * ZP]); xr[t] = cb + w0 * xm3 + w1 * xm2 + w2 * xm1 + w3 * x0; xm3 = xm2; xm2 = xm1; xm1 = x0; }
#pragma unroll
            for (int t = 0; t < 32; ++t) XH[(tg * 32 + t) * XP + j] = (unsigned short)f2bf(xr[t]);
        }
        __syncthreads();
        float ar[32], ai[32];
        {
            typedef float f32x16_t __attribute__((ext_vector_type(16))); typedef short bf16x8_t __attribute__((ext_vector_type(8)));
            const int lane = tid & 63, c = lane & 31, hi = lane >> 5;
            f32x16_t aR[2], aI[2];
#pragma unroll
            for (int cb2 = 0; cb2 < 2; ++cb2) { const float b0 = a->in[I_BA][l * 256 + n * 64 + cb2 * 32 + c], b1 = a->in[I_BX][l * 256 + n * 64 + cb2 * 32 + c];
#pragma unroll
                for (int r = 0; r < 16; ++r) { aR[cb2][r] = b0; aI[cb2][r] = b1; } }
            const float* wan = a->in[I_WA] + ((size_t)l * 4 + n) * 4096; const float* wxn = a->in[I_WX] + ((size_t)l * 4 + n) * 4096;
#pragma unroll
            for (int ks = 0; ks < 4; ++ks) {
                const bf16x8_t af = *(const LAS bf16x8_t*)(XH + (tg * 32 + c) * XP + n * 64 + ks * 16 + hi * 8);
#pragma unroll
                for (int cb2 = 0; cb2 < 2; ++cb2) {
                    const float* wp = wan + (ks * 16 + hi * 8) * 64 + cb2 * 32 + c; const float* xp = wxn + (ks * 16 + hi * 8) * 64 + cb2 * 32 + c;
                    v4u fa, fx;
                    fa.x = pk2(wp[0], wp[64]); fa.y = pk2(wp[128], wp[192]); fa.z = pk2(wp[256], wp[320]); fa.w = pk2(wp[384], wp[448]);
                    fx.x = pk2(xp[0], xp[64]); fx.y = pk2(xp[128], xp[192]); fx.z = pk2(xp[256], xp[320]); fx.w = pk2(xp[384], xp[448]);
                    aR[cb2] = __builtin_amdgcn_mfma_f32_32x32x16_bf16(af, __builtin_bit_cast(bf16x8_t, fa), aR[cb2], 0, 0, 0);
                    aI[cb2] = __builtin_amdgcn_mfma_f32_32x32x16_bf16(af, __builtin_bit_cast(bf16x8_t, fx), aI[cb2], 0, 0, 0);
                }
            }
#pragma unroll
            for (int r = 0; r < 16; ++r) {
                const auto sr = __builtin_amdgcn_permlane32_swap(__float_as_uint(aR[0][r]), __float_as_uint(aR[1][r]), false, false);
                const auto si = __builtin_amdgcn_permlane32_swap(__float_as_uint(aI[0][r]), __float_as_uint(aI[1][r]), false, false);
                const int tlo = (r & 3) + 8 * (r >> 2);
                ar[tlo] = __uint_as_float(sr[0]); ar[tlo + 4] = __uint_as_float(sr[1]);
                ai[tlo] = __uint_as_float(si[0]); ai[tlo + 4] = __uint_as_float(si[1]);
            }
        }
        float h = 0.f, P = 1.f;
#pragma unroll
        for (int t = 0; t < 32; ++t) {
            const float r = __builtin_amdgcn_rcpf(1.0f + __builtin_amdgcn_exp2f(-LOG2E * ar[t])), ig = __builtin_amdgcn_rcpf(1.0f + __builtin_amdgcn_exp2f(-LOG2E * ai[t]));
            const float log_a = sp8 * r; const float av = __builtin_amdgcn_exp2f(LOG2E * log_a);
            const float z = 2.0f * log_a;
            const float em1 = z * (1.0f + z * (0.5f + z * ((1.0f / 6.0f) + z * ((1.0f / 24.0f) + z * ((1.0f / 120.0f) + z * ((1.0f / 720.0f) + z * (1.0f / 5040.0f)))))));
            const float mult = __builtin_amdgcn_sqrtf(-em1);
            const float bv = mult * (ig * xr[t]);
            h = av * h + bv; P = P * av; ar[t] = P; ai[t] = h;
        }
        if (tg == 0) { S0[j * 2] = P; S0[j * 2 + 1] = h; }
        __syncthreads();
        if (tg == 1) { const float P0 = S0[j * 2], H0 = S0[j * 2 + 1];
#pragma unroll
            for (int t = 0; t < 32; ++t) { ai[t] += ar[t] * H0; ar[t] *= P0; }
            PT[((size_t)b * NCH + c) * 256 + j] = ar[31]; HT[((size_t)b * NCH + c) * 256 + j] = ai[31]; }
        const size_t g0 = ((size_t)b * SEQ + t0) * 256 + j;
#pragma unroll
        for (int t = 0; t < 32; ++t) { HL[g0 + (size_t)t * 256] = ai[t]; PL[g0 + (size_t)t * 256] = ar[t]; }
    }
    __syncthreads();
}

__device__ __forceinline__ void attn_naive_phase(ArgsP a, LAS unsigned char* lds, int G) {
    asm volatile("" : "+s"(a));
    int tid_ = threadIdx.x; asm volatile("" : "+v"(tid_)); const int tid = tid_, i = tid >> 3, s = tid & 7;
    unsigned char* ws = a->ws;
    const bf16* Z = (const bf16*)(ws + WS_ACT); bf16* OB = (bf16*)(ws + WS_OB); const float* btab = (const float*)(ws + WS_BTAB);
    LAS float* Ks = (LAS float*)lds;
    LAS float* Vs = Ks + 64 * 65;
    LAS float* Ps = Vs + 64 * 128;
    LAS float* bt = Ps + 64 * 65;
    for (int u = blockIdx.x; u < 2048; u += G) {
        const int bhm = u & 31, cgp = (u >> 5) & 7, rnd = u >> 8; const int qb = 8 * rnd + ((rnd & 1) ? 7 - cgp : cgp);
        const int b = bhm >> 3, hm = bhm & 7, h = hm >> 1; const int q0 = qb * 64;
        __syncthreads();
        if (tid < 384) bt[tid] = btab[hm * 384 + tid];
        float q[64];
        { const v4u* qp = (const v4u*)(Z + ((size_t)b * SEQ + q0 + i) * ZP + ZQ + hm * 64);
#pragma unroll
          for (int c = 0; c < 8; ++c) { const v4u w = qp[c]; q[c * 8] = bflo(w.x); q[c * 8 + 1] = bfhi(w.x); q[c * 8 + 2] = bflo(w.y); q[c * 8 + 3] = bfhi(w.y); q[c * 8 + 4] = bflo(w.z); q[c * 8 + 5] = bfhi(w.z); q[c * 8 + 6] = bflo(w.w); q[c * 8 + 7] = bfhi(w.w); } }
        float o[16]; float mrun = -1e30f, lrun = 0.f;
#pragma unroll
        for (int e = 0; e < 16; ++e) o[e] = 0.f;
        for (int kt = 0; kt <= qb; ++kt) {
            __syncthreads();
            { const int key = tid >> 3, c8 = tid & 7; const bf16* zr = Z + ((size_t)b * SEQ + kt * 64 + key) * ZP;
              const v4u kw = *(const v4u*)(zr + ZK + hm * 64 + c8 * 8);
              LAS float* kd = Ks + key * 65 + c8 * 8;
              kd[0] = bflo(kw.x); kd[1] = bfhi(kw.x); kd[2] = bflo(kw.y); kd[3] = bfhi(kw.y); kd[4] = bflo(kw.z); kd[5] = bfhi(kw.z); kd[6] = bflo(kw.w); kd[7] = bfhi(kw.w);
              const v4u v0 = *(const v4u*)(zr + ZV + h * 128 + c8 * 16), v1 = *(const v4u*)(zr + ZV + h * 128 + c8 * 16 + 8);
              LAS float* vd = Vs + key * 128 + c8 * 16;
              *(LAS f32x4*)(vd) = (f32x4){bflo(v0.x), bfhi(v0.x), bflo(v0.y), bfhi(v0.y)}; *(LAS f32x4*)(vd + 4) = (f32x4){bflo(v0.z), bfhi(v0.z), bflo(v0.w), bfhi(v0.w)};
              *(LAS f32x4*)(vd + 8) = (f32x4){bflo(v1.x), bfhi(v1.x), bflo(v1.y), bfhi(v1.y)}; *(LAS f32x4*)(vd + 12) = (f32x4){bflo(v1.z), bfhi(v1.z), bflo(v1.w), bfhi(v1.w)}; }
            __syncthreads();
            float sc[8]; float mx = -1e30f;
#pragma unroll
            for (int kk = 0; kk < 8; ++kk) { const int key = s * 8 + kk; const LAS float* kp = Ks + key * 65; float d = 0.f;
#pragma unroll
                for (int e = 0; e < 64; ++e) d += q[e] * kp[e];
                const int dist = (q0 + i) - (kt * 64 + key); const int di = dist < 0 ? 0 : (dist > 383 ? 383 : dist);
                d += bt[di]; if (dist < 0) d = -1e30f; sc[kk] = d; mx = fmaxf(mx, d); }
            mx = fmaxf(mx, shx(mx, 1)); mx = fmaxf(mx, shx(mx, 2)); mx = fmaxf(mx, shx(mx, 4));
            const float mnew = fmaxf(mrun, mx); const float corr = __builtin_amdgcn_exp2f(mrun - mnew); mrun = mnew;
            float ps = 0.f;
#pragma unroll
            for (int kk = 0; kk < 8; ++kk) { const float p = __builtin_amdgcn_exp2f(sc[kk] - mnew); ps += p; Ps[i * 65 + s * 8 + kk] = p; }
            ps += shx(ps, 1); ps += shx(ps, 2); ps += shx(ps, 4);
            lrun = lrun * corr + ps;
#pragma unroll
            for (int e = 0; e < 16; ++e) o[e] *= corr;
            asm volatile("s_waitcnt lgkmcnt(0)" ::: "memory");
            for (int key = 0; key < 64; ++key) { const float p = Ps[i * 65 + key]; const LAS float* vp = Vs + key * 128 + s * 16;
#pragma unroll
                for (int e4 = 0; e4 < 4; ++e4) { const f32x4 vv = *(const LAS f32x4*)(vp + e4 * 4);
#pragma unroll
                    for (int e = 0; e < 4; ++e) o[e4 * 4 + e] += p * vv[e]; } }
        }
        const float rl = 1.0f / lrun;
        v4u w0, w1;
        w0.x = pk2(o[0] * rl, o[1] * rl); w0.y = pk2(o[2] * rl, o[3] * rl); w0.z = pk2(o[4] * rl, o[5] * rl); w0.w = pk2(o[6] * rl, o[7] * rl);
        w1.x = pk2(o[8] * rl, o[9] * rl); w1.y = pk2(o[10] * rl, o[11] * rl); w1.z = pk2(o[12] * rl, o[13] * rl); w1.w = pk2(o[14] * rl, o[15] * rl);
        bf16* op = OB + ((size_t)b * SEQ + q0 + i) * DM + hm * 128 + s * 16;
        *(v4u*)op = w0; *(v4u*)(op + 8) = w1;
    }
    __syncthreads();
}

__device__ __forceinline__ float gelu_tanh(float x) {
    const float u = 0.7978845608028654f * (x + 0.044715f * x * x * x);
    const float e = __builtin_amdgcn_exp2f(-2.0f * LOG2E * u);
    return x * __builtin_amdgcn_rcpf(1.0f + e);
}
__device__ __forceinline__ void finalize_phase(ArgsP a, LAS unsigned char* lds, int G, int l) {
    asm volatile("" : "+s"(a));
    int tid_ = threadIdx.x; asm volatile("" : "+v"(tid_)); const int tid = tid_, lane = tid & 63, wave = tid >> 6;
    unsigned char* ws = a->ws;
    const bf16* Z = (const bf16*)(ws + WS_ACT); const bf16* OB = (const bf16*)(ws + WS_OB); bf16* Y = (bf16*)(ws + WS_Y);
    const float* HL = (const float*)(ws + WS_HL); const float* PL = (const float*)(ws + WS_PL); const float* PT = (const float*)(ws + WS_PTOT); const float* HT = (const float*)(ws + WS_HTOT);
    LAS float* Hin = (LAS float*)lds;
    const float lam = ((const float*)(ws + WS_LAM))[l];
    const float lam_init = 0.8f - 0.6f * expf(-0.3f * (float)l);
    const float osc = 1.0f - lam_init;
    const int dh = (lane & 15) * 8;
    float sg[8];
#pragma unroll
    for (int e = 0; e < 8; ++e) sg[e] = a->in[I_SUBG][l * 128 + dh + e] * osc;
    const int ch = lane * 4;
    float scw[3][4];
#pragma unroll
    for (int k = 0; k < 3; ++k)
#pragma unroll
        for (int e = 0; e < 4; ++e) scw[k][e] = a->in[I_SCW][(l * 3 + k) * 256 + ch + e];
    for (int it = blockIdx.x; it < BATCH * NCH; it += G) {
        const int b = it / NCH, c = it % NCH;
        __syncthreads();
        {
            const int chn = tid & 255, hf = tid >> 8, cm = c >> 1, c_lo = hf ? cm : 0, c_hi = hf ? c : cm;
            float H = 0.f, Pp = 1.f; const float* pt = PT + (size_t)b * NCH * 256 + chn; const float* ht = HT + (size_t)b * NCH * 256 + chn;
            int cc = c_lo;
            for (; cc + 8 <= c_hi; cc += 8) { float p[8], h[8];
#pragma unroll
                for (int e = 0; e < 8; ++e) { p[e] = pt[(cc + e) * 256]; h[e] = ht[(cc + e) * 256]; }
#pragma unroll
                for (int e = 0; e < 8; ++e) { H = p[e] * H + h[e]; Pp *= p[e]; } }
            for (; cc < c_hi; ++cc) { const float p = pt[cc * 256], h = ht[cc * 256]; H = p * H + h; Pp *= p; }
            if (hf == 0) Hin[chn] = H;
            __syncthreads();
            if (hf == 1) Hin[chn] = Pp * Hin[chn] + H;
        }
        __syncthreads();
        const f32x4 hin = *(const LAS f32x4*)(Hin + ch);
        for (int r = wave; r < 64; r += NWAVES) {
            const int t = c * 64 + r; const size_t row = (size_t)b * SEQ + t;
            { const int h = lane >> 4; const bf16* op = OB + row * DM + h * 256 + dh;
              const v4u w1 = *(const v4u*)op, w2 = *(const v4u*)(op + 128);
              float d[8];
              d[0] = bflo(w1.x) - lam * bflo(w2.x); d[1] = bfhi(w1.x) - lam * bfhi(w2.x); d[2] = bflo(w1.y) - lam * bflo(w2.y); d[3] = bfhi(w1.y) - lam * bfhi(w2.y);
              d[4] = bflo(w1.z) - lam * bflo(w2.z); d[5] = bfhi(w1.z) - lam * bfhi(w2.z); d[6] = bflo(w1.w) - lam * bflo(w2.w); d[7] = bfhi(w1.w) - lam * bfhi(w2.w);
              float ssq = 0.f;
#pragma unroll
              for (int e = 0; e < 8; ++e) ssq += d[e] * d[e];
              ssq += shx(ssq, 1); ssq += shx(ssq, 2); ssq += shx(ssq, 4); ssq += shx(ssq, 8);
              const float rs = __builtin_amdgcn_rsqf(ssq * (1.0f / 128.0f) + 1e-5f);
              v4u o; o.x = pk2(d[0] * rs * sg[0], d[1] * rs * sg[1]); o.y = pk2(d[2] * rs * sg[2], d[3] * rs * sg[3]); o.z = pk2(d[4] * rs * sg[4], d[5] * rs * sg[5]); o.w = pk2(d[6] * rs * sg[6], d[7] * rs * sg[7]);
              *(v4u*)(Y + row * DM + h * 128 + dh) = o; }
            { const bf16* zr = Z + row * ZP; float acc[4] = {0.f, 0.f, 0.f, 0.f};
#pragma unroll
              for (int k = 0; k < 3; ++k) { const int tt = t - 2 + k; if (tt >= 0) { const bf16* zz = zr - (size_t)(2 - k) * ZP;
                  const v2u cw = *(const v2u*)(zz + ZSC + ch), xw = *(const v2u*)(zz + ZSX + ch);
                  acc[0] += scw[k][0] * (bflo(cw.x) * bflo(xw.x)); acc[1] += scw[k][1] * (bfhi(cw.x) * bfhi(xw.x)); acc[2] += scw[k][2] * (bflo(cw.y) * bflo(xw.y)); acc[3] += scw[k][3] * (bfhi(cw.y) * bfhi(xw.y)); } }
              const v2u bw = *(const v2u*)(zr + ZSB + ch);
              v2u o; o.x = pk2(bflo(bw.x) * acc[0], bfhi(bw.x) * acc[1]); o.y = pk2(bflo(bw.y) * acc[2], bfhi(bw.y) * acc[3]);
              *(v2u*)(Y + row * DM + 512 + ch) = o;
              const f32x4 hl = *(const f32x4*)(HL + row * 256 + ch), pl = *(const f32x4*)(PL + row * 256 + ch);
              const v2u gw = *(const v2u*)(zr + ZLG + ch);
              v2u o2; o2.x = pk2(gelu_tanh(bflo(gw.x)) * (hl[0] + pl[0] * hin[0]), gelu_tanh(bfhi(gw.x)) * (hl[1] + pl[1] * hin[1]));
              o2.y = pk2(gelu_tanh(bflo(gw.y)) * (hl[2] + pl[2] * hin[2]), gelu_tanh(bfhi(gw.y)) * (hl[3] + pl[3] * hin[3]));
              *(v2u*)(Y + row * DM + 768 + ch) = o2; }
        }
    }
    __syncthreads();
}

__device__ __forceinline__ void final_norm_phase(ArgsP a, int G) {
    asm volatile("" : "+s"(a));
    int tid_ = threadIdx.x; asm volatile("" : "+v"(tid_)); const int tid = tid_, lane = tid & 63, wave = tid >> 6;
    const int gw = blockIdx.x * NWAVES + wave, NGW = G * NWAVES;
    const float* SS = (const float*)(a->ws + WS_SS); const float* g = a->in[I_FIN];
    f32x4 gv[4];
#pragma unroll
    for (int j = 0; j < 4; ++j) gv[j] = ((const f32x4*)g)[lane + 64 * j];
    for (int m = gw; m < MTOK; m += NGW) {
        const f32x4 s4 = *(const f32x4*)(SS + (size_t)m * 4);
        const float rs = 1.0f / sqrtf(((s4[0] + s4[1]) + (s4[2] + s4[3])) * (1.0f / 1024.0f) + 1e-6f);
#if RES_BF16
        const v2u* xb = (const v2u*)((const bf16*)(a->ws + WS_XB) + (size_t)m * DM) + lane; f32x4* xr = (f32x4*)(a->out + (size_t)m * DM) + lane;
#pragma unroll
        for (int j = 0; j < 4; ++j) { const v2u w = xb[64 * j]; const f32x4 v = (f32x4){bflo(w.x), bfhi(w.x), bflo(w.y), bfhi(w.y)}; xr[64 * j] = v * rs * gv[j]; }
#else
        f32x4* xr = (f32x4*)(a->out + (size_t)m * DM) + lane;
#pragma unroll
        for (int j = 0; j < 4; ++j) { const f32x4 v = xr[64 * j]; xr[64 * j] = v * rs * gv[j]; }
#endif
    }
}

constexpr int N_PHASES = 2 + 8 * DEPTH;
__global__ void __launch_bounds__(NTHR, 2) hymba_fwd(Args args) {
    extern __shared__ __attribute__((aligned(16))) unsigned char lds_raw[];
    LAS unsigned char* lds = (LAS unsigned char*)lds_raw;
    cg::grid_group grid = cg::this_grid();
    const int G = gridDim.x;
    ArgsP ap = (ArgsP)__builtin_amdgcn_kernarg_segment_ptr();
    if (threadIdx.x < 64) ((LAS unsigned*)(lds + LDSCTL_OFF))[threadIdx.x] = 0u;
    __syncthreads();
    const XcdBarrier bar = xcd_barrier_post((unsigned*)(ap->ws + WS_BAR), (volatile LAS unsigned*)(lds + MISC_OFF) + 8);
    const int ph_lo = ap->ph_lo, ph_hi = ap->ph_hi;
    for (int ph = ph_lo; ph < ph_hi; ++ph) {
        ArgsP a = ap; asm volatile("" : "+s"(a));
        unsigned char* ws = a->ws;
        bf16* XB = (bf16*)(ws + WS_XB); bf16* ACT = (bf16*)(ws + WS_ACT); bf16* Y = (bf16*)(ws + WS_Y); float* SS = (float*)(ws + WS_SS);
        int reps = 1;
        if (PROBE_REP_MASK) { if (ph == 0) reps = ((PROBE_REP_MASK >> 8) & 1) ? 2 : 1; else if (ph < N_PHASES - 1) reps = ((PROBE_REP_MASK >> ((ph - 1) & 7)) & 1) ? 2 : 1; }
        for (int rep = 0; rep < reps; ++rep) {
        if (ph == 0) { prologue_phase(a, lds, G); if ((PROBE_REP_MASK >> 12) & 1) prologue_phase(a, lds, G); }
        else if (ph == N_PHASES - 1) final_norm_phase(a, G);
        else {
            const int l = (ph - 1) >> 3, s = (ph - 1) & 7;
            const unsigned char* wl = ws + WS_W + (size_t)l * WL_STRIDE;
            if (s == 0 || s == 6) {
                pg8::Gemm g{XB, (const bf16*)(wl + (s == 0 ? WL_1C : WL_2C)), MTOK, 2 * DFF, DM}; pg8::StaticOrder S; S.init(MTOK, 2 * DFF, G, (int)blockIdx.x);
                pg8::EpiSwiglu E{ACT, DFF, SS};
                pg8::gemm_phase<pg8::EpiSwiglu, pg8::StaticOrder, PG8_ALIGN_MULTI, true>(lds, g, S, E);
                if (HIDE_CONV && l + 1 < DEPTH) {
                    const int nidle = G - (1408 % G);
                    if (G == 256 && (int)blockIdx.x >= G - nidle) {
                        const int i0 = (l + 1) * CONV_ITEMS_LAYER + (s == 0 ? 0 : CONV_ITEMS_LAYER / 2), i1 = (l + 1) * CONV_ITEMS_LAYER + (s == 0 ? CONV_ITEMS_LAYER / 2 : CONV_ITEMS_LAYER);
                        convert_items(a, lds, i0, i1, ((int)blockIdx.x - (G - nidle)) * NWAVES + __builtin_amdgcn_readfirstlane((int)threadIdx.x >> 6), nidle * NWAVES);
                    }
                }
            } else if (s == 1 || s == 5 || s == 7) {
                const bool isout = (s == 5);
                pg8::Gemm g{isout ? Y : ACT, (const bf16*)(wl + (s == 1 ? WL_1D : (s == 5 ? WL_OUT : WL_2D))), MTOK, DM, isout ? DM : DFF}; pg8::StaticOrder S; S.init(MTOK, DM, G, (int)blockIdx.x);
#if RES_BF16
                pg8::EpiRes16 E{XB, SS, isout ? 1.0f : 0.5f};
                pg8::gemm_phase<pg8::EpiRes16, pg8::StaticOrder, false, true>(lds, g, S, E);
#else
                pg8::EpiRes E{(l == 0 && s == 1) ? a->in[I_X] : a->out, a->out, XB, SS, isout ? 1.0f : 0.5f};
                pg8::gemm_phase<pg8::EpiRes, pg8::StaticOrder, false, true>(lds, g, S, E);
#endif
            } else if (s == 2) {
                pg8::Gemm g{XB, (const bf16*)(wl + WL_IN), MTOK, INW, DM}; pg8::StaticOrder S; S.init(MTOK, INW, G, (int)blockIdx.x);
                pg8::EpiZ E{ACT, ZP, SS, QSCALE};
                pg8::gemm_phase<pg8::EpiZ, pg8::StaticOrder, PG8_ALIGN_MULTI, true>(lds, g, S, E);
            } else if (s == 3) {
                lru_local_phase(a, lds, G, l);
                if ((PROBE_REP_MASK >> 9) & 1) lru_local_phase(a, lds, G, l);
#if USE_NAIVE_ATTN
                attn_naive_phase(a, lds, G);
#elif USE_ATTN128
                { static_assert(attn128::ATTN_LDS_BYTES <= RING_BYTES, "attention LDS");
                  const attn128::AttnTensors AT{(const attn128::bf16*)ACT, (attn128::bf16*)(ws + WS_OB), (const float*)(ws + WS_BTAB)};
                  const attn128::StaticOrder S(G, (int)blockIdx.x);
                  attn128::attn_phase<attn128::StaticOrder>((char*)lds_raw, AT, S);
                  if ((PROBE_REP_MASK >> 10) & 1) attn128::attn_phase<attn128::StaticOrder>((char*)lds_raw, AT, S); }
#elif USE_SWA_ATTN
                { static_assert(swa::LDS_BYTES <= RING_BYTES, "attention LDS");
                  swa::attn_swa_phase((const swa::bf16*)ACT, (swa::bf16*)(ws + WS_OB), (const float*)(ws + WS_BTAB), (char*)lds_raw, G);
                  if ((PROBE_REP_MASK >> 10) & 1) swa::attn_swa_phase((const swa::bf16*)ACT, (swa::bf16*)(ws + WS_OB), (const float*)(ws + WS_BTAB), (char*)lds_raw, G); }
#else
                { static_assert(attn_body::ATTN_LDS_BYTES <= RING_BYTES, "attention LDS");
                  const attn_body::AttnTensors AT{(const attn_body::bf16*)ACT, (attn_body::bf16*)(ws + WS_OB), (const float*)(ws + WS_BTAB)};
                  const attn_body::StaticOrder S(G, (int)blockIdx.x);
                  attn_body::attn_phase<attn_body::StaticOrder>((char*)lds_raw, AT, S);
                  if ((PROBE_REP_MASK >> 10) & 1) attn_body::attn_phase<attn_body::StaticOrder>((char*)lds_raw, AT, S); }
#endif
            } else {
                finalize_phase(a, lds, G, l);
                if ((PROBE_REP_MASK >> 11) & 1) finalize_phase(a, lds, G, l);
            }
        }
        if (rep + 1 < reps) xcd_barrier(bar);
        }
        if (ph + 1 < ph_hi) { if (USE_CG_SYNC || ph_lo < 0) grid.sync(); else xcd_barrier(bar); }
        if (PROBE_EXTRA_SYNC) for (int e = 0; e < PROBE_EXTRA_SYNC; ++e) xcd_barrier(bar);
    }
}

#ifndef MK_PER_PHASE
#define MK_PER_PHASE 0
#endif
extern "C" void kernel_launch(void* const* d_in, const int* in_sizes, int n_in, void* d_out, int out_size, void* d_ws, size_t ws_size, hipStream_t stream) {
    static int grid = 0;
    if (grid == 0) {
        if (n_in != 27 || in_sizes[0] != MTOK * DM || out_size != MTOK * DM || ws_size < WS_END) { fprintf(stderr, "kernel_launch: unexpected shapes / workspace (n_in %d, ws %zu)\n", n_in, ws_size); grid = -1; return; }
        int dev = 0, cus = 0, per_cu = 0;
        hipGetDevice(&dev); hipDeviceGetAttribute(&cus, hipDeviceAttributeMultiprocessorCount, dev);
        if (hipFuncSetAttribute((const void*)hymba_fwd, hipFuncAttributeMaxDynamicSharedMemorySize, LDS_BYTES) != hipSuccess) { fprintf(stderr, "kernel_launch: hipFuncSetAttribute failed\n"); grid = -1; return; }
        hipOccupancyMaxActiveBlocksPerMultiprocessor(&per_cu, (const void*)hymba_fwd, NTHR, LDS_BYTES);
        (void)hipGetLastError();
        if (cus != 256 || per_cu < 1) fprintf(stderr, "kernel_launch: note: cus %d per_cu %d (built for 256 x 1)\n", cus, per_cu);
        grid = 256;
    }
    if (grid < 0) return;
    if (hipMemsetAsync((char*)d_ws + WS_BAR, 0, BAR_BYTES, stream) != hipSuccess) { fprintf(stderr, "kernel_launch: memset failed\n"); return; }
    Args a{};
    for (int i = 0; i < 27; ++i) a.in[i] = (const float*)d_in[i];
    a.out = (float*)d_out; a.ws = (unsigned char*)d_ws;
#if MK_PER_PHASE
    for (int p = 0; p < N_PHASES; ++p) { a.ph_lo = p; a.ph_hi = p + 1; hipLaunchKernelGGL(hymba_fwd, dim3(grid), dim3(NTHR), LDS_BYTES, stream, a); }
#else
    a.ph_lo = 0; a.ph_hi = N_PHASES;
    void* kargs[] = {&a};
    hipError_t e = hipLaunchCooperativeKernel((const void*)hymba_fwd, dim3(grid), dim3(NTHR), kargs, LDS_BYTES, stream);
    if (e != hipSuccess) fprintf(stderr, "kernel_launch: cooperative launch failed: %s\n", hipGetErrorString(e));
#endif
}
```

```cpp
#include <hip/hip_runtime.h>
#include <hip/hip_cooperative_groups.h>
#include <cstdio>
#include <cstdint>
#include <cmath>
namespace cg = cooperative_groups;
#ifndef PG8_WGM
#define PG8_WGM 8
#endif
__device__ __forceinline__ float shx(float v, int m) { int ln; asm volatile("v_mbcnt_lo_u32_b32 %0, -1, 0\n\tv_mbcnt_hi_u32_b32 %0, -1, %0" : "=v"(ln)); return __builtin_bit_cast(float, __builtin_amdgcn_ds_bpermute((ln ^ m) << 2, __builtin_bit_cast(int, v))); }
namespace pg8 {
#define PG8_LAS __attribute__((address_space(3)))
typedef unsigned short bf16_t;
typedef short bf16x8 __attribute__((ext_vector_type(8)));
typedef float f32x4 __attribute__((ext_vector_type(4)));
typedef unsigned u32x4 __attribute__((ext_vector_type(4)));
constexpr int BM = 256, BK = 64, HALF = 128, HTB = HALF * BK * 2  , STAGE_BYTES = 8 * HTB, NXCD = 8, WGM = PG8_WGM;

__host__ __device__ __forceinline__ int lds_byte(int r, int c) { const int st = (r >> 4) * 2 + (c >> 5), rr = r & 15, cc = c & 31, ob = rr * 64 + cc * 2; return st * 1024 + (ob ^ (((ob >> 9) & 1) << 5)); }
__host__ __device__ __forceinline__ void stage_rc(int b, int& R, int& C) { const int st = b / 1024, sb = b % 1024, swz = sb ^ (((sb >> 9) & 1) << 5); R = (st >> 1) * 16 + swz / 64; C = (st & 1) * 32 + (swz % 64) / 2; }
__host__ __device__ __forceinline__ int perm32(int rho) { const int n = rho >> 4, i = rho & 15; return 8 * (i >> 2) + 4 * n + (i & 3); }

struct Unit { int pm, pn; };
struct Gemm { const bf16_t* A; const bf16_t* Bt; int M, N, K; };

struct StaticOrder {
    int nM, nN, nwg, G, c;
    __host__ __device__ void init(int M, int N, int G_, int c_) { nM = M / BM; nN = N / BM; nwg = nM * nN; G = G_; c = c_; }
    __host__ __device__ bool next(int i, Unit& u) const {
        const long L = (long)i * G + c; if (L >= nwg) return false;
        int wgid = (int)L; { const int q = nwg / NXCD, r = nwg % NXCD, xcd = wgid % NXCD, off = wgid / NXCD; wgid = (xcd < r ? xcd * (q + 1) : r * (q + 1) + (xcd - r) * q) + off; }
        const int nig = WGM * nN, gid = wgid / nig, fm = gid * WGM, gsz = (nM - fm) < WGM ? (nM - fm) : WGM;
        u.pm = fm + ((wgid % nig) % gsz); u.pn = (wgid % nig) / gsz; return true;
    }
    __device__ __forceinline__ void a_ready(const Unit&) const {}
    __device__ __forceinline__ void done(const Unit&) const {}
};

__device__ __forceinline__ unsigned cvt_pk_bf16(float lo, float hi) { unsigned r; asm volatile("v_cvt_pk_bf16_f32 %0, %1, %2" : "=v"(r) : "v"(lo), "v"(hi)); return r; }
typedef float f32x2 __attribute__((ext_vector_type(2)));
typedef unsigned u32x2 __attribute__((ext_vector_type(2)));
#define PG8_ST16_WT(w, rs, off) __builtin_amdgcn_raw_buffer_store_b128((w), (rs), (unsigned)(off), 0, 16)
#define PG8_RSRC(p, bytes) __builtin_amdgcn_make_buffer_rsrc((void*)(p), 0, (int)(bytes), 0x00020000)
__device__ __forceinline__ float row_rstd(const float* ss, int row) {
    const f32x4 s4 = *(const f32x4*)(ss + (size_t)row * 4);
    return __builtin_amdgcn_rsqf(((s4[0] + s4[1]) + (s4[2] + s4[3])) * (1.0f / 1024.0f) + 1e-6f);
}
__device__ __forceinline__ float silu_mul(float g, float u) {
    const float e = __builtin_amdgcn_exp2f(-g * 1.4426950408889634f);
    return g * __builtin_amdgcn_rcpf(1.0f + e) * u;
}
struct EpiSwiglu {
    static constexpr bool PERM = true, AFTER_DRAIN = false, ROWTAB = true;
    bf16_t* O; int ldc; const float* ss;
    __device__ __forceinline__ void operator()(const f32x4 (&acc)[2][2][4][2], const Unit& u, int wr, int wc, int fr, int fq, const PG8_LAS float* tab) const {
        { int ln_; asm volatile("v_mbcnt_lo_u32_b32 %0, -1, 0\n\tv_mbcnt_hi_u32_b32 %0, -1, %0" : "=v"(ln_)); fr = ln_ & 15; fq = ln_ >> 4; }
        const int row0 = u.pm * BM + wr * 64 + fr; const int col0 = u.pn * 128 + wc * 32 + 8 * fq;
#pragma unroll
        for (int ai = 0; ai < 2; ++ai)
#pragma unroll
            for (int m = 0; m < 4; ++m) {
                const int row = row0 + ai * HALF + m * 16; const f32x4 s4 = *(const PG8_LAS f32x4*)(tab + (ai * HALF + wr * 64 + m * 16 + fr) * 4); const float rs = __builtin_amdgcn_rsqf(((s4[0] + s4[1]) + (s4[2] + s4[3])) * (1.0f / 1024.0f) + 1e-6f);
                const f32x4 g0 = acc[ai][0][m][0] * rs, g1 = acc[ai][0][m][1] * rs, u0 = acc[ai][1][m][0] * rs, u1 = acc[ai][1][m][1] * rs;
                u32x4 w;
                w.x = cvt_pk_bf16(silu_mul(g0[0], u0[0]), silu_mul(g0[1], u0[1])); w.y = cvt_pk_bf16(silu_mul(g0[2], u0[2]), silu_mul(g0[3], u0[3]));
                w.z = cvt_pk_bf16(silu_mul(g1[0], u1[0]), silu_mul(g1[1], u1[1])); w.w = cvt_pk_bf16(silu_mul(g1[2], u1[2]), silu_mul(g1[3], u1[3]));
                PG8_ST16_WT(w, PG8_RSRC(O, 16384u * 2816u * 2u), ((unsigned)row * (unsigned)ldc + (unsigned)col0) * 2u);
            }
    }
};
struct EpiZ {
    static constexpr bool PERM = true, AFTER_DRAIN = false, ROWTAB = true;
    bf16_t* O; int ldc; const float* ss; float qscale;
    __device__ __forceinline__ void operator()(const f32x4 (&acc)[2][2][4][2], const Unit& u, int wr, int wc, int fr, int fq, const PG8_LAS float* tab) const {
        { int ln_; asm volatile("v_mbcnt_lo_u32_b32 %0, -1, 0\n\tv_mbcnt_hi_u32_b32 %0, -1, %0" : "=v"(ln_)); fr = ln_ & 15; fq = ln_ >> 4; }
        const int row0 = u.pm * BM + wr * 64 + fr; const int col0 = u.pn * BM + wc * 32 + 8 * fq;
        const float sc = (u.pn < 2) ? qscale : 1.0f;
#pragma unroll
        for (int ai = 0; ai < 2; ++ai)
#pragma unroll
            for (int m = 0; m < 4; ++m) {
                const int row = row0 + ai * HALF + m * 16; const f32x4 s4 = *(const PG8_LAS f32x4*)(tab + (ai * HALF + wr * 64 + m * 16 + fr) * 4); const float rs = __builtin_amdgcn_rsqf(((s4[0] + s4[1]) + (s4[2] + s4[3])) * (1.0f / 1024.0f) + 1e-6f) * sc;
#pragma unroll
                for (int bj = 0; bj < 2; ++bj) {
                    const f32x4 v0 = acc[ai][bj][m][0] * rs, v1 = acc[ai][bj][m][1] * rs;
                    u32x4 w; w.x = cvt_pk_bf16(v0[0], v0[1]); w.y = cvt_pk_bf16(v0[2], v0[3]); w.z = cvt_pk_bf16(v1[0], v1[1]); w.w = cvt_pk_bf16(v1[2], v1[3]);
                    PG8_ST16_WT(w, PG8_RSRC(O, 16384u * 2816u * 2u), ((unsigned)row * (unsigned)ldc + (unsigned)(col0 + bj * HALF)) * 2u);
                }
            }
    }
};
struct EpiRes {
    static constexpr bool PERM = false, AFTER_DRAIN = true, ROWTAB = false;
    const float* base; float* out; bf16_t* xb; float* ss; float alpha;
    __device__ __forceinline__ void fused(f32x4 (&acc)[2][2][4][2], const Unit& u, int wr, int wc, int fr, int fq, PG8_LAS unsigned char* lds, int wid, int lane) const {
        PG8_LAS float* P = (PG8_LAS float*)lds;
        const int col0 = u.pn * BM + wc * 32 + 4 * fq;
#pragma unroll
        for (int ai = 0; ai < 2; ++ai)
#pragma unroll
            for (int m = 0; m < 4; ++m) {
                const int r = ai * HALF + wr * 64 + m * 16 + fr; const size_t off = (size_t)(u.pm * BM + r) * 1024 + col0; float s = 0.f;
                f32x4 bb[2][2];
#pragma unroll
                for (int bj = 0; bj < 2; ++bj)
#pragma unroll
                    for (int n = 0; n < 2; ++n) bb[bj][n] = *(const f32x4*)(base + off + bj * HALF + n * 16);
#pragma unroll
                for (int bj = 0; bj < 2; ++bj)
#pragma unroll
                    for (int n = 0; n < 2; ++n) {
                        const f32x4 o = bb[bj][n] + acc[ai][bj][m][n] * alpha;
                        *(f32x4*)(out + off + bj * HALF + n * 16) = o;
                        u32x2 w; w.x = cvt_pk_bf16(o[0], o[1]); w.y = cvt_pk_bf16(o[2], o[3]);
                        *(u32x2*)(xb + off + bj * HALF + n * 16) = w;
                        s += (o[0] * o[0] + o[1] * o[1]) + (o[2] * o[2] + o[3] * o[3]);
                    }
                s += shx(s, 16); s += shx(s, 32);
                if (fq == 0) P[r * 4 + wc] = s;
            }
        asm volatile("s_waitcnt lgkmcnt(0)" ::: "memory"); __builtin_amdgcn_s_barrier(); asm volatile("" ::: "memory");
        const int tid = wid * 64 + lane;
        if (tid < 256) {
            const f32x4 p = *(const PG8_LAS f32x4*)(P + tid * 4);
            const float t = (p[0] + p[1]) + (p[2] + p[3]);
            __hip_atomic_store((unsigned*)ss + ((size_t)(u.pm * BM + tid) * 4 + u.pn), __float_as_uint(t), __ATOMIC_RELAXED, __HIP_MEMORY_SCOPE_AGENT);
        }
        asm volatile("s_waitcnt lgkmcnt(0)" ::: "memory"); __builtin_amdgcn_s_barrier(); asm volatile("" ::: "memory");
    }
};
struct EpiRes16 {
    static constexpr bool PERM = true, AFTER_DRAIN = true, ROWTAB = false;
    bf16_t* xb; float* ss; float alpha;
    __device__ __forceinline__ void fused(f32x4 (&acc)[2][2][4][2], const Unit& u, int wr, int wc, int fr, int fq, PG8_LAS unsigned char* lds, int wid, int lane) const {
        PG8_LAS float* P = (PG8_LAS float*)lds;
        const int col0 = u.pn * BM + wc * 32 + 8 * fq;
        u32x4 bb[2][4][2];
#pragma unroll
        for (int ai = 0; ai < 2; ++ai)
#pragma unroll
            for (int m = 0; m < 4; ++m)
#pragma unroll
                for (int bj = 0; bj < 2; ++bj) bb[ai][m][bj] = *(const u32x4*)(xb + (size_t)(u.pm * BM + ai * HALF + wr * 64 + m * 16 + fr) * 1024 + col0 + bj * HALF);
#pragma unroll
        for (int ai = 0; ai < 2; ++ai)
#pragma unroll
            for (int m = 0; m < 4; ++m) {
                const int r = ai * HALF + wr * 64 + m * 16 + fr; float s = 0.f;
#pragma unroll
                for (int bj = 0; bj < 2; ++bj) {
                    const f32x4 a0 = acc[ai][bj][m][0] * alpha, a1 = acc[ai][bj][m][1] * alpha; const u32x4 b = bb[ai][m][bj];
                    float o[8];
                    o[0] = __uint_as_float(b.x << 16) + a0[0]; o[1] = __uint_as_float(b.x & 0xffff0000u) + a0[1]; o[2] = __uint_as_float(b.y << 16) + a0[2]; o[3] = __uint_as_float(b.y & 0xffff0000u) + a0[3];
                    o[4] = __uint_as_float(b.z << 16) + a1[0]; o[5] = __uint_as_float(b.z & 0xffff0000u) + a1[1]; o[6] = __uint_as_float(b.w << 16) + a1[2]; o[7] = __uint_as_float(b.w & 0xffff0000u) + a1[3];
                    u32x4 w; w.x = cvt_pk_bf16(o[0], o[1]); w.y = cvt_pk_bf16(o[2], o[3]); w.z = cvt_pk_bf16(o[4], o[5]); w.w = cvt_pk_bf16(o[6], o[7]);
                    PG8_ST16_WT(w, PG8_RSRC(xb, 16384u * 1024u * 2u), ((unsigned)(u.pm * BM + r) * 1024u + (unsigned)(col0 + bj * HALF)) * 2u);
#pragma unroll
                    for (int e = 0; e < 8; ++e) s += o[e] * o[e];
                }
                s += shx(s, 16); s += shx(s, 32);
                if (fq == 0) P[r * 4 + wc] = s;
            }
        asm volatile("s_waitcnt lgkmcnt(0)" ::: "memory"); __builtin_amdgcn_s_barrier(); asm volatile("" ::: "memory");
        const int tid = wid * 64 + lane;
        if (tid < 256) {
            const f32x4 p = *(const PG8_LAS f32x4*)(P + tid * 4);
            const float t = (p[0] + p[1]) + (p[2] + p[3]);
            __hip_atomic_store((unsigned*)ss + ((size_t)(u.pm * BM + tid) * 4 + u.pn), __float_as_uint(t), __ATOMIC_RELAXED, __HIP_MEMORY_SCOPE_AGENT);
        }
        asm volatile("s_waitcnt lgkmcnt(0)" ::: "memory"); __builtin_amdgcn_s_barrier(); asm volatile("" ::: "memory");
    }
};
template <class Epi, class Sched, bool ALIGN_EPI = false, bool SP2 = false>
__device__ __forceinline__ void gemm_phase(PG8_LAS unsigned char* lds, const Gemm g, const Sched& S, const Epi& E) {
    int tid_ = threadIdx.x; asm volatile("" : "+v"(tid_));
    const int tid = tid_, wid = __builtin_amdgcn_readfirstlane(tid >> 6), lane = tid & 63, wr = wid >> 2, wc = wid & 3, fr = lane & 15, fq = lane >> 4;
    const int K = g.K, nt = K / BK;
    unsigned voffA[2], voffB[2];
#pragma unroll
    for (int i = 0; i < 2; ++i) { int R, C; stage_rc(tid * 16 + i * 8192, R, C); const int Rb = Epi::PERM ? ((R & ~31) + perm32(R & 31)) : R;
        voffA[i] = (unsigned)(R * K + C) * 2u; voffB[i] = (unsigned)(Rb * K + C) * 2u; }
    const size_t kstep = (size_t)(BK * 2);
    const size_t hstep = (size_t)HALF * K * 2;
    const size_t tstep = 2 * hstep;
    const unsigned ldsw = (unsigned)wid * 1024u;
    const int aoff = lds_byte(wr * 64 + fr, fq * 8), boff = lds_byte(wc * 32 + fr, fq * 8);
#define PG8_SA(b, h) (((b) * 2 + (h)) * HTB)
#define PG8_SB(b, h) ((4 + (b) * 2 + (h)) * HTB)
#define PG8_STAGE(bufoff, gbase, voff) do { _Pragma("unroll") for (int _i = 0; _i < 2; ++_i) \
        __builtin_amdgcn_global_load_lds((const unsigned*)((const char*)(gbase) + (voff)[_i]), (PG8_LAS unsigned*)(lds + (bufoff) + ldsw + _i * 8192), 16, 0, 0); } while (0)
#define PG8_LDA(dst, b, h) do { _Pragma("unroll") for (int m = 0; m < 4; ++m) _Pragma("unroll") for (int k = 0; k < 2; ++k) dst[m][k] = *(const PG8_LAS bf16x8*)(lds + PG8_SA(b, h) + aoff + m * 2048 + k * 1024); } while (0)
#define PG8_LDB(dst, b, h) do { _Pragma("unroll") for (int n = 0; n < 2; ++n) _Pragma("unroll") for (int k = 0; k < 2; ++k) dst[n][k] = *(const PG8_LAS bf16x8*)(lds + PG8_SB(b, h) + boff + n * 2048 + k * 1024); } while (0)
#define PG8_MMA(ai, bj, At, Bt) do { __builtin_amdgcn_s_setprio(1); _Pragma("unroll") for (int m = 0; m < 4; ++m) _Pragma("unroll") for (int n = 0; n < 2; ++n) _Pragma("unroll") for (int k = 0; k < 2; ++k) \
        acc[ai][bj][m][n] = __builtin_amdgcn_mfma_f32_16x16x32_bf16(Bt[n][k], At[m][k], acc[ai][bj][m][n], 0, 0, 0); __builtin_amdgcn_s_setprio(0); } while (0)
#define PG8_WAIT_V(n) asm volatile("s_waitcnt vmcnt(" #n ")" ::: "memory")
#define PG8_WAIT_L(n) asm volatile("s_waitcnt lgkmcnt(" #n ")" ::: "memory")
#define PG8_BAR __builtin_amdgcn_s_barrier()
#define PG8_SCHED __builtin_amdgcn_sched_barrier(0)
    Unit cur, nxt; int ui = 0;
    if (!S.next(0, cur)) return;
    f32x4 acc[2][2][4][2];
#pragma unroll
    for (int a = 0; a < 2; ++a)
#pragma unroll
        for (int b = 0; b < 2; ++b)
#pragma unroll
            for (int m = 0; m < 4; ++m)
#pragma unroll
                for (int n = 0; n < 2; ++n) acc[a][b][m][n] = (f32x4){0.f, 0.f, 0.f, 0.f};
    bf16x8 At[4][2], B0[2][2], B1[2][2];
    const char* cA = (const char*)g.A + (size_t)cur.pm * tstep; const char* cB = (const char*)g.Bt + (size_t)cur.pn * tstep;
    S.a_ready(cur);
    if constexpr (SP2) {
        PG8_STAGE(PG8_SB(0, 0), cB, voffB); PG8_STAGE(PG8_SB(0, 1), cB + hstep, voffB); PG8_STAGE(PG8_SA(0, 0), cA, voffA); PG8_STAGE(PG8_SA(0, 1), cA + hstep, voffA);
        if (wr == 1) PG8_BAR;
        PG8_WAIT_V(2); PG8_BAR;
        PG8_STAGE(PG8_SB(1, 0), cB + kstep, voffB); PG8_STAGE(PG8_SA(1, 0), cA + kstep, voffA); PG8_STAGE(PG8_SB(1, 1), cB + hstep + kstep, voffB);
        PG8_WAIT_V(6); PG8_BAR;
    } else {
        PG8_STAGE(PG8_SB(0, 0), cB, voffB); PG8_STAGE(PG8_SA(0, 0), cA, voffA); PG8_STAGE(PG8_SB(0, 1), cB + hstep, voffB); PG8_STAGE(PG8_SA(0, 1), cA + hstep, voffA);
        if (wr == 1) PG8_BAR;
        PG8_WAIT_V(4); PG8_BAR;
        PG8_STAGE(PG8_SB(1, 0), cB + kstep, voffB); PG8_STAGE(PG8_SA(1, 0), cA + kstep, voffA); PG8_STAGE(PG8_SB(1, 1), cB + hstep + kstep, voffB);
        PG8_WAIT_V(6); PG8_BAR;
    }
    for (;;) {
        const bool has_next = S.next(ui + 1, nxt);
        const char* nA = has_next ? (const char*)g.A + (size_t)nxt.pm * tstep : cA; const char* nB = has_next ? (const char*)g.Bt + (size_t)nxt.pn * tstep : cB;
        for (int t = 0; t < nt; t += 2) {
            const bool last = (t == nt - 2);

            const char* a1 = cA + (size_t)(t + 1) * kstep;
            const char* a2 = last ? nA : cA + (size_t)(t + 2) * kstep; const char* b2 = last ? nB : cB + (size_t)(t + 2) * kstep;
            const char* a3 = a2 + kstep; const char* b3 = b2 + kstep;
            if (last && has_next) S.a_ready(nxt);
            if constexpr (SP2) {
            PG8_LDB(B0, 0, 0); PG8_LDB(B1, 0, 1); PG8_SCHED; PG8_LDA(At, 0, 0); PG8_STAGE(PG8_SA(1, 1), a1 + hstep, voffA);
            PG8_WAIT_V(8); PG8_WAIT_L(0); PG8_BAR; PG8_MMA(0, 0, At, B0); PG8_MMA(0, 1, At, B1); PG8_BAR; PG8_SCHED;
            PG8_LDA(At, 0, 1); PG8_STAGE(PG8_SB(0, 0), b2, voffB); PG8_STAGE(PG8_SB(0, 1), b2 + hstep, voffB); PG8_STAGE(PG8_SA(0, 0), a2, voffA);
            PG8_WAIT_V(8); PG8_WAIT_L(0); PG8_BAR; PG8_MMA(1, 0, At, B0); PG8_MMA(1, 1, At, B1); PG8_BAR; PG8_SCHED;
            PG8_LDB(B0, 1, 0); PG8_LDB(B1, 1, 1); PG8_SCHED; PG8_LDA(At, 1, 0); PG8_STAGE(PG8_SA(0, 1), a2 + hstep, voffA);
            PG8_WAIT_V(8); PG8_WAIT_L(0); PG8_BAR; PG8_MMA(0, 0, At, B0); PG8_MMA(0, 1, At, B1); PG8_BAR; PG8_SCHED;
            PG8_LDA(At, 1, 1); PG8_STAGE(PG8_SB(1, 0), b3, voffB); PG8_STAGE(PG8_SB(1, 1), b3 + hstep, voffB); PG8_STAGE(PG8_SA(1, 0), a3, voffA);
            PG8_WAIT_V(8); PG8_WAIT_L(0); PG8_BAR; PG8_MMA(1, 0, At, B0); PG8_MMA(1, 1, At, B1); PG8_BAR; PG8_SCHED;
            } else {
            PG8_LDB(B0, 0, 0); PG8_SCHED; PG8_LDA(At, 0, 0); PG8_STAGE(PG8_SA(1, 1), a1 + hstep, voffA);
            PG8_WAIT_L(8); PG8_BAR; PG8_WAIT_L(0); PG8_MMA(0, 0, At, B0); PG8_BAR; PG8_SCHED;
            PG8_LDB(B1, 0, 1); PG8_STAGE(PG8_SB(0, 0), b2, voffB);
            PG8_BAR; PG8_WAIT_L(0); PG8_MMA(0, 1, At, B1); PG8_BAR;
            PG8_LDA(At, 0, 1); PG8_STAGE(PG8_SA(0, 0), a2, voffA);
            PG8_BAR; PG8_WAIT_L(0); PG8_MMA(1, 0, At, B0); PG8_BAR; PG8_SCHED;
            PG8_STAGE(PG8_SB(0, 1), b2 + hstep, voffB);
            PG8_WAIT_V(6); PG8_BAR; PG8_MMA(1, 1, At, B1); PG8_BAR;
            PG8_LDB(B0, 1, 0); PG8_SCHED; PG8_LDA(At, 1, 0); PG8_STAGE(PG8_SA(0, 1), a2 + hstep, voffA);
            PG8_WAIT_L(8); PG8_BAR; PG8_WAIT_L(0); PG8_MMA(0, 0, At, B0); PG8_BAR; PG8_SCHED;
            PG8_LDB(B1, 1, 1); PG8_STAGE(PG8_SB(1, 0), b3, voffB);
            PG8_BAR; PG8_WAIT_L(0); PG8_MMA(0, 1, At, B1); PG8_BAR;
            PG8_LDA(At, 1, 1); PG8_STAGE(PG8_SA(1, 0), a3, voffA);
            PG8_BAR; PG8_WAIT_L(0); PG8_MMA(1, 0, At, B0); PG8_BAR; PG8_SCHED;
            PG8_STAGE(PG8_SB(1, 1), b3 + hstep, voffB);
            PG8_WAIT_V(6); PG8_BAR; PG8_MMA(1, 1, At, B1); PG8_BAR;
            }
            if constexpr (Epi::ROWTAB) { if (t == 0 && wid < 4) {
                int ln_; asm volatile("v_mbcnt_lo_u32_b32 %0, -1, 0\n\tv_mbcnt_hi_u32_b32 %0, -1, %0" : "=v"(ln_)); const unsigned voff = (unsigned)(ln_ + wid * 64) * 16u; const char* sb = (const char*)E.ss + (size_t)cur.pm * 4096;
                const unsigned ldst = (unsigned)__builtin_amdgcn_readfirstlane((int)(unsigned)(size_t)(lds + STAGE_BYTES) + wid * 1024); unsigned keep;
                asm volatile("s_mov_b32 %0, m0\n\ts_mov_b32 m0, %3\n\ts_nop 0\n\tglobal_load_lds_dwordx4 %1, %2\n\ts_mov_b32 m0, %0" : "=&s"(keep) : "v"(voff), "s"(sb), "s"(ldst) : "memory"); } }
        }
        if constexpr (ALIGN_EPI) { if (wr == 0) PG8_BAR; }
        if constexpr (!Epi::AFTER_DRAIN) { if constexpr (Epi::ROWTAB) E(acc, cur, wr, wc, fr, fq, (const PG8_LAS float*)(lds + STAGE_BYTES)); else E(acc, cur, wr, wc, fr, fq); S.done(cur); }
        if (!has_next) break;
#pragma unroll
        for (int a = 0; a < 2; ++a)
#pragma unroll
            for (int b = 0; b < 2; ++b)
#pragma unroll
                for (int m = 0; m < 4; ++m)
#pragma unroll
                    for (int n = 0; n < 2; ++n) acc[a][b][m][n] = (f32x4){0.f, 0.f, 0.f, 0.f};
        cur = nxt; cA = nA; cB = nB; ++ui;
        if constexpr (ALIGN_EPI) { if (wr == 1) PG8_BAR; }
    }
    PG8_WAIT_V(0);
    if constexpr (!ALIGN_EPI) { if (wr == 0) PG8_BAR; }
    PG8_BAR;
    if constexpr (Epi::AFTER_DRAIN) { E.fused(acc, cur, wr, wc, fr, fq, lds, wid, lane); S.done(cur); }
#undef PG8_SA
#undef PG8_SB
#undef PG8_STAGE
#undef PG8_LDA
#undef PG8_LDB
#undef PG8_MMA
#undef PG8_WAIT_V
#undef PG8_WAIT_L
#undef PG8_BAR
#undef PG8_SCHED
}
}
#include <hip/hip_bf16.h>
#include <cmath>
namespace attn_body {
using bf16=__hip_bfloat16;
using bf16x8=__attribute__((ext_vector_type(8)))short;
using s16x4=__attribute__((ext_vector_type(4)))short;
using f32x16=__attribute__((ext_vector_type(16)))float;
using u32x4=__attribute__((ext_vector_type(4)))unsigned;
constexpr int BATCH=4,NHEAD=16,SEQ=4096,D=64,DM=2816,OP=1024;
constexpr int NW=8,QBLK=32,QB=QBLK*NW,KVBLK=64,NQB=SEQ/QB;
constexpr int ATTN_PITCH=DM, ATTN_UNIT_ROWS=QB;
__device__ __forceinline__ int crow(int r,int hi){return (r&3)+8*(r>>2)+4*hi;}
#define SBAR() __builtin_amdgcn_sched_barrier(0)
typedef __attribute__((address_space(3))) const float* lds_cfptr;
__device__ __forceinline__ void cmask(f32x16&p0,f32x16&p1,int jb,int qrel,int hi,lds_cfptr bt){
  const float NEG=-INFINITY; const int d00=qrel-(64*jb+4*hi);
  #pragma unroll
  for(int r=0;r<16;++r){const int d0=d00-((r&3)+8*(r>>2)), d1=d0-32;
    p0[r]+=bt[d0<0?0:d0]; p1[r]+=bt[d1<0?0:d1]; if(d0<0)p0[r]=NEG; if(d1<0)p1[r]=NEG;
    if((r&3)==3)__builtin_amdgcn_sched_barrier(0);}
}

constexpr int NSLOT=3, SLOTB=8192;
constexpr int LDS_K=0, LDS_V=NSLOT*SLOTB, LDS_WS=2*NSLOT*SLOTB, LDS_OST=LDS_WS+NW*64*4, LDS_BT=LDS_OST+NW*4096, LDS_BYTES=LDS_BT+1536;
constexpr float C2=0.125f*1.4426950408889634f;
__device__ __forceinline__ void glds16(const void*gsrc,unsigned lds_dst){unsigned keep;
  asm volatile("s_mov_b32 %0, m0\n\ts_mov_b32 m0, %2\n\ts_nop 0\n\tglobal_load_lds_dwordx4 %1, off\n\ts_mov_b32 m0, %0":"=&s"(keep):"v"(gsrc),"s"(lds_dst):"memory");}
__device__ __forceinline__ float max3f(float a,float b,float c){float r;asm("v_max3_f32 %0, %1, %2, %3":"=v"(r):"v"(a),"v"(b),"v"(c));return r;}
__device__ __forceinline__ float max2f(float a,float b){float r;asm("v_max_f32_e32 %0, %1, %2":"=v"(r):"v"(a),"v"(b));return r;}
__device__ __forceinline__ float fadd_s(float a,float b){float r;asm("v_add_f32_e32 %0, %1, %2":"=v"(r):"v"(a),"v"(b));return r;}
__device__ __forceinline__ float fsub_s(float a,float b){float r;asm("v_sub_f32_e32 %0, %1, %2":"=v"(r):"v"(a),"v"(b));return r;}
typedef float f32x2_t __attribute__((ext_vector_type(2))); typedef __bf16 bf16x2_t __attribute__((ext_vector_type(2)));
__device__ __forceinline__ unsigned cvtpk_s(float lo,float hi){f32x2_t v={lo,hi};bf16x2_t b=__builtin_convertvector(v,bf16x2_t);return __builtin_bit_cast(unsigned,b);}
#define WAIT_BAR(N) asm volatile("s_waitcnt vmcnt(" #N ") lgkmcnt(0)\n\ts_barrier":::"memory")

__device__ __forceinline__ void qkt(f32x16&p0,f32x16&p1,const char*Kslot,const bf16x8*qr,const f32x16&negm,int r32,int hi){
  const char*kb=Kslot+hi*1024+r32*16;
  #pragma unroll
  for(int d0=0;d0<4;++d0){
    const bf16x8 b0=*reinterpret_cast<const bf16x8*>(kb+d0*2048);
    const bf16x8 b1=*reinterpret_cast<const bf16x8*>(kb+d0*2048+512);
    if(d0==0){p0=__builtin_amdgcn_mfma_f32_32x32x16_bf16(b0,qr[0],negm,0,0,0);p1=__builtin_amdgcn_mfma_f32_32x32x16_bf16(b1,qr[0],negm,0,0,0);}
    else{p0=__builtin_amdgcn_mfma_f32_32x32x16_bf16(b0,qr[d0],p0,0,0,0);p1=__builtin_amdgcn_mfma_f32_32x32x16_bf16(b1,qr[d0],p1,0,0,0);}}
}
typedef __attribute__((address_space(3))) const char* lds_cptr;
typedef short v4i16_t __attribute__((ext_vector_type(4)));
__device__ __forceinline__ void kload8(bf16x8*kf,lds_cptr kp){
  kf[0]=*(const __attribute__((address_space(3))) bf16x8*)(kp);      kf[1]=*(const __attribute__((address_space(3))) bf16x8*)(kp+512);
  kf[2]=*(const __attribute__((address_space(3))) bf16x8*)(kp+2048); kf[3]=*(const __attribute__((address_space(3))) bf16x8*)(kp+2560);
  kf[4]=*(const __attribute__((address_space(3))) bf16x8*)(kp+4096); kf[5]=*(const __attribute__((address_space(3))) bf16x8*)(kp+4608);
  kf[6]=*(const __attribute__((address_space(3))) bf16x8*)(kp+6144); kf[7]=*(const __attribute__((address_space(3))) bf16x8*)(kp+6656);
}
__device__ __forceinline__ void kload2(bf16x8*kf,lds_cptr kp,int j){ kf[2*j]=*(const __attribute__((address_space(3))) bf16x8*)(kp+j*2048); kf[2*j+1]=*(const __attribute__((address_space(3))) bf16x8*)(kp+j*2048+512); }
__device__ __forceinline__ s16x4 vtr(lds_cptr p){ return __builtin_bit_cast(s16x4,__builtin_amdgcn_ds_read_tr16_b64_v4i16((__attribute__((address_space(3))) v4i16_t*)p)); }
__device__ __forceinline__ float rowmax(const f32x16&p0,const f32x16&p1){
  float a=max3f(p0[0],p0[1],p1[0]),b=max3f(p0[2],p0[3],p1[1]);a=max3f(a,p1[2],p1[3]);
  #pragma unroll
  for(int r=4;r<16;r+=4){a=max3f(a,p0[r],p0[r+1]);b=max3f(b,p0[r+2],p0[r+3]);a=max3f(a,p1[r],p1[r+1]);b=max3f(b,p1[r+2],p1[r+3]);}
  const float m=max2f(a,b);
  auto rr=__builtin_amdgcn_permlane32_swap(__float_as_uint(m),__float_as_uint(m),false,false);
  return max2f(__uint_as_float(rr[0]),__uint_as_float(rr[1]));
}
__device__ __forceinline__ void pv(f32x16*o,int vb,bf16x8 pa0,bf16x8 pa1,bf16x8 pa2,bf16x8 pa3){
  #pragma unroll
  for(int d0=0;d0<2;++d0){s16x4 lo[4],hi[4];
    #pragma unroll
    for(int ks=0;ks<4;++ks){
      asm volatile("ds_read_b64_tr_b16 %0,%1 offset:%c2":"=&v"(lo[ks]):"v"(vb),"i"(d0*4096+ks*1024):"memory");
      asm volatile("ds_read_b64_tr_b16 %0,%1 offset:%c2":"=&v"(hi[ks]):"v"(vb),"i"(d0*4096+ks*1024+512):"memory");}
    asm volatile("s_waitcnt lgkmcnt(0)":::"memory");SBAR();
    #define PK(k) (bf16x8){lo[k][0],lo[k][1],lo[k][2],lo[k][3],hi[k][0],hi[k][1],hi[k][2],hi[k][3]}
    o[d0]=__builtin_amdgcn_mfma_f32_32x32x16_bf16(pa0,PK(0),o[d0],0,0,0);
    o[d0]=__builtin_amdgcn_mfma_f32_32x32x16_bf16(pa1,PK(1),o[d0],0,0,0);
    o[d0]=__builtin_amdgcn_mfma_f32_32x32x16_bf16(pa2,PK(2),o[d0],0,0,0);
    o[d0]=__builtin_amdgcn_mfma_f32_32x32x16_bf16(pa3,PK(3),o[d0],0,0,0);
    #undef PK
  }
}

#ifndef ATTN_STORE16
#define ATTN_STORE16(p,v) (*(u32x4*)(p)=(v))
#endif
template<int THRL> __device__ __forceinline__ void attn_unit(int b,int g,int qb,const bf16*__restrict__ Zb,bf16*O,const float*__restrict__ btab,char*shm){
  int tid_=threadIdx.x; asm volatile("":"+v"(tid_)); const int tid=tid_,lane=tid&63,r32=lane&31,hi=lane>>5; const int wid=__builtin_amdgcn_readfirstlane(tid>>6);
  const long rowbase=(long)b*SEQ; const int q0=qb*QB;
  const int hm=g>>1;
  const float btv=(tid<384)?btab[hm*384+tid]:0.f;
  const bf16*Qw=Zb+(rowbase+q0+wid*QBLK)*DM+hm*D;
  const bf16*Kh=Zb+rowbase*DM+512+hm*D,*Vh=Zb+rowbase*DM+1024+(g>>2)*128+(g&1)*64;
  const unsigned lds0=(unsigned)(uintptr_t)shm;
  float*wsf=(float*)(shm+LDS_WS)+wid*64;
  const bf16*ksrc=Kh+(long)lane*DM+wid*8;
  const bf16*vsrc=Vh+(long)(16*(wid&3)+(lane>>2))*DM+(wid>>2)*32+(lane&3)*8;
  const unsigned kdst=lds0+LDS_K+wid*1024, vdst=lds0+LDS_V+wid*1024;
  #define DMA_K(t,slot) glds16(ksrc+(long)(t)*KVBLK*DM,(unsigned)__builtin_amdgcn_readfirstlane(kdst+(slot)))
  #define DMA_V(t,slot) glds16(vsrc+(long)(t)*KVBLK*DM,(unsigned)__builtin_amdgcn_readfirstlane(vdst+(slot)))
  const int vb0=(int)(lds0+LDS_V)+((lane>>4)&1)*32+(lane&3)*8+(4*hi+((lane&15)>>2))*64;
  const char*Kbase=shm+LDS_K; bf16x8 kf[8];
  const lds_cptr shm3=(lds_cptr)shm; const lds_cptr kp0=shm3+LDS_K+hi*1024+r32*16; const lds_cptr vp0=shm3+LDS_V+((lane>>4)&1)*32+(lane&3)*8+(4*hi+((lane&15)>>2))*64;
  const int NT=(q0+QB)/KVBLK;
  DMA_K(0,0);DMA_V(0,0);DMA_K(1,SLOTB);
  bf16x8 qr[4];
  #pragma unroll
  for(int d0=0;d0<4;++d0)qr[d0]=*reinterpret_cast<const bf16x8*>(&Qw[(long)r32*DM+d0*16+hi*8]);
  const lds_cfptr btl=(lds_cfptr)((lds_cptr)shm+LDS_BT); if(tid<384)((__attribute__((address_space(3))) float*)((__attribute__((address_space(3))) char*)shm+LDS_BT))[tid]=btv;
  float mhat=0.f,l_reg=0.f;f32x16 o[2];o[0]=f32x16{};o[1]=f32x16{};f32x16 negm=f32x16{};asm volatile("":"+v"(negm));
  const int qrel=wid*QBLK+r32;
  #define CMASK(P0,P1,t) do{int jb_=(t)-(NT-4); if(jb_>=-2)cmask(P0,P1,jb_,qrel,hi,btl);}while(0)
  bool resc=false;
  #define START(P0,P1) do{ const float rm=rowmax(P0,P1); resc=false; \
    { const float dl=rm; mhat=fadd_s(mhat,dl); \
      _Pragma("unroll") for(int r=0;r<16;++r){P0[r]=fsub_s(P0[r],dl);P1[r]=fsub_s(P1[r],dl);} \
      _Pragma("unroll") for(int r=0;r<16;++r)negm[r]=-mhat; asm volatile("":"+v"(negm)); } \
    _Pragma("unroll") for(int r=0;r<16;++r)P0[r]=__builtin_amdgcn_exp2f(P0[r]); }while(0)
  #define RESC() do{ if(resc){ asm volatile("s_waitcnt lgkmcnt(0)":::"memory"); \
      _Pragma("unroll") for(int d_=0;d_<2;++d_) _Pragma("unroll") for(int r=0;r<16;++r)o[d_][r]*=wsf[crow(r,hi)]; } }while(0)
  f32x16 pA0,pA1,pB0,pB1;
  int sl_prev=0,sl_cur=0,sl_next=SLOTB;
  #define ROT() do{sl_prev=sl_cur;sl_cur=sl_next;sl_next=(sl_next==(NSLOT-1)*SLOTB)?0:sl_next+SLOTB;}while(0)
  DMA_K(2,2*SLOTB);
  WAIT_BAR(3);
  qkt(pA0,pA1,Kbase,qr,negm,r32,hi);asm volatile("s_nop 15\n\ts_nop 7":"+v"(pA0),"+v"(pA1));CMASK(pA0,pA1,0);
  START(pA0,pA1);
  _Pragma("unroll") for(int r=0;r<16;++r)pA1[r]=__builtin_amdgcn_exp2f(pA1[r]);
  WAIT_BAR(0);
  DMA_K(3,0);DMA_V(1,SLOTB);
  ROT();
  kload8(kf,kp0+sl_cur);
  WAIT_BAR(2);
  s16x4 vlo[8],vhi[8]; u32x4 pw0,pw1,pw2,pw3;
  #define PKW(P,B) cvtpk_s(P[B],P[B+1])
  #define PAF(k) __builtin_bit_cast(bf16x8,pw##k)
  #define VFR(i) (bf16x8){vlo[i][0],vlo[i][1],vlo[i][2],vlo[i][3],vhi[i][0],vhi[i][1],vhi[i][2],vhi[i][3]}
  #define PIN(x) asm volatile("":"+v"(x))
  #define MX3(a,b,c) __builtin_fmaxf(__builtin_fmaxf((a),(b)),(c))
  #define GAPA(MF,A0,A1,A2,A3,W0,W1,PW) do{ MF; sacc+=A0; sacc+=A1; sacc+=A2; sacc+=A3; PIN(sacc); W0; W1; PIN(PW); SBAR(); }while(0)
  #define EX(v) __builtin_amdgcn_exp2f(v)
  #define GAPB(MF,X,B) do{ MF; X[B]=EX(X[B]); X[B+1]=EX(X[B+1]); X[B+2]=EX(X[B+2]); X[B+3]=EX(X[B+3]); PIN(X); SBAR(); }while(0)
  #define VRD(i) do{ vlo[i]=vtr(vp_+(((i)>>2)*4096+((i)&3)*1024)); vhi[i]=vtr(vp_+(((i)>>2)*4096+((i)&3)*1024+512)); }while(0)
  #define KRD(G,j) do{ if(G){ kload2(kf,kp0+sl_next,j); SBAR(); } }while(0)
  #define STEP(C0,C1,P0,P1,t,GK,GV,GL) do{ SBAR(); \
    const lds_cptr vp_=vp0+sl_prev; \
    VRD(0); SBAR(); float sacc=(P0[0]+P0[1]); \
    GAPA(C0=__builtin_amdgcn_mfma_f32_32x32x16_bf16(kf[0],qr[0],negm,0,0,0), P0[2],P0[3],P0[4],P0[5],     pw0[0]=PKW(P0,0), pw0[1]=PKW(P0,2), pw0); \
    VRD(4); SBAR(); GAPA(C1=__builtin_amdgcn_mfma_f32_32x32x16_bf16(kf[1],qr[0],negm,0,0,0), P0[6],P0[7],P0[8],P0[9],     pw0[2]=PKW(P0,4), pw0[3]=PKW(P0,6), pw0); \
    VRD(1); SBAR(); GAPA(C0=__builtin_amdgcn_mfma_f32_32x32x16_bf16(kf[2],qr[1],C0,0,0,0),   P0[10],P0[11],P0[12],P0[13], pw1[0]=PKW(P0,8), pw1[1]=PKW(P0,10), pw1); \
    VRD(5); SBAR(); GAPA(C1=__builtin_amdgcn_mfma_f32_32x32x16_bf16(kf[3],qr[1],C1,0,0,0),   P0[14],P0[15],P1[0],P1[1],   pw1[2]=PKW(P0,12),pw1[3]=PKW(P0,14), pw1); \
    VRD(2); SBAR(); GAPA(C0=__builtin_amdgcn_mfma_f32_32x32x16_bf16(kf[4],qr[2],C0,0,0,0),   P1[2],P1[3],P1[4],P1[5],     pw2[0]=PKW(P1,0), pw2[1]=PKW(P1,2), pw2); \
    VRD(6); SBAR(); GAPA(C1=__builtin_amdgcn_mfma_f32_32x32x16_bf16(kf[5],qr[2],C1,0,0,0),   P1[6],P1[7],P1[8],P1[9],     pw2[2]=PKW(P1,4), pw2[3]=PKW(P1,6), pw2); \
    VRD(3); SBAR(); GAPA(C0=__builtin_amdgcn_mfma_f32_32x32x16_bf16(kf[6],qr[3],C0,0,0,0),   P1[10],P1[11],P1[12],P1[13], pw3[0]=PKW(P1,8), pw3[1]=PKW(P1,10), pw3); \
    VRD(7); SBAR(); GAPA(C1=__builtin_amdgcn_mfma_f32_32x32x16_bf16(kf[7],qr[3],C1,0,0,0),   P1[14],P1[15],0.f,0.f,       pw3[2]=PKW(P1,12),pw3[3]=PKW(P1,14), pw3); \
    l_reg+=sacc; \
    if(GK){DMA_K((t)+3,sl_cur);} if(GV){DMA_V((t)+1,sl_next);} \
    CMASK(C0,C1,t); \
    { float a=MX3(C0[0],C0[1],C1[0]),b=MX3(C0[2],C0[3],C1[1]); a=MX3(a,C1[2],C1[3]); \
      _Pragma("unroll") for(int r=4;r<16;r+=4){a=MX3(a,C0[r],C0[r+1]);b=MX3(b,C0[r+2],C0[r+3]);a=MX3(a,C1[r],C1[r+1]);b=MX3(b,C1[r+2],C1[r+3]);} \
      float rm=__builtin_fmaxf(a,b); { auto rr=__builtin_amdgcn_permlane32_swap(__float_as_uint(rm),__float_as_uint(rm),false,false); rm=__builtin_fmaxf(__uint_as_float(rr[0]),__uint_as_float(rr[1])); } \
      resc=false; \
      if(__builtin_expect(__any(rm>(float)THRL),0)){ const float dl=__builtin_fmaxf(rm,0.f); mhat+=dl; \
        _Pragma("unroll") for(int r=0;r<16;++r){C0[r]-=dl;C1[r]-=dl;} \
        _Pragma("unroll") for(int r=0;r<16;++r)negm[r]=-mhat; asm volatile("":"+v"(negm)); \
        const float f=__builtin_amdgcn_exp2f(-dl); l_reg*=f; if(hi==0)wsf[r32]=f; resc=true; } } \
    SBAR(); \
    GAPB(o[0]=__builtin_amdgcn_mfma_f32_32x32x16_bf16(PAF(0),VFR(0),o[0],0,0,0), C0,0); \
    GAPB(o[1]=__builtin_amdgcn_mfma_f32_32x32x16_bf16(PAF(0),VFR(4),o[1],0,0,0), C0,4); \
    KRD(GL,0); GAPB(o[0]=__builtin_amdgcn_mfma_f32_32x32x16_bf16(PAF(1),VFR(1),o[0],0,0,0), C0,8); \
    KRD(GL,1); GAPB(o[1]=__builtin_amdgcn_mfma_f32_32x32x16_bf16(PAF(1),VFR(5),o[1],0,0,0), C0,12); \
    KRD(GL,2); GAPB(o[0]=__builtin_amdgcn_mfma_f32_32x32x16_bf16(PAF(2),VFR(2),o[0],0,0,0), C1,0); \
    KRD(GL,3); GAPB(o[1]=__builtin_amdgcn_mfma_f32_32x32x16_bf16(PAF(2),VFR(6),o[1],0,0,0), C1,4); \
    GAPB(o[0]=__builtin_amdgcn_mfma_f32_32x32x16_bf16(PAF(3),VFR(3),o[0],0,0,0), C1,8); \
    GAPB(o[1]=__builtin_amdgcn_mfma_f32_32x32x16_bf16(PAF(3),VFR(7),o[1],0,0,0), C1,12); \
    }while(0)
  int t=1;
  #undef CMASK
  #define CMASK(P0,P1,t) do{int jb_=(t)-(NT-4); if(jb_>=-2)cmask(P0,P1,jb_,qrel,hi,btl);}while(0)
  for(;t+5<NT;t+=2){
    STEP(pB0,pB1,pA0,pA1,t,true,true,true);     WAIT_BAR(2); RESC(); ROT();
    STEP(pA0,pA1,pB0,pB1,t+1,true,true,true);   WAIT_BAR(2); RESC(); ROT();
  }
  #undef CMASK
  #define CMASK(P0,P1,t) do{int jb_=(t)-(NT-4); if(jb_>=-2)cmask(P0,P1,jb_,qrel,hi,btl);}while(0)
  #define ENDW(tt) do{ if((tt)+3<NT){WAIT_BAR(2);} else if((tt)+2<NT){WAIT_BAR(1);} else {WAIT_BAR(0);} }while(0)
  for(;t+1<NT;t+=2){
    STEP(pB0,pB1,pA0,pA1,t,(t+3<NT),(t+1<NT),(t+1<NT));       ENDW(t);   RESC(); ROT();
    STEP(pA0,pA1,pB0,pB1,t+1,(t+4<NT),(t+2<NT),(t+2<NT));     ENDW(t+1); RESC(); ROT();
  }
  STEP(pB0,pB1,pA0,pA1,NT-1,false,false,false); RESC();
  { float sacc=pB0[0]+pB0[1]; _Pragma("unroll") for(int r=2;r<16;++r)sacc+=pB0[r]; _Pragma("unroll") for(int r=0;r<16;++r)sacc+=pB1[r]; l_reg+=sacc;
    pw0=(u32x4){PKW(pB0,0),PKW(pB0,2),PKW(pB0,4),PKW(pB0,6)};pw1=(u32x4){PKW(pB0,8),PKW(pB0,10),PKW(pB0,12),PKW(pB0,14)};pw2=(u32x4){PKW(pB1,0),PKW(pB1,2),PKW(pB1,4),PKW(pB1,6)};pw3=(u32x4){PKW(pB1,8),PKW(pB1,10),PKW(pB1,12),PKW(pB1,14)};
    SBAR(); pv(o,vb0+sl_cur,PAF(0),PAF(1),PAF(2),PAF(3)); }
  #undef PKW
  #undef PAF
  #undef VFR
  #undef PIN
  #undef MX3
  #undef GAPA
  #undef GAPB
  #undef EX
  #undef VRD
  #undef KRD
  #undef STEP
  #undef ENDW
  {auto rr=__builtin_amdgcn_permlane32_swap(__float_as_uint(l_reg),__float_as_uint(l_reg),false,false);l_reg=__uint_as_float(rr[0])+__uint_as_float(rr[1]);}
  if(hi==0)wsf[32+r32]=l_reg;asm volatile("s_waitcnt lgkmcnt(0)":::"memory");
  float rli[16];
  #pragma unroll
  for(int r=0;r<16;++r)rli[r]=__builtin_amdgcn_rcpf(wsf[32+crow(r,hi)]);
  bf16*Ow=O+(rowbase+q0+wid*QBLK)*OP+g*D;
  { bf16*stg=(bf16*)(shm+LDS_OST)+wid*2048;
    #pragma unroll
    for(int r=0;r<16;++r){const int orow=crow(r,hi);
      #pragma unroll
      for(int d0=0;d0<2;++d0)stg[orow*64+d0*32+r32]=__float2bfloat16(o[d0][r]*rli[r]);}
    asm volatile("s_waitcnt lgkmcnt(0)":::"memory");
    #pragma unroll
    for(int i=0;i<4;++i){const int row=i*8+(lane>>3),ch=lane&7; const u32x4 v=*(const u32x4*)(stg+row*64+ch*8); ATTN_STORE16(Ow+(long)row*OP+ch*8,v);} }
  asm volatile("s_waitcnt lgkmcnt(0)\n\ts_barrier":::"memory");
  #undef DMA_K
  #undef DMA_V
  #undef CMASK
  #undef START
  #undef RESC
  #undef ROT
}
constexpr int ATTN_LDS_BYTES=LDS_BYTES;
struct AttnTensors { const bf16* Z; bf16* O; const float* btab; };
struct AttnUnit { int bh; int qb; };
struct StaticOrder {
  int vcu;
  __device__ __forceinline__ explicit StaticOrder(int grid,int block):vcu((block%8)*(grid/8)+block/8){}
  __device__ __forceinline__ bool next(int i,AttnUnit&u)const{ if(i>=4)return false; const int s=vcu&3; u.bh=vcu>>2; u.qb=(i==0)?15-s:(i==1)?8+s:(i==2)?7-s:s; return true; }
  __device__ __forceinline__ void a_ready(const AttnUnit&)const{}
  __device__ __forceinline__ void done(const AttnUnit&)const{}
};
template<class Sched,int THRL=8> __device__ __forceinline__ void attn_phase(char*lds,const AttnTensors&T,const Sched&S){
  AttnUnit u;
  for(int i=0;S.next(i,u);++i){ S.a_ready(u); attn_unit<THRL>(u.bh/NHEAD,u.bh%NHEAD,u.qb,T.Z,T.O,T.btab,lds); S.done(u); }
}
#undef SBAR
#undef WAIT_BAR
}
namespace attn128 {
using bf16=__hip_bfloat16;
using bf16x8=__attribute__((ext_vector_type(8)))short;
using s16x4=__attribute__((ext_vector_type(4)))short;
using f32x16=__attribute__((ext_vector_type(16)))float;
using u32x4=__attribute__((ext_vector_type(4)))unsigned;
constexpr int BATCH=4,NHEAD=16,SEQ=4096,D=64,DM=2816,OP=1024;
constexpr int NW=8,QBLK=32,QB=QBLK*NW,KVBLK=64,NQB=SEQ/QB;
constexpr int ATTN_PITCH=DM, ATTN_UNIT_ROWS=QB;
__device__ __forceinline__ int crow(int r,int hi){return (r&3)+8*(r>>2)+4*hi;}
#define SBAR() __builtin_amdgcn_sched_barrier(0)
typedef __attribute__((address_space(3))) const float* lds_cfptr;
__device__ __forceinline__ void cmask(f32x16&p0,f32x16&p1,int jb,int qrel,int hi,lds_cfptr bt){
  const float NEG=-INFINITY; const int d00=qrel-(64*jb+4*hi);
  #pragma unroll
  for(int r=0;r<16;++r){const int d0=d00-((r&3)+8*(r>>2)), d1=d0-32;
    p0[r]+=bt[d0<0?0:d0]; p1[r]+=bt[d1<0?0:d1]; if(d0<0)p0[r]=NEG; if(d1<0)p1[r]=NEG;
    if((r&3)==3)__builtin_amdgcn_sched_barrier(0);}
}

constexpr int NSLOT=3, SLOTB=8192;
constexpr int LDS_K=0, LDS_V=NSLOT*SLOTB, LDS_WS=3*NSLOT*SLOTB, LDS_OST=LDS_WS+NW*64*4, LDS_BT=LDS_OST+NW*4096, LDS_BYTES=LDS_BT+1536;
constexpr float C2=0.125f*1.4426950408889634f;
__device__ __forceinline__ void glds16(const void*gsrc,unsigned lds_dst){unsigned keep;
  asm volatile("s_mov_b32 %0, m0\n\ts_mov_b32 m0, %2\n\ts_nop 0\n\tglobal_load_lds_dwordx4 %1, off\n\ts_mov_b32 m0, %0":"=&s"(keep):"v"(gsrc),"s"(lds_dst):"memory");}
__device__ __forceinline__ float max3f(float a,float b,float c){float r;asm("v_max3_f32 %0, %1, %2, %3":"=v"(r):"v"(a),"v"(b),"v"(c));return r;}
__device__ __forceinline__ float max2f(float a,float b){float r;asm("v_max_f32_e32 %0, %1, %2":"=v"(r):"v"(a),"v"(b));return r;}
__device__ __forceinline__ float fadd_s(float a,float b){float r;asm("v_add_f32_e32 %0, %1, %2":"=v"(r):"v"(a),"v"(b));return r;}
__device__ __forceinline__ float fsub_s(float a,float b){float r;asm("v_sub_f32_e32 %0, %1, %2":"=v"(r):"v"(a),"v"(b));return r;}
typedef float f32x2_t __attribute__((ext_vector_type(2))); typedef __bf16 bf16x2_t __attribute__((ext_vector_type(2)));
__device__ __forceinline__ unsigned cvtpk_s(float lo,float hi){f32x2_t v={lo,hi};bf16x2_t b=__builtin_convertvector(v,bf16x2_t);return __builtin_bit_cast(unsigned,b);}
#define WAIT_BAR(N) asm volatile("s_waitcnt vmcnt(" #N ") lgkmcnt(0)\n\ts_barrier":::"memory")

__device__ __forceinline__ void qkt(f32x16&p0,f32x16&p1,const char*Kslot,const bf16x8*qr,int r32,int hi){
  const char*kb=Kslot+hi*1024+r32*16;
  #pragma unroll
  for(int d0=0;d0<4;++d0){
    const bf16x8 b0=*reinterpret_cast<const bf16x8*>(kb+d0*2048);
    const bf16x8 b1=*reinterpret_cast<const bf16x8*>(kb+d0*2048+512);
    if(d0==0){p0=__builtin_amdgcn_mfma_f32_32x32x16_bf16(b0,qr[0],f32x16{},0,0,0);p1=__builtin_amdgcn_mfma_f32_32x32x16_bf16(b1,qr[0],f32x16{},0,0,0);}
    else{p0=__builtin_amdgcn_mfma_f32_32x32x16_bf16(b0,qr[d0],p0,0,0,0);p1=__builtin_amdgcn_mfma_f32_32x32x16_bf16(b1,qr[d0],p1,0,0,0);}}
}
typedef __attribute__((address_space(3))) const char* lds_cptr;
typedef short v4i16_t __attribute__((ext_vector_type(4)));
__device__ __forceinline__ void kload8(bf16x8*kf,lds_cptr kp){
  kf[0]=*(const __attribute__((address_space(3))) bf16x8*)(kp);      kf[1]=*(const __attribute__((address_space(3))) bf16x8*)(kp+512);
  kf[2]=*(const __attribute__((address_space(3))) bf16x8*)(kp+2048); kf[3]=*(const __attribute__((address_space(3))) bf16x8*)(kp+2560);
  kf[4]=*(const __attribute__((address_space(3))) bf16x8*)(kp+4096); kf[5]=*(const __attribute__((address_space(3))) bf16x8*)(kp+4608);
  kf[6]=*(const __attribute__((address_space(3))) bf16x8*)(kp+6144); kf[7]=*(const __attribute__((address_space(3))) bf16x8*)(kp+6656);
}
__device__ __forceinline__ void kload2(bf16x8*kf,lds_cptr kp,int j){ kf[2*j]=*(const __attribute__((address_space(3))) bf16x8*)(kp+j*2048); kf[2*j+1]=*(const __attribute__((address_space(3))) bf16x8*)(kp+j*2048+512); }
__device__ __forceinline__ s16x4 vtr(lds_cptr p){ return __builtin_bit_cast(s16x4,__builtin_amdgcn_ds_read_tr16_b64_v4i16((__attribute__((address_space(3))) v4i16_t*)p)); }
__device__ __forceinline__ float rowmax(const f32x16&p0,const f32x16&p1){
  float a=max3f(p0[0],p0[1],p1[0]),b=max3f(p0[2],p0[3],p1[1]);a=max3f(a,p1[2],p1[3]);
  #pragma unroll
  for(int r=4;r<16;r+=4){a=max3f(a,p0[r],p0[r+1]);b=max3f(b,p0[r+2],p0[r+3]);a=max3f(a,p1[r],p1[r+1]);b=max3f(b,p1[r+2],p1[r+3]);}
  const float m=max2f(a,b);
  auto rr=__builtin_amdgcn_permlane32_swap(__float_as_uint(m),__float_as_uint(m),false,false);
  return max2f(__uint_as_float(rr[0]),__uint_as_float(rr[1]));
}
__device__ __forceinline__ void pv(f32x16*o,int vb,bf16x8 pa0,bf16x8 pa1,bf16x8 pa2,bf16x8 pa3){
  #pragma unroll
  for(int d0=0;d0<4;++d0){s16x4 lo[4],hi[4];
    #pragma unroll
    for(int ks=0;ks<4;++ks){
      asm volatile("ds_read_b64_tr_b16 %0,%1 offset:%c2":"=&v"(lo[ks]):"v"(vb),"i"(d0*4096+ks*1024):"memory");
      asm volatile("ds_read_b64_tr_b16 %0,%1 offset:%c2":"=&v"(hi[ks]):"v"(vb),"i"(d0*4096+ks*1024+512):"memory");}
    asm volatile("s_waitcnt lgkmcnt(0)":::"memory");SBAR();
    #define PK(k) (bf16x8){lo[k][0],lo[k][1],lo[k][2],lo[k][3],hi[k][0],hi[k][1],hi[k][2],hi[k][3]}
    o[d0]=__builtin_amdgcn_mfma_f32_32x32x16_bf16(pa0,PK(0),o[d0],0,0,0);
    o[d0]=__builtin_amdgcn_mfma_f32_32x32x16_bf16(pa1,PK(1),o[d0],0,0,0);
    o[d0]=__builtin_amdgcn_mfma_f32_32x32x16_bf16(pa2,PK(2),o[d0],0,0,0);
    o[d0]=__builtin_amdgcn_mfma_f32_32x32x16_bf16(pa3,PK(3),o[d0],0,0,0);
    #undef PK
  }
}

#undef ATTN_STORE16
#define ATTN_STORE16(p,v) (*(u32x4*)(p)=(v))
template<int THRL> __device__ __forceinline__ void attn_unit(int b,int hm,int qb,const bf16*__restrict__ Zb,bf16*O,const float*__restrict__ btab,char*shm){
  int tid_=threadIdx.x; asm volatile("":"+v"(tid_)); const int tid=tid_,lane=tid&63,r32=lane&31,hi=lane>>5; const int wid=__builtin_amdgcn_readfirstlane(tid>>6);
  const long rowbase=(long)b*SEQ; const int q0=qb*QB;
  const float btv=(tid<384)?btab[hm*384+tid]:0.f;
  const bf16*Qw=Zb+(rowbase+q0+wid*QBLK)*DM+hm*D;
  const bf16*Kh=Zb+rowbase*DM+512+hm*D,*Vh=Zb+rowbase*DM+1024+(hm>>1)*128;
  const unsigned lds0=(unsigned)(uintptr_t)shm;
  float*wsf=(float*)(shm+LDS_WS)+wid*64;
  const bf16*ksrc=Kh+(long)lane*DM+wid*8;
  const bf16*vsrc=Vh+(long)(16*(wid&3)+(lane>>2))*DM+(wid>>2)*32+(lane&3)*8;
  const unsigned kdst=lds0+LDS_K+wid*1024, vdst=lds0+LDS_V+wid*1024;
  #define DMA_K(t,slot) glds16(ksrc+(long)(t)*KVBLK*DM,(unsigned)__builtin_amdgcn_readfirstlane(kdst+(slot)))
  #define DMA_V(t,slot) do{ glds16(vsrc+(long)(t)*KVBLK*DM,(unsigned)__builtin_amdgcn_readfirstlane(vdst+2*(slot))); glds16(vsrc+(long)(t)*KVBLK*DM+64,(unsigned)__builtin_amdgcn_readfirstlane(vdst+2*(slot)+8192)); }while(0)
  const int vb0=(int)(lds0+LDS_V)+((lane>>4)&1)*32+(lane&3)*8+(4*hi+((lane&15)>>2))*64;
  const char*Kbase=shm+LDS_K; bf16x8 kf[8];
  const lds_cptr shm3=(lds_cptr)shm; const lds_cptr kp0=shm3+LDS_K+hi*1024+r32*16; const lds_cptr vp0=shm3+LDS_V+((lane>>4)&1)*32+(lane&3)*8+(4*hi+((lane&15)>>2))*64;
  const int NT=(q0+QB)/KVBLK;
  DMA_K(0,0);DMA_V(0,0);DMA_K(1,SLOTB);
  bf16x8 qr[4];
  #pragma unroll
  for(int d0=0;d0<4;++d0)qr[d0]=*reinterpret_cast<const bf16x8*>(&Qw[(long)r32*DM+d0*16+hi*8]);
  const lds_cfptr btl=(lds_cfptr)((lds_cptr)shm+LDS_BT); if(tid<384)((__attribute__((address_space(3))) float*)((__attribute__((address_space(3))) char*)shm+LDS_BT))[tid]=btv;
  float mhat=0.f,l_reg=0.f;f32x16 o[4];o[0]=f32x16{};o[1]=f32x16{};o[2]=f32x16{};o[3]=f32x16{};
  const int qrel=wid*QBLK+r32;
  #define CMASK(P0,P1,t) do{int jb_=(t)-(NT-4); if(jb_>=-2)cmask(P0,P1,jb_,qrel,hi,btl);}while(0)
  bool resc=false;
  #define START(P0,P1) do{ const float rm=rowmax(P0,P1); resc=false; mhat=rm; \
    _Pragma("unroll") for(int r=0;r<16;++r)P0[r]=__builtin_amdgcn_exp2f(P0[r]-mhat); }while(0)
  #define RESC() do{ if(resc){ asm volatile("s_waitcnt lgkmcnt(0)":::"memory"); \
      _Pragma("unroll") for(int d_=0;d_<4;++d_) _Pragma("unroll") for(int r=0;r<16;++r)o[d_][r]*=wsf[crow(r,hi)]; } }while(0)
  f32x16 pA0,pA1,pB0,pB1;
  int sl_prev=0,sl_cur=0,sl_next=SLOTB;
  #define ROT() do{sl_prev=sl_cur;sl_cur=sl_next;sl_next=(sl_next==(NSLOT-1)*SLOTB)?0:sl_next+SLOTB;}while(0)
  DMA_K(2,2*SLOTB);
  WAIT_BAR(4);
  qkt(pA0,pA1,Kbase,qr,r32,hi);asm volatile("s_nop 15\n\ts_nop 7":"+v"(pA0),"+v"(pA1));CMASK(pA0,pA1,0);
  START(pA0,pA1);
  _Pragma("unroll") for(int r=0;r<16;++r)pA1[r]=__builtin_amdgcn_exp2f(pA1[r]-mhat);
  WAIT_BAR(0);
  DMA_K(3,0);DMA_V(1,SLOTB);
  ROT();
  kload8(kf,kp0+sl_cur);
  WAIT_BAR(3);
  s16x4 vlo[8],vhi[8]; u32x4 pw0,pw1,pw2,pw3;
  #define PKW(P,B) cvtpk_s(P[B],P[B+1])
  #define PAF(k) __builtin_bit_cast(bf16x8,pw##k)
  #define VFR(i) (bf16x8){vlo[i][0],vlo[i][1],vlo[i][2],vlo[i][3],vhi[i][0],vhi[i][1],vhi[i][2],vhi[i][3]}
  #define PIN(x) asm volatile("":"+v"(x))
  #define MX3(a,b,c) __builtin_fmaxf(__builtin_fmaxf((a),(b)),(c))
  #define GAPA(MF,A0,A1,A2,A3,W0,W1,PW) do{ MF; sacc+=A0; sacc+=A1; sacc+=A2; sacc+=A3; PIN(sacc); W0; W1; PIN(PW); SBAR(); }while(0)
  #define EX(v) __builtin_amdgcn_exp2f(v)
  #define GAPB(MF,X,B) do{ MF; X[B]=EX(X[B]-mhat); X[B+1]=EX(X[B+1]-mhat); X[B+2]=EX(X[B+2]-mhat); X[B+3]=EX(X[B+3]-mhat); PIN(X); SBAR(); }while(0)
  #define VRD2(i) do{ vlo[i]=vtr(vp_+(8192+((i)>>2)*4096+((i)&3)*1024)); vhi[i]=vtr(vp_+(8192+((i)>>2)*4096+((i)&3)*1024+512)); SBAR(); }while(0)
  #define GAPE(MF,X,B) do{ MF; X[B]=EX(X[B]-mhat); X[B+1]=EX(X[B+1]-mhat); PIN(X); SBAR(); }while(0)
  #define VRD(i) do{ vlo[i]=vtr(vp_+(((i)>>2)*4096+((i)&3)*1024)); vhi[i]=vtr(vp_+(((i)>>2)*4096+((i)&3)*1024+512)); }while(0)
  #define KRD(G,j) do{ if(G){ kload2(kf,kp0+sl_next,j); SBAR(); } }while(0)
  #define STEP(C0,C1,P0,P1,t,GK,GV,GL) do{ SBAR(); \
    const lds_cptr vp_=vp0+2*sl_prev; \
    VRD(0); SBAR(); float sacc=(P0[0]+P0[1]); \
    GAPA(C0=__builtin_amdgcn_mfma_f32_32x32x16_bf16(kf[0],qr[0],f32x16{},0,0,0), P0[2],P0[3],P0[4],P0[5],     pw0[0]=PKW(P0,0), pw0[1]=PKW(P0,2), pw0); \
    VRD(4); SBAR(); GAPA(C1=__builtin_amdgcn_mfma_f32_32x32x16_bf16(kf[1],qr[0],f32x16{},0,0,0), P0[6],P0[7],P0[8],P0[9],     pw0[2]=PKW(P0,4), pw0[3]=PKW(P0,6), pw0); \
    VRD(1); SBAR(); GAPA(C0=__builtin_amdgcn_mfma_f32_32x32x16_bf16(kf[2],qr[1],C0,0,0,0),   P0[10],P0[11],P0[12],P0[13], pw1[0]=PKW(P0,8), pw1[1]=PKW(P0,10), pw1); \
    VRD(5); SBAR(); GAPA(C1=__builtin_amdgcn_mfma_f32_32x32x16_bf16(kf[3],qr[1],C1,0,0,0),   P0[14],P0[15],P1[0],P1[1],   pw1[2]=PKW(P0,12),pw1[3]=PKW(P0,14), pw1); \
    VRD(2); SBAR(); GAPA(C0=__builtin_amdgcn_mfma_f32_32x32x16_bf16(kf[4],qr[2],C0,0,0,0),   P1[2],P1[3],P1[4],P1[5],     pw2[0]=PKW(P1,0), pw2[1]=PKW(P1,2), pw2); \
    VRD(6); SBAR(); GAPA(C1=__builtin_amdgcn_mfma_f32_32x32x16_bf16(kf[5],qr[2],C1,0,0,0),   P1[6],P1[7],P1[8],P1[9],     pw2[2]=PKW(P1,4), pw2[3]=PKW(P1,6), pw2); \
    VRD(3); SBAR(); GAPA(C0=__builtin_amdgcn_mfma_f32_32x32x16_bf16(kf[6],qr[3],C0,0,0,0),   P1[10],P1[11],P1[12],P1[13], pw3[0]=PKW(P1,8), pw3[1]=PKW(P1,10), pw3); \
    VRD(7); SBAR(); GAPA(C1=__builtin_amdgcn_mfma_f32_32x32x16_bf16(kf[7],qr[3],C1,0,0,0),   P1[14],P1[15],0.f,0.f,       pw3[2]=PKW(P1,12),pw3[3]=PKW(P1,14), pw3); \
    l_reg+=sacc; \
    if(GK){DMA_K((t)+3,sl_cur);} if(GV){DMA_V((t)+1,sl_next);} \
    CMASK(C0,C1,t); \
    { float a=MX3(C0[0],C0[1],C1[0]),b=MX3(C0[2],C0[3],C1[1]); a=MX3(a,C1[2],C1[3]); \
      _Pragma("unroll") for(int r=4;r<16;r+=4){a=MX3(a,C0[r],C0[r+1]);b=MX3(b,C0[r+2],C0[r+3]);a=MX3(a,C1[r],C1[r+1]);b=MX3(b,C1[r+2],C1[r+3]);} \
      float rm=__builtin_fmaxf(a,b); { auto rr=__builtin_amdgcn_permlane32_swap(__float_as_uint(rm),__float_as_uint(rm),false,false); rm=__builtin_fmaxf(__uint_as_float(rr[0]),__uint_as_float(rr[1])); } \
      resc=false; \
      rm-=mhat; \
      if(__builtin_expect(__any(rm>(float)THRL),0)){ const float dl=__builtin_fmaxf(rm,0.f); mhat+=dl; \
        const float f=__builtin_amdgcn_exp2f(-dl); l_reg*=f; if(hi==0)wsf[r32]=f; resc=true; } } \
    SBAR(); \
    GAPE(o[0]=__builtin_amdgcn_mfma_f32_32x32x16_bf16(PAF(0),VFR(0),o[0],0,0,0), C0,0); VRD2(0); \
    GAPE(o[1]=__builtin_amdgcn_mfma_f32_32x32x16_bf16(PAF(0),VFR(4),o[1],0,0,0), C0,2); VRD2(4); \
    GAPE(o[0]=__builtin_amdgcn_mfma_f32_32x32x16_bf16(PAF(1),VFR(1),o[0],0,0,0), C0,4); VRD2(1); \
    GAPE(o[1]=__builtin_amdgcn_mfma_f32_32x32x16_bf16(PAF(1),VFR(5),o[1],0,0,0), C0,6); VRD2(5); \
    GAPE(o[0]=__builtin_amdgcn_mfma_f32_32x32x16_bf16(PAF(2),VFR(2),o[0],0,0,0), C0,8); VRD2(2); \
    GAPE(o[1]=__builtin_amdgcn_mfma_f32_32x32x16_bf16(PAF(2),VFR(6),o[1],0,0,0), C0,10); VRD2(6); \
    GAPE(o[0]=__builtin_amdgcn_mfma_f32_32x32x16_bf16(PAF(3),VFR(3),o[0],0,0,0), C0,12); VRD2(3); \
    GAPE(o[1]=__builtin_amdgcn_mfma_f32_32x32x16_bf16(PAF(3),VFR(7),o[1],0,0,0), C0,14); VRD2(7); \
    KRD(GL,0); GAPE(o[2]=__builtin_amdgcn_mfma_f32_32x32x16_bf16(PAF(0),VFR(0),o[2],0,0,0), C1,0); \
    KRD(GL,1); GAPE(o[3]=__builtin_amdgcn_mfma_f32_32x32x16_bf16(PAF(0),VFR(4),o[3],0,0,0), C1,2); \
    KRD(GL,2); GAPE(o[2]=__builtin_amdgcn_mfma_f32_32x32x16_bf16(PAF(1),VFR(1),o[2],0,0,0), C1,4); \
    KRD(GL,3); GAPE(o[3]=__builtin_amdgcn_mfma_f32_32x32x16_bf16(PAF(1),VFR(5),o[3],0,0,0), C1,6); \
    GAPE(o[2]=__builtin_amdgcn_mfma_f32_32x32x16_bf16(PAF(2),VFR(2),o[2],0,0,0), C1,8); \
    GAPE(o[3]=__builtin_amdgcn_mfma_f32_32x32x16_bf16(PAF(2),VFR(6),o[3],0,0,0), C1,10); \
    GAPE(o[2]=__builtin_amdgcn_mfma_f32_32x32x16_bf16(PAF(3),VFR(3),o[2],0,0,0), C1,12); \
    GAPE(o[3]=__builtin_amdgcn_mfma_f32_32x32x16_bf16(PAF(3),VFR(7),o[3],0,0,0), C1,14); \
    }while(0)
  int t=1;
  #undef CMASK
  #define CMASK(P0,P1,t) do{int jb_=(t)-(NT-4); if(jb_>=-2)cmask(P0,P1,jb_,qrel,hi,btl);}while(0)
  for(;t+5<NT;t+=2){
    STEP(pB0,pB1,pA0,pA1,t,true,true,true);     WAIT_BAR(3); RESC(); ROT();
    STEP(pA0,pA1,pB0,pB1,t+1,true,true,true);   WAIT_BAR(3); RESC(); ROT();
  }
  #undef CMASK
  #define CMASK(P0,P1,t) do{int jb_=(t)-(NT-4); if(jb_>=-2)cmask(P0,P1,jb_,qrel,hi,btl);}while(0)
  #define ENDW(tt) do{ if((tt)+3<NT){WAIT_BAR(3);} else if((tt)+2<NT){WAIT_BAR(2);} else {WAIT_BAR(0);} }while(0)
  for(;t+1<NT;t+=2){
    STEP(pB0,pB1,pA0,pA1,t,(t+3<NT),(t+1<NT),(t+1<NT));       ENDW(t);   RESC(); ROT();
    STEP(pA0,pA1,pB0,pB1,t+1,(t+4<NT),(t+2<NT),(t+2<NT));     ENDW(t+1); RESC(); ROT();
  }
  STEP(pB0,pB1,pA0,pA1,NT-1,false,false,false); RESC();
  { float sacc=pB0[0]+pB0[1]; _Pragma("unroll") for(int r=2;r<16;++r)sacc+=pB0[r]; _Pragma("unroll") for(int r=0;r<16;++r)sacc+=pB1[r]; l_reg+=sacc;
    pw0=(u32x4){PKW(pB0,0),PKW(pB0,2),PKW(pB0,4),PKW(pB0,6)};pw1=(u32x4){PKW(pB0,8),PKW(pB0,10),PKW(pB0,12),PKW(pB0,14)};pw2=(u32x4){PKW(pB1,0),PKW(pB1,2),PKW(pB1,4),PKW(pB1,6)};pw3=(u32x4){PKW(pB1,8),PKW(pB1,10),PKW(pB1,12),PKW(pB1,14)};
    SBAR(); pv(o,vb0+2*sl_cur,PAF(0),PAF(1),PAF(2),PAF(3)); }
  #undef PKW
  #undef PAF
  #undef VFR
  #undef PIN
  #undef MX3
  #undef GAPA
  #undef GAPB
  #undef EX
  #undef VRD
  #undef VRD2
  #undef GAPE
  #undef KRD
  #undef STEP
  #undef ENDW
  {auto rr=__builtin_amdgcn_permlane32_swap(__float_as_uint(l_reg),__float_as_uint(l_reg),false,false);l_reg=__uint_as_float(rr[0])+__uint_as_float(rr[1]);}
  if(hi==0)wsf[32+r32]=l_reg;asm volatile("s_waitcnt lgkmcnt(0)":::"memory");
  float rli[16];
  #pragma unroll
  for(int r=0;r<16;++r)rli[r]=__builtin_amdgcn_rcpf(wsf[32+crow(r,hi)]);
  bf16*Ow=O+(rowbase+q0+wid*QBLK)*OP+hm*128;
  { bf16*stg=(bf16*)(shm+LDS_OST)+wid*2048;
    #pragma unroll
    for(int hf=0;hf<2;++hf){
      #pragma unroll
      for(int r=0;r<16;++r){const int orow=crow(r,hi);
        #pragma unroll
        for(int d0=0;d0<2;++d0)stg[orow*64+d0*32+r32]=__float2bfloat16(o[2*hf+d0][r]*rli[r]);}
      asm volatile("s_waitcnt lgkmcnt(0)":::"memory");
      #pragma unroll
      for(int i=0;i<4;++i){const int row=i*8+(lane>>3),ch=lane&7; const u32x4 v=*(const u32x4*)(stg+row*64+ch*8); ATTN_STORE16(Ow+(long)row*OP+hf*64+ch*8,v);}
      asm volatile("s_waitcnt lgkmcnt(0)":::"memory"); } }
  asm volatile("s_waitcnt lgkmcnt(0)\n\ts_barrier":::"memory");
  #undef DMA_K
  #undef DMA_V
  #undef CMASK
  #undef START
  #undef RESC
  #undef ROT
}
constexpr int ATTN_LDS_BYTES=LDS_BYTES;
struct AttnTensors { const bf16* Z; bf16* O; const float* btab; };
struct AttnUnit { int bh; int qb; };
struct StaticOrder {
  int vcu;
  __device__ __forceinline__ explicit StaticOrder(int grid,int block):vcu((block%8)*(grid/8)+block/8){}
  __device__ __forceinline__ bool next(int i,AttnUnit&u)const{ if(i>=2)return false; const int s=vcu&7; u.bh=vcu>>3; u.qb=(i==0)?15-s:s; return true; }
  __device__ __forceinline__ void a_ready(const AttnUnit&)const{}
  __device__ __forceinline__ void done(const AttnUnit&)const{}
};
template<class Sched,int THRL=8> __device__ __forceinline__ void attn_phase(char*lds,const AttnTensors&T,const Sched&S){
  AttnUnit u;
  for(int i=0;S.next(i,u);++i){ S.a_ready(u); attn_unit<THRL>(u.bh>>3,u.bh&7,u.qb,T.Z,T.O,T.btab,lds); S.done(u); }
}
#undef SBAR
#undef WAIT_BAR
}
namespace swa {
constexpr float THR = 8.f; constexpr bool WSKIP = false;
constexpr float SCALE = 0.6931471805599453f;
constexpr int D = 128, DK = 64, ZPITCH = 2816, OPITCH = 1024;
constexpr int NW = 8, QBLK = 32, KVBLK = 64, QB = NW * QBLK;
constexpr int SHM_V = KVBLK * D * 2, SHM_K = KVBLK * DK * 2;
constexpr int LDS_BT = 2 * SHM_V + 2 * SHM_K + NW * 64 * 4, LDS_BYTES = LDS_BT + 1536;

using bf16 = __hip_bfloat16;
typedef __attribute__((address_space(3))) const float* lds_cfptr;
typedef short bf16x8 __attribute__((ext_vector_type(8)));
typedef short s16x4 __attribute__((ext_vector_type(4)));
typedef float f32x16 __attribute__((ext_vector_type(16)));
typedef float f32x4 __attribute__((ext_vector_type(4)));
typedef unsigned u32x4 __attribute__((ext_vector_type(4)));
template <class A, class Bt> struct same_t { static constexpr bool v = false; };
template <class A> struct same_t<A, A> { static constexpr bool v = true; };

#define KSWZ(row, colB) ((row) * 128 + ((colB) ^ ((((row) >> 1) & 7) << 4)))
#define SBAR() __builtin_amdgcn_sched_barrier(0)
__device__ __forceinline__ int v_st(int k, int c) { const int kk = (k & ~0xC) | ((k & 4) << 1) | ((k & 8) >> 1); return ((kk >> 3) * 4 + (c >> 5)) * 512 + ((kk & 7) * 32 + (c & 31)) * 2; }
__device__ __forceinline__ int v_rd_base(int lane) { return ((lane & 3) << 3) | (((lane >> 2) & 3) << 6) | (((lane >> 4) & 1) << 5) | (((lane >> 5) & 1) << 8); }
constexpr int v_rd_off(int d0, int ks, int half) { return d0 * 512 + ks * 4096 + half * 2048; }
__device__ __forceinline__ int crow(int r, int hi) { return (r & 3) + 8 * (r >> 2) + 4 * hi; }
__device__ __forceinline__ unsigned cvtpk(float lo, float hi) {
    unsigned r; asm volatile("v_cvt_pk_bf16_f32 %0, %1, %2" : "=v"(r) : "v"(lo), "v"(hi)); return r;
}
__device__ __forceinline__ bf16x8 pack8(f32x4 a, f32x4 b) {
    u32x4 w = {cvtpk(a[0], a[1]), cvtpk(a[2], a[3]), cvtpk(b[0], b[1]), cvtpk(b[2], b[3])};
    return *reinterpret_cast<bf16x8*>(&w);
}
template <class T> __device__ __forceinline__ bf16x8 load8(const T* p) {
    if constexpr (same_t<T, float>::v) { return pack8(*(const f32x4*)p, *(const f32x4*)(p + 4)); }
    else { return *reinterpret_cast<const bf16x8*>(p); }
}
__device__ __forceinline__ void mask_tile(f32x16& p0, f32x16& p1, int dq, lds_cfptr bt) {
    const float NEG = -__builtin_inff();
#pragma unroll
    for (int r = 0; r < 16; ++r) {
        const int c = (r & 3) + 8 * (r >> 2); const int d0 = dq - c, d1 = d0 - 32;
        p0[r] += bt[d0 < 0 ? 0 : d0]; p1[r] += bt[d1 < 0 ? 0 : d1];
        if (d0 < 0) p0[r] = NEG; if (d1 < 0) p1[r] = NEG;
        if ((r & 3) == 3) __builtin_amdgcn_sched_barrier(0);
    }
}
__device__ __forceinline__ void partialSM(f32x16& p0, f32x16& p1, float& m_reg, float& mn, float& alpha) {
    float pmax = p0[0]; for (int r = 1; r < 16; ++r) pmax = fmaxf(pmax, p0[r]); for (int r = 0; r < 16; ++r) pmax = fmaxf(pmax, p1[r]);
    { auto rr = __builtin_amdgcn_permlane32_swap(__float_as_uint(pmax), __float_as_uint(pmax), false, false);
      pmax = fmaxf(__uint_as_float(rr[0]), __uint_as_float(rr[1])); }
    constexpr float C2 = 1.4426950408889634f * SCALE;
    if (__builtin_expect(__all((pmax - m_reg) * SCALE <= THR), 1)) { mn = m_reg; alpha = 1.f; }
    else { mn = fmaxf(m_reg, pmax); alpha = __builtin_amdgcn_exp2f((m_reg - mn) * C2); m_reg = mn; }
    const float mnL = -mn * C2;
    for (int r = 0; r < 16; ++r) p0[r] = fmaf(p0[r], C2, mnL); for (int r = 0; r < 16; ++r) p1[r] = fmaf(p1[r], C2, mnL);
    for (int r = 0; r < 16; ++r) p0[r] = __builtin_amdgcn_exp2f(p0[r]);
}
__device__ __forceinline__ void finishSM(f32x16& p0, f32x16& p1, float alpha, float& l_reg, bf16x8& pa0, bf16x8& pa1, bf16x8& pa2, bf16x8& pa3) {
    for (int r = 0; r < 16; ++r) p1[r] = __builtin_amdgcn_exp2f(p1[r]);
    float ps = 0; for (int r = 0; r < 16; ++r) ps += p0[r]; for (int r = 0; r < 16; ++r) ps += p1[r];
    { auto rr = __builtin_amdgcn_permlane32_swap(__float_as_uint(ps), __float_as_uint(ps), false, false);
      ps = __uint_as_float(rr[0]) + __uint_as_float(rr[1]); }
    l_reg = l_reg * alpha + ps;
#define PK4(P, B_, OUT) do { unsigned a0 = cvtpk(P[B_+0], P[B_+1]), a1 = cvtpk(P[B_+2], P[B_+3]);                          \
        unsigned b0 = cvtpk(P[B_+4], P[B_+5]), b1 = cvtpk(P[B_+6], P[B_+7]);                                             \
        auto r0 = __builtin_amdgcn_permlane32_swap(a0, b0, false, false); auto r1 = __builtin_amdgcn_permlane32_swap(a1, b1, false, false); \
        u32x4 w = {r0[0], r1[0], r0[1], r1[1]}; OUT = *reinterpret_cast<bf16x8*>(&w); } while (0)
    PK4(p0, 0, pa0); PK4(p0, 8, pa1); PK4(p1, 0, pa2); PK4(p1, 8, pa3);
#undef PK4
}
template <int KB, bool SK>
__device__ __forceinline__ void qkt(f32x16& p0, f32x16& p1, const char* K_lds, int r32, int hi, const bf16x8* qr, bool act) {
    if (SK && !act) { const float NEG = -__builtin_inff();
#pragma unroll
        for (int r = 0; r < 16; ++r) { p0[r] = NEG; p1[r] = NEG; } return; }
    p0 = f32x16{}; p1 = f32x16{};
    const char* kb[4];
#pragma unroll
    for (int dd = 0; dd < 4; ++dd) kb[dd] = K_lds + KB * SHM_K + KSWZ(r32, (dd * 16 + hi * 8) * 2);
#pragma unroll
    for (int d0 = 0; d0 < 4; ++d0) { const char* a = kb[d0];
        bf16x8 b0 = *reinterpret_cast<const bf16x8*>(a);
        bf16x8 b1 = *reinterpret_cast<const bf16x8*>(a + 32 * 128);
        p0 = __builtin_amdgcn_mfma_f32_32x32x16_bf16(b0, qr[d0], p0, 0, 0, 0);
        p1 = __builtin_amdgcn_mfma_f32_32x32x16_bf16(b1, qr[d0], p1, 0, 0, 0); }
}
typedef __attribute__((address_space(3))) const char* lds_cptr;
typedef short v4i16_t __attribute__((ext_vector_type(4)));
__device__ __forceinline__ s16x4 vtr(lds_cptr p) { return __builtin_bit_cast(s16x4, __builtin_amdgcn_ds_read_tr16_b64_v4i16((__attribute__((address_space(3))) v4i16_t*)p)); }
template <int VB, bool SK>
__device__ __forceinline__ void pv_tile(f32x16* o, lds_cptr vp, bf16x8 pa0, bf16x8 pa1, bf16x8 pa2, bf16x8 pa3, bool act) {
    if (SK && !act) return;
    s16x4 fa[8], fb[8];
#define PV_RD(F, d0) do { _Pragma("unroll") for (int ks = 0; ks < 4; ++ks) { F[2 * ks] = vtr(vp + (VB * SHM_V + (d0) * 512 + ks * 4096)); F[2 * ks + 1] = vtr(vp + (VB * SHM_V + (d0) * 512 + ks * 4096 + 2048)); } } while (0)
#define PV_FR(F, k) (bf16x8){F[2 * (k)][0], F[2 * (k)][1], F[2 * (k)][2], F[2 * (k)][3], F[2 * (k) + 1][0], F[2 * (k) + 1][1], F[2 * (k) + 1][2], F[2 * (k) + 1][3]}
#define PV_MF(O, F) do { O = __builtin_amdgcn_mfma_f32_32x32x16_bf16(pa0, PV_FR(F, 0), O, 0, 0, 0); O = __builtin_amdgcn_mfma_f32_32x32x16_bf16(pa1, PV_FR(F, 1), O, 0, 0, 0); \
                         O = __builtin_amdgcn_mfma_f32_32x32x16_bf16(pa2, PV_FR(F, 2), O, 0, 0, 0); O = __builtin_amdgcn_mfma_f32_32x32x16_bf16(pa3, PV_FR(F, 3), O, 0, 0, 0); } while (0)
    PV_RD(fa, 0); SBAR(); PV_RD(fb, 1); SBAR();
    PV_MF(o[0], fa); SBAR(); PV_RD(fa, 2); SBAR();
    PV_MF(o[1], fb); SBAR(); PV_RD(fb, 3); SBAR();
    PV_MF(o[2], fa); SBAR();
    PV_MF(o[3], fb);
#undef PV_RD
#undef PV_FR
#undef PV_MF
}

template <class TIn, class TOut> struct BlockRef { const TIn* Q; const TIn* K; const TIn* V; TOut* O; int P0; };
template <class TIn> struct Seam {
    bf16x8 qr[4];
    bf16x8 st_v0, st_v1, st_k0;
    bf16x8 sb_v0, sb_v1, sb_k0;
};
__device__ __forceinline__ int swa_jlo(int P0, int W) { const int lowk = P0 - W + 1; return lowk > 0 ? lowk / KVBLK : 0; }
#define ROW(p, k0, rr) ((p) + (size_t)((k0) + (rr)) * ZPITCH + sc)
#define ROWK(p, k0) ((p) + (size_t)((k0) + ksr) * ZPITCH + ksc)
#define VMW() asm volatile("s_waitcnt vmcnt(0)" ::: "memory")
#define VMWN(n) asm volatile("s_waitcnt vmcnt(%0)" :: "i"(n) : "memory")
#define SLOAD_H(Kp, Vp, k0) do { S.st_v0 = load8<TIn>(ROW(Vp, k0, sr)); S.st_v1 = load8<TIn>(ROW(Vp, k0, 32 + sr));              \
                         S.st_k0 = load8<TIn>(ROWK(Kp, k0)); } while (0)
#define SWRITE_HK(bf) do { *(bf16x8*)(K_lds + (bf) * SHM_K + kws) = S.st_k0; } while (0)
#define SWRITE_HV(bf) do { *(bf16x8*)(V_lds + (bf) * SHM_V + vst0) = S.st_v0; *(bf16x8*)(V_lds + (bf) * SHM_V + vst1) = S.st_v1; } while (0)
#define SWRITE_H(bf) do { SWRITE_HV(bf); SWRITE_HK(bf); } while (0)
#define SLOAD_HB(Kp, Vp, k0) do { S.sb_v0 = load8<TIn>(ROW(Vp, k0, sr)); S.sb_v1 = load8<TIn>(ROW(Vp, k0, 32 + sr)); S.sb_k0 = load8<TIn>(ROWK(Kp, k0)); } while (0)
#define SWRITE_HB(bf) do { *(bf16x8*)(V_lds + (bf) * SHM_V + vst0) = S.sb_v0; *(bf16x8*)(V_lds + (bf) * SHM_V + vst1) = S.sb_v1; *(bf16x8*)(K_lds + (bf) * SHM_K + kws) = S.sb_k0; } while (0)
template <class TIn, class TOut>
__device__ __forceinline__ void causal_swa_prime(const BlockRef<TIn, TOut>& cur, const float* btab_hm, char* lds, Seam<TIn>& S) {
    int tid_ = threadIdx.x; asm volatile("" : "+v"(tid_)); const int tid = tid_, wid = __builtin_amdgcn_readfirstlane(tid >> 6), lane = tid & 63, r32 = lane & 31, hi = lane >> 5;
    const int sr = tid >> 4, sc = (tid & 15) * 8, ksr = tid >> 3, ksc = (tid & 7) * 8, kws = KSWZ(ksr, ksc * 2); char* K_lds = lds + 2 * SHM_V;
    const int kb0 = 0;
    if (tid < 384) ((__attribute__((address_space(3))) float*)((__attribute__((address_space(3))) char*)lds + LDS_BT))[tid] = btab_hm[tid];
    for (int d0 = 0; d0 < 4; ++d0) S.qr[d0] = load8<TIn>(cur.Q + (size_t)(wid * QBLK + r32) * ZPITCH + d0 * 16 + hi * 8);
    SLOAD_H(cur.K, cur.V, kb0); VMW(); SWRITE_HK(0);
    __syncthreads();
}
template <class TIn, class TOut>
__device__ __forceinline__ void causal_swa_block(const BlockRef<TIn, TOut>& cur, const BlockRef<TIn, TOut>& nxt, int skv, char* lds, Seam<TIn>& S) {
    int tid_ = threadIdx.x; asm volatile("" : "+v"(tid_)); const int tid = tid_, wid = __builtin_amdgcn_readfirstlane(tid >> 6), lane = tid & 63, r32 = lane & 31, hi = lane >> 5;
    const int j_lo = 0;
    int j_hi = (cur.P0 + QB - 1) / KVBLK + 1; if (j_hi > skv / KVBLK) j_hi = skv / KVBLK;
    const int NT = j_hi - j_lo;
    const int kbn = 0;
    const int qlo = cur.P0 + wid * QBLK, qm = qlo + r32 - 4 * hi;
    char* V_lds = lds; char* K_lds = lds + 2 * SHM_V;
    float* ws = (float*)(lds + 2 * SHM_V + 2 * SHM_K) + wid * 64; float* li_l = ws, * al_l = ws + 32;
    const lds_cfptr btl = (lds_cfptr)((__attribute__((address_space(3))) const char*)lds + LDS_BT);
    float m_reg = -1e30f, l_reg = 0; f32x16 o[4] = {};
    const int sr = tid >> 4, sc = (tid & 15) * 8, vst0 = v_st(sr, sc), vst1 = v_st(32 + sr, sc);
    const int ksr = tid >> 3, ksc = (tid & 7) * 8, kws = KSWZ(ksr, ksc * 2);
    const lds_cptr vb0 = (lds_cptr)V_lds + v_rd_base(lane);
    const TIn* Kh = cur.K; const TIn* Vh = cur.V;
#define RESC(a) do { if (__any((a) < 1.f)) { if (hi == 0) al_l[r32] = (a); asm volatile("s_waitcnt lgkmcnt(0)" ::: "memory");              \
                     for (int d_ = 0; d_ < 4; ++d_) for (int r = 0; r < 16; ++r) o[d_][r] *= al_l[crow(r, hi)]; } } while (0)
#define KBASE(t) ((j_lo + (t)) * KVBLK)
#define ACT(t) true
#define MASKT(P0_, P1_, t) do { const int kb_ = KBASE(t); if (kb_ + KVBLK - 1 > qlo - 113) mask_tile(P0_, P1_, qm - kb_, btl); } while (0)
    constexpr int NQL = 4;
    constexpr bool SK = false;
#define SEAM_K0() do { VMWN(NQL); SWRITE_HK(0); SBAR(); } while (0)
    f32x16 pA0, pA1, pB0, pB1; float mnA, mnB, alA, alB; bf16x8 pa0, pa1, pa2, pa3;
    SWRITE_HV(0); SBAR();
    if (NT > 1) { SLOAD_H(Kh, Vh, KBASE(1)); SBAR(); if (NT > 2) { SLOAD_HB(Kh, Vh, KBASE(2)); } }
    SBAR(); qkt<0, SK>(pA0, pA1, K_lds, r32, hi, S.qr, ACT(0));
    MASKT(pA0, pA1, 0); partialSM(pA0, pA1, m_reg, mnA, alA);
    if (NT > 1) { if (NT > 2) { VMWN(3); } else { VMW(); } SWRITE_H(1); }
    __syncthreads();
#define HALF_STEP(PX0, PX1, mnX, alX, PY0, PY1, alY, t, KB, VB, SB, LD2, WR1) do {                                            \
        SBAR(); qkt<KB, SK>(PX0, PX1, K_lds, r32, hi, S.qr, ACT(t));                                             \
        finishSM(PY0, PY1, alY, l_reg, pa0, pa1, pa2, pa3); SBAR();                                                           \
        if ((t) + 2 < NT) { LD2(Kh, Vh, KBASE((t) + 2)); SBAR(); }                                                            \
        pv_tile<VB, SK>(o, vb0, pa0, pa1, pa2, pa3, ACT((t) - 1)); MASKT(PX0, PX1, (t)); partialSM(PX0, PX1, m_reg, mnX, alX);                                        \
        __syncthreads();                                                                                                      \
        if ((t) + 1 < NT) { if ((t) + 2 < NT) { VMWN(3); } else { VMW(); } WR1(SB); }                                          \
        RESC(alX); __syncthreads(); } while (0)
    for (int t = 1; t + 1 < NT; t += 2) {
        HALF_STEP(pB0, pB1, mnB, alB, pA0, pA1, alA, t, 1, 0, 0, SLOAD_H, SWRITE_HB);
        HALF_STEP(pA0, pA1, mnA, alA, pB0, pB1, alB, t + 1, 0, 1, 1, SLOAD_HB, SWRITE_H);
    }
    const bool even = (NT & 1) == 0;
    if (even) { SBAR(); qkt<1, SK>(pB0, pB1, K_lds, r32, hi, S.qr, ACT(NT - 1)); SBAR(); }
    { SLOAD_H(nxt.K, nxt.V, kbn); SBAR();
#pragma unroll
        for (int d0 = 0; d0 < 4; ++d0) S.qr[d0] = load8<TIn>(nxt.Q + (size_t)(wid * QBLK + r32) * ZPITCH + d0 * 16 + hi * 8); }
    SBAR();
    finishSM(pA0, pA1, alA, l_reg, pa0, pa1, pa2, pa3); SBAR();
    pv_tile<0, SK>(o, vb0, pa0, pa1, pa2, pa3, ACT(even ? NT - 2 : NT - 1));
    if (even) { MASKT(pB0, pB1, NT - 1); partialSM(pB0, pB1, m_reg, mnB, alB); __syncthreads(); RESC(alB);
        finishSM(pB0, pB1, alB, l_reg, pa0, pa1, pa2, pa3); SBAR(); pv_tile<1, SK>(o, vb0, pa0, pa1, pa2, pa3, ACT(NT - 1)); }
    SBAR(); SEAM_K0();
    if (hi == 0) li_l[r32] = l_reg; asm volatile("s_waitcnt lgkmcnt(0)" ::: "memory");
    float rli[16];
#pragma unroll
    for (int r = 0; r < 16; ++r) rli[r] = __builtin_amdgcn_rcpf(li_l[crow(r, hi)]);
    TOut* Ow = cur.O + (size_t)(wid * QBLK) * OPITCH;
#pragma unroll
    for (int r = 0; r < 16; ++r) { const int orow = crow(r, hi);
#pragma unroll
        for (int d0 = 0; d0 < 4; ++d0) { const float v = o[d0][r] * rli[r];
            const float vn = __shfl_xor(v, 1);
            if ((r32 & 1) == 0) *(unsigned*)(Ow + (size_t)orow * OPITCH + d0 * 32 + r32) = cvtpk(v, vn); } }
    __syncthreads();
#undef RESC
#undef KBASE
#undef ACT
#undef MASKT
#undef SEAM_K0
#undef HALF_STEP
}
#undef ROW
#undef ROWK
#undef VMW
#undef VMWN
#undef SLOAD_H
#undef SWRITE_HK
#undef SWRITE_HV
#undef SWRITE_H
#undef SLOAD_HB
#undef SWRITE_HB


__device__ __forceinline__ BlockRef<bf16, bf16> unit_ref(const bf16* Z, bf16* OB, int b, int hm, int qb) {
    BlockRef<bf16, bf16> r; const size_t row0 = (size_t)b * 4096;
    r.Q = Z + (row0 + (size_t)qb * QB) * ZPITCH + hm * DK; r.K = Z + row0 * ZPITCH + 512 + hm * DK; r.V = Z + row0 * ZPITCH + 1024 + (hm >> 1) * D;
    r.O = OB + (row0 + (size_t)qb * QB) * OPITCH + hm * D; r.P0 = qb * QB; return r;
}
__device__ __forceinline__ void attn_swa_phase(const bf16* Z, bf16* OB, const float* btab, char* lds, int G) {
    const int bx = blockIdx.x; const int vcu = (G % 8 == 0) ? (bx % 8) * (G / 8) + bx / 8 : bx;
    for (int L = vcu; L < 256; L += G) {
        const int bh = L >> 3, x = L & 7, b = bh >> 3, hm = bh & 7;
        const BlockRef<bf16, bf16> first = unit_ref(Z, OB, b, hm, 15 - x), second = unit_ref(Z, OB, b, hm, x);
        Seam<bf16> S;
        causal_swa_prime<bf16, bf16>(first, btab + hm * 384, lds, S);
        causal_swa_block<bf16, bf16>(first, second, 4096, lds, S);
        causal_swa_block<bf16, bf16>(second, second, 4096, lds, S);
    }
}

}
#ifndef PROBE_REP_MASK
#define PROBE_REP_MASK 0
#endif
#ifndef PROBE_EXTRA_SYNC
#define PROBE_EXTRA_SYNC 0
#endif
#ifndef PG8_ALIGN_MULTI
#define PG8_ALIGN_MULTI true
#endif
#ifndef HIDE_CONV
#define HIDE_CONV 1
#endif
#ifndef RES_BF16
#define RES_BF16 1
#endif
#ifndef USE_CG_SYNC
#define USE_CG_SYNC 0
#endif
#ifndef USE_ATTN128
#define USE_ATTN128 1
#endif
#ifndef USE_SWA_ATTN
#define USE_SWA_ATTN 1
#endif
#ifndef USE_NAIVE_ATTN
#define USE_NAIVE_ATTN 0
#endif
constexpr int NWAVES = 8, NTHR = 512;
constexpr int BATCH = 4, SEQ = 4096, DM = 1024, DEPTH = 4, DFF = 2816, INW = 2816, MTOK = BATCH * SEQ;
constexpr int ZP = 2816;
constexpr int ZQ = 0, ZK = 512, ZV = 1024, ZSB = 1536, ZSC = 1792, ZSX = 2048, ZLX = 2304, ZLG = 2560;
constexpr float LOG2E = 1.4426950408889634f;
constexpr float QSCALE = 0.125f * LOG2E;
constexpr int NCH = 64;

constexpr size_t MiB = 1u << 20;
constexpr size_t WS_LAM = 0;
constexpr size_t WS_BTAB = 4096;
constexpr size_t WS_PTOT = 64 * 1024;
constexpr size_t WS_HTOT = 320 * 1024;
constexpr size_t WS_SS = 640 * 1024;
constexpr size_t WS_BAR = 1 * MiB, BAR_BYTES = 16384;
constexpr size_t WS_W = 2 * MiB;
constexpr size_t WL_1C = 0, WL_1D = 11 * MiB, WL_IN = WL_1D + 11 * MiB / 2, WL_2C = WL_IN + 11 * MiB / 2, WL_2D = WL_2C + 11 * MiB, WL_OUT = WL_2D + 11 * MiB / 2, WL_STRIDE = WL_OUT + 2 * MiB;
static_assert(WL_STRIDE == 40 * MiB + MiB / 2, "layer weight stride");
constexpr size_t WS_XB = 164 * MiB, WS_ACT = 196 * MiB, WS_OB = 284 * MiB, WS_Y = 316 * MiB, WS_HL = 348 * MiB, WS_PL = 364 * MiB, WS_END = 380 * MiB;
static_assert(WS_W + 4 * WL_STRIDE <= WS_XB, "weights fit");

constexpr int RING_BYTES = 131072, LDS_BYTES = 147456, LDSCTL_OFF = LDS_BYTES - 256, MISC_OFF = LDSCTL_OFF + 64;

#define LAS __attribute__((address_space(3)))
typedef unsigned short bf16;
typedef unsigned v4u __attribute__((ext_vector_type(4)));
typedef unsigned v2u __attribute__((ext_vector_type(2)));
typedef float f32x4 __attribute__((ext_vector_type(4)));

__device__ __forceinline__ unsigned f2bf(float f) { unsigned u = __builtin_bit_cast(unsigned, f); return (u + 0x7fffu + ((u >> 16) & 1u)) >> 16; }
__device__ __forceinline__ unsigned pk2(float lo, float hi) { return f2bf(lo) | (f2bf(hi) << 16); }
__device__ __forceinline__ float bf2f(unsigned short b) { return __builtin_bit_cast(float, (unsigned)b << 16); }
__device__ __forceinline__ float bflo(unsigned w) { return __builtin_bit_cast(float, w << 16); }
__device__ __forceinline__ float bfhi(unsigned w) { return __builtin_bit_cast(float, w & 0xffff0000u); }
__device__ __forceinline__ float wave_sum(float v) {
#pragma unroll
    for (int o = 1; o < 64; o <<= 1) v += shx(v, o);
    return v;
}

#define XB_TMO      128
#define XB_XCNT(j)  (256  + 64 * (j))
#define XB_XSUB(j)  (1280 + 64 * (j))
#define XB_XGEN(j)  (2304 + 64 * (j))
#define XB_TOP      3328
#define XB_TOPGEN   3392
#define XCD_BAR_WORDS 3456
#define XB_SPIN_CAP (1u << 18)

__device__ __forceinline__ unsigned xb_ld(unsigned* p)              { return __hip_atomic_load(p, __ATOMIC_RELAXED, __HIP_MEMORY_SCOPE_AGENT); }
__device__ __forceinline__ unsigned xb_add(unsigned* p, unsigned v) { return __hip_atomic_fetch_add(p, v, __ATOMIC_RELAXED, __HIP_MEMORY_SCOPE_AGENT); }
__device__ __forceinline__ unsigned xb_xcc_id() { return (unsigned)__builtin_amdgcn_s_getreg((3 << 11) | 20) & 0xFu; }
#define XB_SPIN(cond, bar) do { unsigned _sp = 0; while (cond) { __builtin_amdgcn_s_sleep(1); \
    if ((++_sp & 255u) == 0u) { if (xb_ld(&(bar)[XB_TMO])) break; if (_sp > XB_SPIN_CAP) { atomicAdd(&(bar)[XB_TMO], 1u); break; } } } } while (0)

struct XcdBarrier {
    unsigned* bar; unsigned x;
    volatile LAS unsigned* st;
};

__device__ __forceinline__ XcdBarrier xcd_barrier_post(unsigned* bar, volatile LAS unsigned* st) {
    XcdBarrier b; b.bar = bar; b.x = xb_xcc_id(); b.st = st;
    if (threadIdx.x == 0) (void)xb_add(&bar[XB_XCNT(b.x)], 1u);
    return b;
}
__device__ __forceinline__ void xcd_barrier_complete(unsigned* bar, unsigned x, unsigned& nloc, unsigned& nx) {
    const unsigned G = gridDim.x * gridDim.y * gridDim.z;
    unsigned sum, cnt, mine, sp = 0u;
    for (;;) {
        sum = 0u; cnt = 0u; mine = 0u;
#pragma unroll
        for (unsigned j = 0; j < 16; ++j) { const unsigned c = xb_ld(&bar[XB_XCNT(j)]); sum += c; cnt += (c > 0u) ? 1u : 0u; mine = (j == x) ? c : mine; }
        if (sum == G) break;
        __builtin_amdgcn_s_sleep(1);
        if ((++sp & 255u) == 0u) { if (xb_ld(&bar[XB_TMO])) break; if (sp > XB_SPIN_CAP) { atomicAdd(&bar[XB_TMO], 1u); break; } }
    }
    nloc = mine > 0u ? mine : 1u; nx = cnt > 0u ? cnt : 1u;
}

__device__ __forceinline__ void xcd_barrier(const XcdBarrier& b) {
    asm volatile("s_waitcnt vmcnt(0)" ::: "memory");
    __syncthreads();
    if (threadIdx.x == 0) {
        unsigned* bar = b.bar;
        __builtin_amdgcn_s_waitcnt(0);
        unsigned nloc = b.st[0], nx = b.st[1];
        if (nloc == 0u) { xcd_barrier_complete(bar, b.x, nloc, nx); b.st[0] = nloc; b.st[1] = nx; }
        const unsigned old = xb_add(&bar[XB_XSUB(b.x)], 1u);
        const unsigned gen = old / nloc;
        if (old + 1u == (gen + 1u) * nloc) {
            __builtin_amdgcn_fence(__ATOMIC_RELEASE, "agent");
            asm volatile("s_waitcnt vmcnt(0)" ::: "memory");
            const unsigned og = xb_add(&bar[XB_TOP], 1u);
            const unsigned tg = og / nx;
            if (og + 1u == (tg + 1u) * nx) xb_add(&bar[XB_TOPGEN], 1u);
            else XB_SPIN(xb_ld(&bar[XB_TOPGEN]) == tg, bar);
            __builtin_amdgcn_fence(__ATOMIC_ACQUIRE, "agent");
            xb_add(&bar[XB_XGEN(b.x)], 1u);
            asm volatile("s_waitcnt vmcnt(0)" ::: "memory");
        } else {
            XB_SPIN(xb_ld(&bar[XB_XGEN(b.x)]) == gen, bar);
            __builtin_amdgcn_fence(__ATOMIC_ACQUIRE, "agent");
            asm volatile("s_waitcnt vmcnt(0)" ::: "memory");
        }
    }
    __syncthreads();
}

struct Args { const float* in[27]; float* out; unsigned char* ws; int ph_lo, ph_hi; };
typedef const __attribute__((address_space(4))) Args* ArgsP;
enum { I_X = 0, I_RELB, I_F1N, I_F1G, I_F1U, I_F1D, I_MIXN, I_WIN, I_WOUT, I_LQ1, I_LK1, I_LQ2, I_LK2, I_SUBG, I_SCW, I_LCW, I_LCB, I_WA, I_BA, I_WX, I_BX, I_LLAM, I_F2N, I_F2G, I_F2U, I_F2D, I_FIN };

struct TrItem { const float* W; const float* gain; bf16* WT; int K, N, k0, n0, drow0; };
__device__ __forceinline__ bool tr_item(ArgsP a, int it, TrItem& t) {
    constexpr int IT_BIG = 704, IT_OUT = 256, IT_LAYER = 7 * IT_BIG + IT_OUT;
    if (it >= DEPTH * IT_LAYER) return false;
    const int l = it / IT_LAYER, r = it % IT_LAYER;
    unsigned char* wl = a->ws + WS_W + (size_t)l * WL_STRIDE;
    const size_t wofs = (size_t)l * DM * DFF;
    int mode = 0, ii; t.gain = nullptr; t.K = DM; t.N = DFF;
    if (r >= 7 * IT_BIG) { t.W = a->in[I_WOUT] + (size_t)l * DM * DM; t.N = DM; t.WT = (bf16*)(wl + WL_OUT); ii = r - 7 * IT_BIG; }
    else {
        const int mat = r / IT_BIG; ii = r % IT_BIG;
        if (mat == 0)      { t.W = a->in[I_F1G] + wofs; t.gain = a->in[I_F1N] + l * DM; t.WT = (bf16*)(wl + WL_1C); mode = 1; }
        else if (mat == 1) { t.W = a->in[I_F1U] + wofs; t.gain = a->in[I_F1N] + l * DM; t.WT = (bf16*)(wl + WL_1C); mode = 2; }
        else if (mat == 2) { t.W = a->in[I_F1D] + wofs; t.K = DFF; t.N = DM; t.WT = (bf16*)(wl + WL_1D); }
        else if (mat == 3) { t.W = a->in[I_WIN] + wofs; t.gain = a->in[I_MIXN] + l * DM; t.WT = (bf16*)(wl + WL_IN); }
        else if (mat == 4) { t.W = a->in[I_F2G] + wofs; t.gain = a->in[I_F2N] + l * DM; t.WT = (bf16*)(wl + WL_2C); mode = 1; }
        else if (mat == 5) { t.W = a->in[I_F2U] + wofs; t.gain = a->in[I_F2N] + l * DM; t.WT = (bf16*)(wl + WL_2C); mode = 2; }
        else               { t.W = a->in[I_F2D] + wofs; t.K = DFF; t.N = DM; t.WT = (bf16*)(wl + WL_2D); }
    }
    const int nblk = t.N / 64, kb = ii / nblk, nb = ii % nblk; t.k0 = 64 * kb; t.n0 = 64 * nb;
    t.drow0 = (mode == 0) ? t.n0 : ((t.n0 >> 7) * 256 + (t.n0 & 127) + (mode == 2 ? 128 : 0));
    return true;
}

__device__ __forceinline__ void convert_items(ArgsP a, LAS unsigned char* lds, int it0, int it1, int w, int nw) {
    asm volatile("" : "+s"(a));
    int tid_ = threadIdx.x; asm volatile("" : "+v"(tid_)); const int tid = tid_, lane = tid & 63, wave = __builtin_amdgcn_readfirstlane(tid >> 6);
    LAS float* scr = (LAS float*)(lds + wave * 16640);
    static_assert(8 * 16640 <= LDSCTL_OFF, "conversion tiles vs LDS control words");
    TrItem cur, nxt; float v[64];
    int it = it0 + w;
    bool have = (it < it1) && tr_item(a, it, cur);
    if (have) {
#pragma unroll
        for (int i = 0; i < 64; ++i) v[i] = __builtin_nontemporal_load(cur.W + (size_t)(cur.k0 + i) * cur.N + cur.n0 + lane);
    }
    for (; have; it += nw) {
        if (cur.gain) {
#pragma unroll
            for (int i = 0; i < 64; ++i) scr[i * 65 + lane] = v[i] * cur.gain[cur.k0 + i];
        } else {
#pragma unroll
            for (int i = 0; i < 64; ++i) scr[i * 65 + lane] = v[i];
        }
        const bool hn = (it + nw < it1) && tr_item(a, it + nw, nxt);
        if (hn) {
#pragma unroll
            for (int i = 0; i < 64; ++i) v[i] = __builtin_nontemporal_load(nxt.W + (size_t)(nxt.k0 + i) * nxt.N + nxt.n0 + lane);
        }
        asm volatile("s_waitcnt lgkmcnt(0)" ::: "memory");
        const int c = lane & 7;
#pragma unroll
        for (int j = 0; j < 8; ++j) { const int n = (lane >> 3) + 8 * j; const LAS float* s = scr + (8 * c) * 65 + n;
            v4u o; o.x = pg8::cvt_pk_bf16(s[0 * 65], s[1 * 65]); o.y = pg8::cvt_pk_bf16(s[2 * 65], s[3 * 65]); o.z = pg8::cvt_pk_bf16(s[4 * 65], s[5 * 65]); o.w = pg8::cvt_pk_bf16(s[6 * 65], s[7 * 65]);
            *(v4u*)(cur.WT + (size_t)(cur.drow0 + n) * cur.K + cur.k0 + 8 * c) = o; }
        asm volatile("s_waitcnt lgkmcnt(0)" ::: "memory");
        cur = nxt; have = hn;
    }
}
constexpr int CONV_ITEMS_LAYER = 7 * 704 + 256;

__device__ __forceinline__ void prologue_phase(ArgsP a, LAS unsigned char* lds, int G) {
    asm volatile("" : "+s"(a));
    int tid_ = threadIdx.x; asm volatile("" : "+v"(tid_)); const int tid = tid_, lane = tid & 63, wave = __builtin_amdgcn_readfirstlane(tid >> 6);
    const int gw = blockIdx.x * NWAVES + wave, NGW = G * NWAVES;
    unsigned char* ws = a->ws;
    convert_items(a, lds, 0, (HIDE_CONV ? 1 : DEPTH) * CONV_ITEMS_LAYER, gw, NGW);
    const float* x = a->in[I_X]; bf16* XB = (bf16*)(ws + WS_XB); float* SS = (float*)(ws + WS_SS);
    for (int m = gw; m < MTOK; m += NGW) {
        const f32x4* xr = (const f32x4*)(x + (size_t)m * DM) + lane; float s = 0.f;
        unsigned long long* o8 = (unsigned long long*)(XB + (size_t)m * DM) + lane;
#pragma unroll
        for (int j = 0; j < 4; ++j) { const f32x4 v = xr[64 * j]; s += (v[0] * v[0] + v[1] * v[1]) + (v[2] * v[2] + v[3] * v[3]);
            o8[64 * j] = (unsigned long long)pk2(v[0], v[1]) | ((unsigned long long)pk2(v[2], v[3]) << 32); }
        s = wave_sum(s);
        if (lane < 4) SS[(size_t)m * 4 + lane] = (lane == 0) ? s : 0.f;
    }
    if (blockIdx.x == 0) {
        float* btab = (float*)(ws + WS_BTAB); const float* rb = a->in[I_RELB];
        for (int i = tid; i < 8 * 384; i += NTHR) { const int hm = i / 384, d = i % 384;
            int bk; if (d < 16) bk = d; else { bk = 16 + (int)(logf((float)d / 16.0f) / logf(8.0f) * 16.0f); bk = bk < 31 ? bk : 31; }
            btab[i] = (rb[bk * 8 + hm] - rb[31 * 8 + hm]) * LOG2E; }
        if (wave < DEPTH) { const int l = wave;
            const float s1 = wave_sum(a->in[I_LQ1][l * 64 + lane] * a->in[I_LK1][l * 64 + lane]);
            const float s2 = wave_sum(a->in[I_LQ2][l * 64 + lane] * a->in[I_LK2][l * 64 + lane]);
            const float lam_init = 0.8f - 0.6f * expf(-0.3f * (float)l);
            if (lane == 0) ((float*)(ws + WS_LAM))[l] = expf(s1) - expf(s2) + lam_init; }
    }
}

__device__ __forceinline__ void lru_local_phase(ArgsP a, LAS unsigned char* lds, int G, int l) {
    asm volatile("" : "+s"(a));
    int tid_ = threadIdx.x; asm volatile("" : "+v"(tid_)); const int tid = tid_, j = tid & 255, tg = tid >> 8, n = j >> 6, jj = j & 63;
    unsigned char* ws = a->ws;
    const bf16* Z = (const bf16*)(ws + WS_ACT);
    float* HL = (float*)(ws + WS_HL); float* PL = (float*)(ws + WS_PL); float* PT = (float*)(ws + WS_PTOT); float* HT = (float*)(ws + WS_HTOT);
    constexpr int XP = 264;
    LAS unsigned short* XH = (LAS unsigned short*)lds;
    LAS float* S0 = (LAS float*)(lds + 64 * XP * 2);
    const float* cw = a->in[I_LCW] + l * 4 * 256; const float cb = a->in[I_LCB][l * 256 + j];
    const float w0 = cw[j], w1 = cw[256 + j], w2 = cw[512 + j], w3 = cw[768 + j];
    const float* wa = a->in[I_WA] + ((size_t)l * 4 + n) * 4096 + jj; const float* wx = a->in[I_WX] + ((size_t)l * 4 + n) * 4096 + jj;
    const float ba = a->in[I_BA][l * 256 + j], bx = a->in[I_BX][l * 256 + j];
    const float lam = a->in[I_LLAM][l * 256 + j];
    const float sp8 = -8.0f * log1pf(expf(-lam));
    for (int it = blockIdx.x; it < BATCH * NCH; it += G) {
        const int b = it / NCH, c = it % NCH; const int t0 = c * 64 + tg * 32;
        const bf16* zx = Z + ((size_t)b * SEQ) * ZP + ZLX + j;
        __syncthreads();
        float xr[32];
        {
            float xm3 = (t0 >= 3) ? bf2f(zx[(size_t)(t0 - 3) * ZP]) : 0.f, xm2 = (t0 >= 2) ? bf2f(zx[(size_t)(t0 - 2) * ZP]) : 0.f, xm1 = (t0 >= 1) ? bf2f(zx[(size_t)(t0 - 1) * ZP]) : 0.f;
#pragma unroll
            for (int t = 0; t < 32; ++t) { const float x0 = bf2f(zx[(size_t)(t0 + t) * ZP]); xr[t] = cb + w0 * xm3 + w1 * xm2 + w2 * xm1 + w3 * x0; xm3 = xm2; xm2 = xm1; xm1 = x0; }
#pragma unroll
            for (int t = 0; t < 32; ++t) XH[(tg * 32 + t) * XP + j] = (unsigned short)f2bf(xr[t]);
        }
        __syncthreads();
        float ar[32], ai[32];
        {
            typedef float f32x16_t __attribute__((ext_vector_type(16))); typedef short bf16x8_t __attribute__((ext_vector_type(8)));
            const int lane = tid & 63, c = lane & 31, hi = lane >> 5;
            f32x16_t aR[2], aI[2];
#pragma unroll
            for (int cb2 = 0; cb2 < 2; ++cb2) { const float b0 = a->in[I_BA][l * 256 + n * 64 + cb2 * 32 + c], b1 = a->in[I_BX][l * 256 + n * 64 + cb2 * 32 + c];
#pragma unroll
                for (int r = 0; r < 16; ++r) { aR[cb2][r] = b0; aI[cb2][r] = b1; } }
            const float* wan = a->in[I_WA] + ((size_t)l * 4 + n) * 4096; const float* wxn = a->in[I_WX] + ((size_t)l * 4 + n) * 4096;
#pragma unroll
            for (int ks = 0; ks < 4; ++ks) {
                const bf16x8_t af = *(const LAS bf16x8_t*)(XH + (tg * 32 + c) * XP + n * 64 + ks * 16 + hi * 8);
#pragma unroll
                for (int cb2 = 0; cb2 < 2; ++cb2) {
                    const float* wp = wan + (ks * 16 + hi * 8) * 64 + cb2 * 32 + c; const float* xp = wxn + (ks * 16 + hi * 8) * 64 + cb2 * 32 + c;
                    v4u fa, fx;
                    fa.x = pk2(wp[0], wp[64]); fa.y = pk2(wp[128], wp[192]); fa.z = pk2(wp[256], wp[320]); fa.w = pk2(wp[384], wp[448]);
                    fx.x = pk2(xp[0], xp[64]); fx.y = pk2(xp[128], xp[192]); fx.z = pk2(xp[256], xp[320]); fx.w = pk2(xp[384], xp[448]);
                    aR[cb2] = __builtin_amdgcn_mfma_f32_32x32x16_bf16(af, __builtin_bit_cast(bf16x8_t, fa), aR[cb2], 0, 0, 0);
                    aI[cb2] = __builtin_amdgcn_mfma_f32_32x32x16_bf16(af, __builtin_bit_cast(bf16x8_t, fx), aI[cb2], 0, 0, 0);
                }
            }
#pragma unroll
            for (int r = 0; r < 16; ++r) {
                const auto sr = __builtin_amdgcn_permlane32_swap(__float_as_uint(aR[0][r]), __float_as_uint(aR[1][r]), false, false);
                const auto si = __builtin_amdgcn_permlane32_swap(__float_as_uint(aI[0][r]), __float_as_uint(aI[1][r]), false, false);
                const int tlo = (r & 3) + 8 * (r >> 2);
                ar[tlo] = __uint_as_float(sr[0]); ar[tlo + 4] = __uint_as_float(sr[1]);
                ai[tlo] = __uint_as_float(si[0]); ai[tlo + 4] = __uint_as_float(si[1]);
            }
        }
        float h = 0.f, P = 1.f;
#pragma unroll
        for (int t = 0; t < 32; ++t) {
            const float r = __builtin_amdgcn_rcpf(1.0f + __builtin_amdgcn_exp2f(-LOG2E * ar[t])), ig = __builtin_amdgcn_rcpf(1.0f + __builtin_amdgcn_exp2f(-LOG2E * ai[t]));
            const float log_a = sp8 * r; const float av = __builtin_amdgcn_exp2f(LOG2E * log_a);
            const float z = 2.0f * log_a;
            const float em1 = z * (1.0f + z * (0.5f + z * ((1.0f / 6.0f) + z * ((1.0f / 24.0f) + z * ((1.0f / 120.0f) + z * ((1.0f / 720.0f) + z * (1.0f / 5040.0f)))))));
            const float mult = __builtin_amdgcn_sqrtf(-em1);
            const float bv = mult * (ig * xr[t]);
            h = av * h + bv; P = P * av; ar[t] = P; ai[t] = h;
        }
        if (tg == 0) { S0[j * 2] = P; S0[j * 2 + 1] = h; }
        __syncthreads();
        if (tg == 1) { const float P0 = S0[j * 2], H0 = S0[j * 2 + 1];
#pragma unroll
            for (int t = 0; t < 32; ++t) { ai[t] += ar[t] * H0; ar[t] *= P0; }
            PT[((size_t)b * NCH + c) * 256 + j] = ar[31]; HT[((size_t)b * NCH + c) * 256 + j] = ai[31]; }
        const size_t g0 = ((size_t)b * SEQ + t0) * 256 + j;
#pragma unroll
        for (int t = 0; t < 32; ++t) { HL[g0 + (size_t)t * 256] = ai[t]; PL[g0 + (size_t)t * 256] = ar[t]; }
    }
    __syncthreads();
}

__device__ __forceinline__ void attn_naive_phase(ArgsP a, LAS unsigned char* lds, int G) {
    asm volatile("" : "+s"(a));
    int tid_ = threadIdx.x; asm volatile("" : "+v"(tid_)); const int tid = tid_, i = tid >> 3, s = tid & 7;
    unsigned char* ws = a->ws;
    const bf16* Z = (const bf16*)(ws + WS_ACT); bf16* OB = (bf16*)(ws + WS_OB); const float* btab = (const float*)(ws + WS_BTAB);
    LAS float* Ks = (LAS float*)lds;
    LAS float* Vs = Ks + 64 * 65;
    LAS float* Ps = Vs + 64 * 128;
    LAS float* bt = Ps + 64 * 65;
    for (int u = blockIdx.x; u < 2048; u += G) {
        const int bhm = u & 31, cgp = (u >> 5) & 7, rnd = u >> 8; const int qb = 8 * rnd + ((rnd & 1) ? 7 - cgp : cgp);
        const int b = bhm >> 3, hm = bhm & 7, h = hm >> 1; const int q0 = qb * 64;
        __syncthreads();
        if (tid < 384) bt[tid] = btab[hm * 384 + tid];
        float q[64];
        { const v4u* qp = (const v4u*)(Z + ((size_t)b * SEQ + q0 + i) * ZP + ZQ + hm * 64);
#pragma unroll
          for (int c = 0; c < 8; ++c) { const v4u w = qp[c]; q[c * 8] = bflo(w.x); q[c * 8 + 1] = bfhi(w.x); q[c * 8 + 2] = bflo(w.y); q[c * 8 + 3] = bfhi(w.y); q[c * 8 + 4] = bflo(w.z); q[c * 8 + 5] = bfhi(w.z); q[c * 8 + 6] = bflo(w.w); q[c * 8 + 7] = bfhi(w.w); } }
        float o[16]; float mrun = -1e30f, lrun = 0.f;
#pragma unroll
        for (int e = 0; e < 16; ++e) o[e] = 0.f;
        for (int kt = 0; kt <= qb; ++kt) {
            __syncthreads();
            { const int key = tid >> 3, c8 = tid & 7; const bf16* zr = Z + ((size_t)b * SEQ + kt * 64 + key) * ZP;
              const v4u kw = *(const v4u*)(zr + ZK + hm * 64 + c8 * 8);
              LAS float* kd = Ks + key * 65 + c8 * 8;
              kd[0] = bflo(kw.x); kd[1] = bfhi(kw.x); kd[2] = bflo(kw.y); kd[3] = bfhi(kw.y); kd[4] = bflo(kw.z); kd[5] = bfhi(kw.z); kd[6] = bflo(kw.w); kd[7] = bfhi(kw.w);
              const v4u v0 = *(const v4u*)(zr + ZV + h * 128 + c8 * 16), v1 = *(const v4u*)(zr + ZV + h * 128 + c8 * 16 + 8);
              LAS float* vd = Vs + key * 128 + c8 * 16;
              *(LAS f32x4*)(vd) = (f32x4){bflo(v0.x), bfhi(v0.x), bflo(v0.y), bfhi(v0.y)}; *(LAS f32x4*)(vd + 4) = (f32x4){bflo(v0.z), bfhi(v0.z), bflo(v0.w), bfhi(v0.w)};
              *(LAS f32x4*)(vd + 8) = (f32x4){bflo(v1.x), bfhi(v1.x), bflo(v1.y), bfhi(v1.y)}; *(LAS f32x4*)(vd + 12) = (f32x4){bflo(v1.z), bfhi(v1.z), bflo(v1.w), bfhi(v1.w)}; }
            __syncthreads();
            float sc[8]; float mx = -1e30f;
#pragma unroll
            for (int kk = 0; kk < 8; ++kk) { const int key = s * 8 + kk; const LAS float* kp = Ks + key * 65; float d = 0.f;
#pragma unroll
                for (int e = 0; e < 64; ++e) d += q[e] * kp[e];
                const int dist = (q0 + i) - (kt * 64 + key); const int di = dist < 0 ? 0 : (dist > 383 ? 383 : dist);
                d += bt[di]; if (dist < 0) d = -1e30f; sc[kk] = d; mx = fmaxf(mx, d); }
            mx = fmaxf(mx, shx(mx, 1)); mx = fmaxf(mx, shx(mx, 2)); mx = fmaxf(mx, shx(mx, 4));
            const float mnew = fmaxf(mrun, mx); const float corr = __builtin_amdgcn_exp2f(mrun - mnew); mrun = mnew;
            float ps = 0.f;
#pragma unroll
            for (int kk = 0; kk < 8; ++kk) { const float p = __builtin_amdgcn_exp2f(sc[kk] - mnew); ps += p; Ps[i * 65 + s * 8 + kk] = p; }
            ps += shx(ps, 1); ps += shx(ps, 2); ps += shx(ps, 4);
            lrun = lrun * corr + ps;
#pragma unroll
            for (int e = 0; e < 16; ++e) o[e] *= corr;
            asm volatile("s_waitcnt lgkmcnt(0)" ::: "memory");
            for (int key = 0; key < 64; ++key) { const float p = Ps[i * 65 + key]; const LAS float* vp = Vs + key * 128 + s * 16;
#pragma unroll
                for (int e4 = 0; e4 < 4; ++e4) { const f32x4 vv = *(const LAS f32x4*)(vp + e4 * 4);
#pragma unroll
                    for (int e = 0; e < 4; ++e) o[e4 * 4 + e] += p * vv[e]; } }
        }
        const float rl = 1.0f / lrun;
        v4u w0, w1;
        w0.x = pk2(o[0] * rl, o[1] * rl); w0.y = pk2(o[2] * rl, o[3] * rl); w0.z = pk2(o[4] * rl, o[5] * rl); w0.w = pk2(o[6] * rl, o[7] * rl);
        w1.x = pk2(o[8] * rl, o[9] * rl); w1.y = pk2(o[10] * rl, o[11] * rl); w1.z = pk2(o[12] * rl, o[13] * rl); w1.w = pk2(o[14] * rl, o[15] * rl);
        bf16* op = OB + ((size_t)b * SEQ + q0 + i) * DM + hm * 128 + s * 16;
        *(v4u*)op = w0; *(v4u*)(op + 8) = w1;
    }
    __syncthreads();
}

__device__ __forceinline__ float gelu_tanh(float x) {
    const float u = 0.7978845608028654f * (x + 0.044715f * x * x * x);
    const float e = __builtin_amdgcn_exp2f(-2.0f * LOG2E * u);
    return x * __builtin_amdgcn_rcpf(1.0f + e);
}
__device__ __forceinline__ void finalize_phase(ArgsP a, LAS unsigned char* lds, int G, int l) {
    asm volatile("" : "+s"(a));
    int tid_ = threadIdx.x; asm volatile("" : "+v"(tid_)); const int tid = tid_, lane = tid & 63, wave = tid >> 6;
    unsigned char* ws = a->ws;
    const bf16* Z = (const bf16*)(ws + WS_ACT); const bf16* OB = (const bf16*)(ws + WS_OB); bf16* Y = (bf16*)(ws + WS_Y);
    const float* HL = (const float*)(ws + WS_HL); const float* PL = (const float*)(ws + WS_PL); const float* PT = (const float*)(ws + WS_PTOT); const float* HT = (const float*)(ws + WS_HTOT);
    LAS float* Hin = (LAS float*)lds;
    const float lam = ((const float*)(ws + WS_LAM))[l];
    const float lam_init = 0.8f - 0.6f * expf(-0.3f * (float)l);
    const float osc = 1.0f - lam_init;
    const int dh = (lane & 15) * 8;
    float sg[8];
#pragma unroll
    for (int e = 0; e < 8; ++e) sg[e] = a->in[I_SUBG][l * 128 + dh + e] * osc;
    const int ch = lane * 4;
    float scw[3][4];
#pragma unroll
    for (int k = 0; k < 3; ++k)
#pragma unroll
        for (int e = 0; e < 4; ++e) scw[k][e] = a->in[I_SCW][(l * 3 + k) * 256 + ch + e];
    for (int it = blockIdx.x; it < BATCH * NCH; it += G) {
        const int b = it / NCH, c = it % NCH;
        __syncthreads();
        {
            const int chn = tid & 255, hf = tid >> 8, cm = c >> 1, c_lo = hf ? cm : 0, c_hi = hf ? c : cm;
            float H = 0.f, Pp = 1.f; const float* pt = PT + (size_t)b * NCH * 256 + chn; const float* ht = HT + (size_t)b * NCH * 256 + chn;
            int cc = c_lo;
            for (; cc + 8 <= c_hi; cc += 8) { float p[8], h[8];
#pragma unroll
                for (int e = 0; e < 8; ++e) { p[e] = pt[(cc + e) * 256]; h[e] = ht[(cc + e) * 256]; }
#pragma unroll
                for (int e = 0; e < 8; ++e) { H = p[e] * H + h[e]; Pp *= p[e]; } }
            for (; cc < c_hi; ++cc) { const float p = pt[cc * 256], h = ht[cc * 256]; H = p * H + h; Pp *= p; }
            if (hf == 0) Hin[chn] = H;
            __syncthreads();
            if (hf == 1) Hin[chn] = Pp * Hin[chn] + H;
        }
        __syncthreads();
        const f32x4 hin = *(const LAS f32x4*)(Hin + ch);
        for (int r = wave; r < 64; r += NWAVES) {
            const int t = c * 64 + r; const size_t row = (size_t)b * SEQ + t;
            { const int h = lane >> 4; const bf16* op = OB + row * DM + h * 256 + dh;
              const v4u w1 = *(const v4u*)op, w2 = *(const v4u*)(op + 128);
              float d[8];
              d[0] = bflo(w1.x) - lam * bflo(w2.x); d[1] = bfhi(w1.x) - lam * bfhi(w2.x); d[2] = bflo(w1.y) - lam * bflo(w2.y); d[3] = bfhi(w1.y) - lam * bfhi(w2.y);
              d[4] = bflo(w1.z) - lam * bflo(w2.z); d[5] = bfhi(w1.z) - lam * bfhi(w2.z); d[6] = bflo(w1.w) - lam * bflo(w2.w); d[7] = bfhi(w1.w) - lam * bfhi(w2.w);
              float ssq = 0.f;
#pragma unroll
              for (int e = 0; e < 8; ++e) ssq += d[e] * d[e];
              ssq += shx(ssq, 1); ssq += shx(ssq, 2); ssq += shx(ssq, 4); ssq += shx(ssq, 8);
              const float rs = __builtin_amdgcn_rsqf(ssq * (1.0f / 128.0f) + 1e-5f);
              v4u o; o.x = pk2(d[0] * rs * sg[0], d[1] * rs * sg[1]); o.y = pk2(d[2] * rs * sg[2], d[3] * rs * sg[3]); o.z = pk2(d[4] * rs * sg[4], d[5] * rs * sg[5]); o.w = pk2(d[6] * rs * sg[6], d[7] * rs * sg[7]);
              *(v4u*)(Y + row * DM + h * 128 + dh) = o; }
            { const bf16* zr = Z + row * ZP; float acc[4] = {0.f, 0.f, 0.f, 0.f};
#pragma unroll
              for (int k = 0; k < 3; ++k) { const int tt = t - 2 + k; if (tt >= 0) { const bf16* zz = zr - (size_t)(2 - k) * ZP;
                  const v2u cw = *(const v2u*)(zz + ZSC + ch), xw = *(const v2u*)(zz + ZSX + ch);
                  acc[0] += scw[k][0] * (bflo(cw.x) * bflo(xw.x)); acc[1] += scw[k][1] * (bfhi(cw.x) * bfhi(xw.x)); acc[2] += scw[k][2] * (bflo(cw.y) * bflo(xw.y)); acc[3] += scw[k][3] * (bfhi(cw.y) * bfhi(xw.y)); } }
              const v2u bw = *(const v2u*)(zr + ZSB + ch);
              v2u o; o.x = pk2(bflo(bw.x) * acc[0], bfhi(bw.x) * acc[1]); o.y = pk2(bflo(bw.y) * acc[2], bfhi(bw.y) * acc[3]);
              *(v2u*)(Y + row * DM + 512 + ch) = o;
              const f32x4 hl = *(const f32x4*)(HL + row * 256 + ch), pl = *(const f32x4*)(PL + row * 256 + ch);
              const v2u gw = *(const v2u*)(zr + ZLG + ch);
              v2u o2; o2.x = pk2(gelu_tanh(bflo(gw.x)) * (hl[0] + pl[0] * hin[0]), gelu_tanh(bfhi(gw.x)) * (hl[1] + pl[1] * hin[1]));
              o2.y = pk2(gelu_tanh(bflo(gw.y)) * (hl[2] + pl[2] * hin[2]), gelu_tanh(bfhi(gw.y)) * (hl[3] + pl[3] * hin[3]));
              *(v2u*)(Y + row * DM + 768 + ch) = o2; }
        }
    }
    __syncthreads();
}

__device__ __forceinline__ void final_norm_phase(ArgsP a, int G) {
    asm volatile("" : "+s"(a));
    int tid_ = threadIdx.x; asm volatile("" : "+v"(tid_)); const int tid = tid_, lane = tid & 63, wave = tid >> 6;
    const int gw = blockIdx.x * NWAVES + wave, NGW = G * NWAVES;
    const float* SS = (const float*)(a->ws + WS_SS); const float* g = a->in[I_FIN];
    f32x4 gv[4];
#pragma unroll
    for (int j = 0; j < 4; ++j) gv[j] = ((const f32x4*)g)[lane + 64 * j];
    for (int m = gw; m < MTOK; m += NGW) {
        const f32x4 s4 = *(const f32x4*)(SS + (size_t)m * 4);
        const float rs = 1.0f / sqrtf(((s4[0] + s4[1]) + (s4[2] + s4[3])) * (1.0f / 1024.0f) + 1e-6f);
#if RES_BF16
        const v2u* xb = (const v2u*)((const bf16*)(a->ws + WS_XB) + (size_t)m * DM) + lane; f32x4* xr = (f32x4*)(a->out + (size_t)m * DM) + lane;
#pragma unroll
        for (int j = 0; j < 4; ++j) { const v2u w = xb[64 * j]; const f32x4 v = (f32x4){bflo(w.x), bfhi(w.x), bflo(w.y), bfhi(w.y)}; xr[64 * j] = v * rs * gv[j]; }
#else
        f32x4* xr = (f32x4*)(a->out + (size_t)m * DM) + lane;
#pragma unroll
        for (int j = 0; j < 4; ++j) { const f32x4 v = xr[64 * j]; xr[64 * j] = v * rs * gv[j]; }
#endif
    }
}

constexpr int N_PHASES = 2 + 8 * DEPTH;
__global__ void __launch_bounds__(NTHR, 2) hymba_fwd(Args args) {
    extern __shared__ __attribute__((aligned(16))) unsigned char lds_raw[];
    LAS unsigned char* lds = (LAS unsigned char*)lds_raw;
    cg::grid_group grid = cg::this_grid();
    const int G = gridDim.x;
    ArgsP ap = (ArgsP)__builtin_amdgcn_kernarg_segment_ptr();
    if (threadIdx.x < 64) ((LAS unsigned*)(lds + LDSCTL_OFF))[threadIdx.x] = 0u;
    __syncthreads();
    const XcdBarrier bar = xcd_barrier_post((unsigned*)(ap->ws + WS_BAR), (volatile LAS unsigned*)(lds + MISC_OFF) + 8);
    const int ph_lo = ap->ph_lo, ph_hi = ap->ph_hi;
    for (int ph = ph_lo; ph < ph_hi; ++ph) {
        ArgsP a = ap; asm volatile("" : "+s"(a));
        unsigned char* ws = a->ws;
        bf16* XB = (bf16*)(ws + WS_XB); bf16* ACT = (bf16*)(ws + WS_ACT); bf16* Y = (bf16*)(ws + WS_Y); float* SS = (float*)(ws + WS_SS);
        int reps = 1;
        if (PROBE_REP_MASK) { if (ph == 0) reps = ((PROBE_REP_MASK >> 8) & 1) ? 2 : 1; else if (ph < N_PHASES - 1) reps = ((PROBE_REP_MASK >> ((ph - 1) & 7)) & 1) ? 2 : 1; }
        for (int rep = 0; rep < reps; ++rep) {
        if (ph == 0) { prologue_phase(a, lds, G); if ((PROBE_REP_MASK >> 12) & 1) prologue_phase(a, lds, G); }
        else if (ph == N_PHASES - 1) final_norm_phase(a, G);
        else {
            const int l = (ph - 1) >> 3, s = (ph - 1) & 7;
            const unsigned char* wl = ws + WS_W + (size_t)l * WL_STRIDE;
            if (s == 0 || s == 6) {
                pg8::Gemm g{XB, (const bf16*)(wl + (s == 0 ? WL_1C : WL_2C)), MTOK, 2 * DFF, DM}; pg8::StaticOrder S; S.init(MTOK, 2 * DFF, G, (int)blockIdx.x);
                pg8::EpiSwiglu E{ACT, DFF, SS};
                pg8::gemm_phase<pg8::EpiSwiglu, pg8::StaticOrder, PG8_ALIGN_MULTI, true>(lds, g, S, E);
                if (HIDE_CONV && l + 1 < DEPTH) {
                    const int nidle = G - (1408 % G);
                    if (G == 256 && (int)blockIdx.x >= G - nidle) {
                        const int i0 = (l + 1) * CONV_ITEMS_LAYER + (s == 0 ? 0 : CONV_ITEMS_LAYER / 2), i1 = (l + 1) * CONV_ITEMS_LAYER + (s == 0 ? CONV_ITEMS_LAYER / 2 : CONV_ITEMS_LAYER);
                        convert_items(a, lds, i0, i1, ((int)blockIdx.x - (G - nidle)) * NWAVES + __builtin_amdgcn_readfirstlane((int)threadIdx.x >> 6), nidle * NWAVES);
                    }
                }
            } else if (s == 1 || s == 5 || s == 7) {
                const bool isout = (s == 5);
                pg8::Gemm g{isout ? Y : ACT, (const bf16*)(wl + (s == 1 ? WL_1D : (s == 5 ? WL_OUT : WL_2D))), MTOK, DM, isout ? DM : DFF}; pg8::StaticOrder S; S.init(MTOK, DM, G, (int)blockIdx.x);
#if RES_BF16
                pg8::EpiRes16 E{XB, SS, isout ? 1.0f : 0.5f};
                pg8::gemm_phase<pg8::EpiRes16, pg8::StaticOrder, false, true>(lds, g, S, E);
#else
                pg8::EpiRes E{(l == 0 && s == 1) ? a->in[I_X] : a->out, a->out, XB, SS, isout ? 1.0f : 0.5f};
                pg8::gemm_phase<pg8::EpiRes, pg8::StaticOrder, false, true>(lds, g, S, E);
#endif
            } else if (s == 2) {
                pg8::Gemm g{XB, (const bf16*)(wl + WL_IN), MTOK, INW, DM}; pg8::StaticOrder S; S.init(MTOK, INW, G, (int)blockIdx.x);
                pg8::EpiZ E{ACT, ZP, SS, QSCALE};
                pg8::gemm_phase<pg8::EpiZ, pg8::StaticOrder, PG8_ALIGN_MULTI, true>(lds, g, S, E);
            } else if (s == 3) {
                lru_local_phase(a, lds, G, l);
                if ((PROBE_REP_MASK >> 9) & 1) lru_local_phase(a, lds, G, l);
#if USE_NAIVE_ATTN
                attn_naive_phase(a, lds, G);
#elif USE_ATTN128
                { static_assert(attn128::ATTN_LDS_BYTES <= RING_BYTES, "attention LDS");
                  const attn128::AttnTensors AT{(const attn128::bf16*)ACT, (attn128::bf16*)(ws + WS_OB), (const float*)(ws + WS_BTAB)};
                  const attn128::StaticOrder S(G, (int)blockIdx.x);
                  attn128::attn_phase<attn128::StaticOrder>((char*)lds_raw, AT, S);
                  if ((PROBE_REP_MASK >> 10) & 1) attn128::attn_phase<attn128::StaticOrder>((char*)lds_raw, AT, S); }
#elif USE_SWA_ATTN
                { static_assert(swa::LDS_BYTES <= RING_BYTES, "attention LDS");
                  swa::attn_swa_phase((const swa::bf16*)ACT, (swa::bf16*)(ws + WS_OB), (const float*)(ws + WS_BTAB), (char*)lds_raw, G);
                  if ((PROBE_REP_MASK >> 10) & 1) swa::attn_swa_phase((const swa::bf16*)ACT, (swa::bf16*)(ws + WS_OB), (const float*)(ws + WS_BTAB), (char*)lds_raw, G); }
#else
                { static_assert(attn_body::ATTN_LDS_BYTES <= RING_BYTES, "attention LDS");
                  const attn_body::AttnTensors AT{(const attn_body::bf16*)ACT, (attn_body::bf16*)(ws + WS_OB), (const float*)(ws + WS_BTAB)};
                  const attn_body::StaticOrder S(G, (int)blockIdx.x);
                  attn_body::attn_phase<attn_body::StaticOrder>((char*)lds_raw, AT, S);
                  if ((PROBE_REP_MASK >> 10) & 1) attn_body::attn_phase<attn_body::StaticOrder>((char*)lds_raw, AT, S); }
#endif
            } else {
                finalize_phase(a, lds, G, l);
                if ((PROBE_REP_MASK >> 11) & 1) finalize_phase(a, lds, G, l);
            }
        }
        if (rep + 1 < reps) xcd_barrier(bar);
        }
        if (ph + 1 < ph_hi) { if (USE_CG_SYNC || ph_lo < 0) grid.sync(); else xcd_barrier(bar); }
        if (PROBE_EXTRA_SYNC) for (int e = 0; e < PROBE_EXTRA_SYNC; ++e) xcd_barrier(bar);
    }
}

#ifndef MK_PER_PHASE
#define MK_PER_PHASE 0
#endif
extern "C" void kernel_launch(void* const* d_in, const int* in_sizes, int n_in, void* d_out, int out_size, void* d_ws, size_t ws_size, hipStream_t stream) {
    static int grid = 0;
    if (grid == 0) {
        if (n_in != 27 || in_sizes[0] != MTOK * DM || out_size != MTOK * DM || ws_size < WS_END) { fprintf(stderr, "kernel_launch: unexpected shapes / workspace (n_in %d, ws %zu)\n", n_in, ws_size); grid = -1; return; }
        int dev = 0, cus = 0, per_cu = 0;
        hipGetDevice(&dev); hipDeviceGetAttribute(&cus, hipDeviceAttributeMultiprocessorCount, dev);
        if (hipFuncSetAttribute((const void*)hymba_fwd, hipFuncAttributeMaxDynamicSharedMemorySize, LDS_BYTES) != hipSuccess) { fprintf(stderr, "kernel_launch: hipFuncSetAttribute failed\n"); grid = -1; return; }
        hipOccupancyMaxActiveBlocksPerMultiprocessor(&per_cu, (const void*)hymba_fwd, NTHR, LDS_BYTES);
        (void)hipGetLastError();
        if (cus != 256 || per_cu < 1) fprintf(stderr, "kernel_launch: note: cus %d per_cu %d (built for 256 x 1)\n", cus, per_cu);
        grid = 256;
    }
    if (grid < 0) return;
    if (hipMemsetAsync((char*)d_ws + WS_BAR, 0, BAR_BYTES, stream) != hipSuccess) { fprintf(stderr, "kernel_launch: memset failed\n"); return; }
    Args a{};
    for (int i = 0; i < 27; ++i) a.in[i] = (const float*)d_in[i];
    a.out = (float*)d_out; a.ws = (unsigned char*)d_ws;
#if MK_PER_PHASE
    for (int p = 0; p < N_PHASES; ++p) { a.ph_lo = p; a.ph_hi = p + 1; hipLaunchKernelGGL(hymba_fwd, dim3(grid), dim3(NTHR), LDS_BYTES, stream, a); }
#else
    a.ph_lo = 0; a.ph_hi = N_PHASES;
    void* kargs[] = {&a};
    hipError_t e = hipLaunchCooperativeKernel((const void*)hymba_fwd, dim3(grid), dim3(NTHR), kargs, LDS_BYTES, stream);
    if (e != hipSuccess) fprintf(stderr, "kernel_launch: cooperative launch failed: %s\n", hipGetErrorString(e));
#endif
}
```

```cpp
#include <hip/hip_runtime.h>
#include <hip/hip_cooperative_groups.h>
#include <cstdio>
#include <cstdint>
#include <cmath>
namespace cg = cooperative_groups;
#ifndef PG8_WGM
#define PG8_WGM 8
#endif
__device__ __forceinline__ float shx(float v, int m) { int ln; asm volatile("v_mbcnt_lo_u32_b32 %0, -1, 0\n\tv_mbcnt_hi_u32_b32 %0, -1, %0" : "=v"(ln)); return __builtin_bit_cast(float, __builtin_amdgcn_ds_bpermute((ln ^ m) << 2, __builtin_bit_cast(int, v))); }
namespace pg8 {
#define PG8_LAS __attribute__((address_space(3)))
typedef unsigned short bf16_t;
typedef short bf16x8 __attribute__((ext_vector_type(8)));
typedef float f32x4 __attribute__((ext_vector_type(4)));
typedef unsigned u32x4 __attribute__((ext_vector_type(4)));
constexpr int BM = 256, BK = 64, HALF = 128, HTB = HALF * BK * 2  , STAGE_BYTES = 8 * HTB, NXCD = 8, WGM = PG8_WGM;

__host__ __device__ __forceinline__ int lds_byte(int r, int c) { const int st = (r >> 4) * 2 + (c >> 5), rr = r & 15, cc = c & 31, ob = rr * 64 + cc * 2; return st * 1024 + (ob ^ (((ob >> 9) & 1) << 5)); }
__host__ __device__ __forceinline__ void stage_rc(int b, int& R, int& C) { const int st = b / 1024, sb = b % 1024, swz = sb ^ (((sb >> 9) & 1) << 5); R = (st >> 1) * 16 + swz / 64; C = (st & 1) * 32 + (swz % 64) / 2; }
__host__ __device__ __forceinline__ int perm32(int rho) { const int n = rho >> 4, i = rho & 15; return 8 * (i >> 2) + 4 * n + (i & 3); }

struct Unit { int pm, pn; };
struct Gemm { const bf16_t* A; const bf16_t* Bt; int M, N, K; };

struct StaticOrder {
    int nM, nN, nwg, G, c;
    __host__ __device__ void init(int M, int N, int G_, int c_) { nM = M / BM; nN = N / BM; nwg = nM * nN; G = G_; c = c_; }
    __host__ __device__ bool next(int i, Unit& u) const {
        const long L = (long)i * G + c; if (L >= nwg) return false;
        int wgid = (int)L; { const int q = nwg / NXCD, r = nwg % NXCD, xcd = wgid % NXCD, off = wgid / NXCD; wgid = (xcd < r ? xcd * (q + 1) : r * (q + 1) + (xcd - r) * q) + off; }
        const int nig = WGM * nN, gid = wgid / nig, fm = gid * WGM, gsz = (nM - fm) < WGM ? (nM - fm) : WGM;
        u.pm = fm + ((wgid % nig) % gsz); u.pn = (wgid % nig) / gsz; return true;
    }
    __device__ __forceinline__ void a_ready(const Unit&) const {}
    __device__ __forceinline__ void done(const Unit&) const {}
};

__device__ __forceinline__ unsigned cvt_pk_bf16(float lo, float hi) { unsigned r; asm volatile("v_cvt_pk_bf16_f32 %0, %1, %2" : "=v"(r) : "v"(lo), "v"(hi)); return r; }
typedef float f32x2 __attribute__((ext_vector_type(2)));
typedef unsigned u32x2 __attribute__((ext_vector_type(2)));
#define PG8_ST16_WT(w, rs, off) __builtin_amdgcn_raw_buffer_store_b128((w), (rs), (unsigned)(off), 0, 16)
#define PG8_RSRC(p, bytes) __builtin_amdgcn_make_buffer_rsrc((void*)(p), 0, (int)(bytes), 0x00020000)
__device__ __forceinline__ float row_rstd(const float* ss, int row) {
    const f32x4 s4 = *(const f32x4*)(ss + (size_t)row * 4);
    return __builtin_amdgcn_rsqf(((s4[0] + s4[1]) + (s4[2] + s4[3])) * (1.0f / 1024.0f) + 1e-6f);
}
__device__ __forceinline__ float silu_mul(float g, float u) {
    const float e = __builtin_amdgcn_exp2f(-g * 1.4426950408889634f);
    return g * __builtin_amdgcn_rcpf(1.0f + e) * u;
}
struct EpiSwiglu {
    static constexpr bool PERM = true, AFTER_DRAIN = false, ROWTAB = true;
    bf16_t* O; int ldc; const float* ss;
    __device__ __forceinline__ void operator()(const f32x4 (&acc)[2][2][4][2], const Unit& u, int wr, int wc, int fr, int fq, const PG8_LAS float* tab) const {
        { int ln_; asm volatile("v_mbcnt_lo_u32_b32 %0, -1, 0\n\tv_mbcnt_hi_u32_b32 %0, -1, %0" : "=v"(ln_)); fr = ln_ & 15; fq = ln_ >> 4; }
        const int row0 = u.pm * BM + wr * 64 + fr; const int col0 = u.pn * 128 + wc * 32 + 8 * fq;
        float rsv[2][4];
        { f32x4 s4v[2][4];
#pragma unroll
          for (int ai = 0; ai < 2; ++ai)
#pragma unroll
              for (int m = 0; m < 4; ++m) s4v[ai][m] = *(const PG8_LAS f32x4*)(tab + (ai * HALF + wr * 64 + m * 16 + fr) * 4);
#pragma unroll
          for (int ai = 0; ai < 2; ++ai)
#pragma unroll
              for (int m = 0; m < 4; ++m) rsv[ai][m] = __builtin_amdgcn_rsqf(((s4v[ai][m][0] + s4v[ai][m][1]) + (s4v[ai][m][2] + s4v[ai][m][3])) * (1.0f / 1024.0f) + 1e-6f); }
#pragma unroll
        for (int ai = 0; ai < 2; ++ai)
#pragma unroll
            for (int m = 0; m < 4; ++m) {
                const int row = row0 + ai * HALF + m * 16; const float rs = rsv[ai][m];
                const f32x4 g0 = acc[ai][0][m][0] * rs, g1 = acc[ai][0][m][1] * rs, u0 = acc[ai][1][m][0] * rs, u1 = acc[ai][1][m][1] * rs;
                u32x4 w;
                w.x = cvt_pk_bf16(silu_mul(g0[0], u0[0]), silu_mul(g0[1], u0[1])); w.y = cvt_pk_bf16(silu_mul(g0[2], u0[2]), silu_mul(g0[3], u0[3]));
                w.z = cvt_pk_bf16(silu_mul(g1[0], u1[0]), silu_mul(g1[1], u1[1])); w.w = cvt_pk_bf16(silu_mul(g1[2], u1[2]), silu_mul(g1[3], u1[3]));
                PG8_ST16_WT(w, PG8_RSRC(O, 16384u * 2816u * 2u), ((unsigned)row * (unsigned)ldc + (unsigned)col0) * 2u);
            }
    }
};
struct EpiZ {
    static constexpr bool PERM = true, AFTER_DRAIN = false, ROWTAB = true;
    bf16_t* O; int ldc; const float* ss; float qscale;
    __device__ __forceinline__ void operator()(const f32x4 (&acc)[2][2][4][2], const Unit& u, int wr, int wc, int fr, int fq, const PG8_LAS float* tab) const {
        { int ln_; asm volatile("v_mbcnt_lo_u32_b32 %0, -1, 0\n\tv_mbcnt_hi_u32_b32 %0, -1, %0" : "=v"(ln_)); fr = ln_ & 15; fq = ln_ >> 4; }
        const int row0 = u.pm * BM + wr * 64 + fr; const int col0 = u.pn * BM + wc * 32 + 8 * fq;
        const float sc = (u.pn < 2) ? qscale : 1.0f;
        float rsv[2][4];
        { f32x4 s4v[2][4];
#pragma unroll
          for (int ai = 0; ai < 2; ++ai)
#pragma unroll
              for (int m = 0; m < 4; ++m) s4v[ai][m] = *(const PG8_LAS f32x4*)(tab + (ai * HALF + wr * 64 + m * 16 + fr) * 4);
#pragma unroll
          for (int ai = 0; ai < 2; ++ai)
#pragma unroll
              for (int m = 0; m < 4; ++m) rsv[ai][m] = __builtin_amdgcn_rsqf(((s4v[ai][m][0] + s4v[ai][m][1]) + (s4v[ai][m][2] + s4v[ai][m][3])) * (1.0f / 1024.0f) + 1e-6f) * sc; }
#pragma unroll
        for (int ai = 0; ai < 2; ++ai)
#pragma unroll
            for (int m = 0; m < 4; ++m) {
                const int row = row0 + ai * HALF + m * 16; const float rs = rsv[ai][m];
#pragma unroll
                for (int bj = 0; bj < 2; ++bj) {
                    const f32x4 v0 = acc[ai][bj][m][0] * rs, v1 = acc[ai][bj][m][1] * rs;
                    u32x4 w; w.x = cvt_pk_bf16(v0[0], v0[1]); w.y = cvt_pk_bf16(v0[2], v0[3]); w.z = cvt_pk_bf16(v1[0], v1[1]); w.w = cvt_pk_bf16(v1[2], v1[3]);
                    PG8_ST16_WT(w, PG8_RSRC(O, 16384u * 2816u * 2u), ((unsigned)row * (unsigned)ldc + (unsigned)(col0 + bj * HALF)) * 2u);
                }
            }
    }
};
struct EpiRes {
    static constexpr bool PERM = false, AFTER_DRAIN = true, ROWTAB = false;
    const float* base; float* out; bf16_t* xb; float* ss; float alpha;
    __device__ __forceinline__ void fused(f32x4 (&acc)[2][2][4][2], const Unit& u, int wr, int wc, int fr, int fq, PG8_LAS unsigned char* lds, int wid, int lane) const {
        PG8_LAS float* P = (PG8_LAS float*)lds;
        const int col0 = u.pn * BM + wc * 32 + 4 * fq;
#pragma unroll
        for (int ai = 0; ai < 2; ++ai)
#pragma unroll
            for (int m = 0; m < 4; ++m) {
                const int r = ai * HALF + wr * 64 + m * 16 + fr; const size_t off = (size_t)(u.pm * BM + r) * 1024 + col0; float s = 0.f;
                f32x4 bb[2][2];
#pragma unroll
                for (int bj = 0; bj < 2; ++bj)
#pragma unroll
                    for (int n = 0; n < 2; ++n) bb[bj][n] = *(const f32x4*)(base + off + bj * HALF + n * 16);
#pragma unroll
                for (int bj = 0; bj < 2; ++bj)
#pragma unroll
                    for (int n = 0; n < 2; ++n) {
                        const f32x4 o = bb[bj][n] + acc[ai][bj][m][n] * alpha;
                        *(f32x4*)(out + off + bj * HALF + n * 16) = o;
                        u32x2 w; w.x = cvt_pk_bf16(o[0], o[1]); w.y = cvt_pk_bf16(o[2], o[3]);
                        *(u32x2*)(xb + off + bj * HALF + n * 16) = w;
                        s += (o[0] * o[0] + o[1] * o[1]) + (o[2] * o[2] + o[3] * o[3]);
                    }
                s += shx(s, 16); s += shx(s, 32);
                if (fq == 0) P[r * 4 + wc] = s;
            }
        asm volatile("s_waitcnt lgkmcnt(0)" ::: "memory"); __builtin_amdgcn_s_barrier(); asm volatile("" ::: "memory");
        const int tid = wid * 64 + lane;
        if (tid < 256) {
            const f32x4 p = *(const PG8_LAS f32x4*)(P + tid * 4);
            const float t = (p[0] + p[1]) + (p[2] + p[3]);
            __hip_atomic_store((unsigned*)ss + ((size_t)(u.pm * BM + tid) * 4 + u.pn), __float_as_uint(t), __ATOMIC_RELAXED, __HIP_MEMORY_SCOPE_AGENT);
        }
        asm volatile("s_waitcnt lgkmcnt(0)" ::: "memory"); __builtin_amdgcn_s_barrier(); asm volatile("" ::: "memory");
    }
};
struct EpiRes16 {
    static constexpr bool PERM = true, AFTER_DRAIN = true, ROWTAB = false;
    bf16_t* xb; float* ss; float alpha;
    __device__ __forceinline__ void fused(f32x4 (&acc)[2][2][4][2], const Unit& u, int wr, int wc, int fr, int fq, PG8_LAS unsigned char* lds, int wid, int lane) const {
        PG8_LAS float* P = (PG8_LAS float*)lds;
        const int col0 = u.pn * BM + wc * 32 + 8 * fq;
        u32x4 bb[2][4][2];
#pragma unroll
        for (int ai = 0; ai < 2; ++ai)
#pragma unroll
            for (int m = 0; m < 4; ++m)
#pragma unroll
                for (int bj = 0; bj < 2; ++bj) bb[ai][m][bj] = *(const u32x4*)(xb + (size_t)(u.pm * BM + ai * HALF + wr * 64 + m * 16 + fr) * 1024 + col0 + bj * HALF);
#pragma unroll
        for (int ai = 0; ai < 2; ++ai)
#pragma unroll
            for (int m = 0; m < 4; ++m) {
                const int r = ai * HALF + wr * 64 + m * 16 + fr; float s = 0.f;
#pragma unroll
                for (int bj = 0; bj < 2; ++bj) {
                    const f32x4 a0 = acc[ai][bj][m][0] * alpha, a1 = acc[ai][bj][m][1] * alpha; const u32x4 b = bb[ai][m][bj];
                    float o[8];
                    o[0] = __uint_as_float(b.x << 16) + a0[0]; o[1] = __uint_as_float(b.x & 0xffff0000u) + a0[1]; o[2] = __uint_as_float(b.y << 16) + a0[2]; o[3] = __uint_as_float(b.y & 0xffff0000u) + a0[3];
                    o[4] = __uint_as_float(b.z << 16) + a1[0]; o[5] = __uint_as_float(b.z & 0xffff0000u) + a1[1]; o[6] = __uint_as_float(b.w << 16) + a1[2]; o[7] = __uint_as_float(b.w & 0xffff0000u) + a1[3];
                    u32x4 w; w.x = cvt_pk_bf16(o[0], o[1]); w.y = cvt_pk_bf16(o[2], o[3]); w.z = cvt_pk_bf16(o[4], o[5]); w.w = cvt_pk_bf16(o[6], o[7]);
                    PG8_ST16_WT(w, PG8_RSRC(xb, 16384u * 1024u * 2u), ((unsigned)(u.pm * BM + r) * 1024u + (unsigned)(col0 + bj * HALF)) * 2u);
#pragma unroll
                    for (int e = 0; e < 8; ++e) s += o[e] * o[e];
                }
                s += shx(s, 16); s += shx(s, 32);
                if (fq == 0) P[r * 4 + wc] = s;
            }
        asm volatile("s_waitcnt lgkmcnt(0)" ::: "memory"); __builtin_amdgcn_s_barrier(); asm volatile("" ::: "memory");
        const int tid = wid * 64 + lane;
        if (tid < 256) {
            const f32x4 p = *(const PG8_LAS f32x4*)(P + tid * 4);
            const float t = (p[0] + p[1]) + (p[2] + p[3]);
            __hip_atomic_store((unsigned*)ss + ((size_t)(u.pm * BM + tid) * 4 + u.pn), __float_as_uint(t), __ATOMIC_RELAXED, __HIP_MEMORY_SCOPE_AGENT);
        }
        asm volatile("s_waitcnt lgkmcnt(0)" ::: "memory"); __builtin_amdgcn_s_barrier(); asm volatile("" ::: "memory");
    }
};
template <class Epi, class Sched, bool ALIGN_EPI = false, bool SP2 = false>
__device__ __forceinline__ void gemm_phase(PG8_LAS unsigned char* lds, const Gemm g, const Sched& S, const Epi& E) {
    int tid_ = threadIdx.x; asm volatile("" : "+v"(tid_));
    const int tid = tid_, wid = __builtin_amdgcn_readfirstlane(tid >> 6), lane = tid & 63, wr = wid >> 2, wc = wid & 3, fr = lane & 15, fq = lane >> 4;
    const int K = g.K, nt = K / BK;
    unsigned voffA[2], voffB[2];
#pragma unroll
    for (int i = 0; i < 2; ++i) { int R, C; stage_rc(tid * 16 + i * 8192, R, C); const int Rb = Epi::PERM ? ((R & ~31) + perm32(R & 31)) : R;
        voffA[i] = (unsigned)(R * K + C) * 2u; voffB[i] = (unsigned)(Rb * K + C) * 2u; }
    const size_t kstep = (size_t)(BK * 2);
    const size_t hstep = (size_t)HALF * K * 2;
    const size_t tstep = 2 * hstep;
    const unsigned ldsw = (unsigned)wid * 1024u;
    const int aoff = lds_byte(wr * 64 + fr, fq * 8), boff = lds_byte(wc * 32 + fr, fq * 8);
#define PG8_SA(b, h) (((b) * 2 + (h)) * HTB)
#define PG8_SB(b, h) ((4 + (b) * 2 + (h)) * HTB)
#define PG8_STAGE(bufoff, gbase, voff) do { _Pragma("unroll") for (int _i = 0; _i < 2; ++_i) \
        __builtin_amdgcn_global_load_lds((const unsigned*)((const char*)(gbase) + (voff)[_i]), (PG8_LAS unsigned*)(lds + (bufoff) + ldsw + _i * 8192), 16, 0, 0); } while (0)
#define PG8_LDA(dst, b, h) do { _Pragma("unroll") for (int m = 0; m < 4; ++m) _Pragma("unroll") for (int k = 0; k < 2; ++k) dst[m][k] = *(const PG8_LAS bf16x8*)(lds + PG8_SA(b, h) + aoff + m * 2048 + k * 1024); } while (0)
#define PG8_LDB(dst, b, h) do { _Pragma("unroll") for (int n = 0; n < 2; ++n) _Pragma("unroll") for (int k = 0; k < 2; ++k) dst[n][k] = *(const PG8_LAS bf16x8*)(lds + PG8_SB(b, h) + boff + n * 2048 + k * 1024); } while (0)
#define PG8_MMA(ai, bj, At, Bt) do { __builtin_amdgcn_s_setprio(1); _Pragma("unroll") for (int m = 0; m < 4; ++m) _Pragma("unroll") for (int n = 0; n < 2; ++n) _Pragma("unroll") for (int k = 0; k < 2; ++k) \
        acc[ai][bj][m][n] = __builtin_amdgcn_mfma_f32_16x16x32_bf16(Bt[n][k], At[m][k], acc[ai][bj][m][n], 0, 0, 0); __builtin_amdgcn_s_setprio(0); } while (0)
#define PG8_WAIT_V(n) asm volatile("s_waitcnt vmcnt(" #n ")" ::: "memory")
#define PG8_WAIT_L(n) asm volatile("s_waitcnt lgkmcnt(" #n ")" ::: "memory")
#define PG8_BAR __builtin_amdgcn_s_barrier()
#define PG8_SCHED __builtin_amdgcn_sched_barrier(0)
    Unit cur, nxt; int ui = 0;
    if (!S.next(0, cur)) return;
    f32x4 acc[2][2][4][2];
#pragma unroll
    for (int a = 0; a < 2; ++a)
#pragma unroll
        for (int b = 0; b < 2; ++b)
#pragma unroll
            for (int m = 0; m < 4; ++m)
#pragma unroll
                for (int n = 0; n < 2; ++n) acc[a][b][m][n] = (f32x4){0.f, 0.f, 0.f, 0.f};
    bf16x8 At[4][2], B0[2][2], B1[2][2];
    const char* cA = (const char*)g.A + (size_t)cur.pm * tstep; const char* cB = (const char*)g.Bt + (size_t)cur.pn * tstep;
    S.a_ready(cur);
    if constexpr (SP2) {
        PG8_STAGE(PG8_SB(0, 0), cB, voffB); PG8_STAGE(PG8_SB(0, 1), cB + hstep, voffB); PG8_STAGE(PG8_SA(0, 0), cA, voffA); PG8_STAGE(PG8_SA(0, 1), cA + hstep, voffA);
        if (wr == 1) PG8_BAR;
        PG8_WAIT_V(2); PG8_BAR;
        PG8_STAGE(PG8_SB(1, 0), cB + kstep, voffB); PG8_STAGE(PG8_SA(1, 0), cA + kstep, voffA); PG8_STAGE(PG8_SB(1, 1), cB + hstep + kstep, voffB);
        PG8_WAIT_V(6); PG8_BAR;
    } else {
        PG8_STAGE(PG8_SB(0, 0), cB, voffB); PG8_STAGE(PG8_SA(0, 0), cA, voffA); PG8_STAGE(PG8_SB(0, 1), cB + hstep, voffB); PG8_STAGE(PG8_SA(0, 1), cA + hstep, voffA);
        if (wr == 1) PG8_BAR;
        PG8_WAIT_V(4); PG8_BAR;
        PG8_STAGE(PG8_SB(1, 0), cB + kstep, voffB); PG8_STAGE(PG8_SA(1, 0), cA + kstep, voffA); PG8_STAGE(PG8_SB(1, 1), cB + hstep + kstep, voffB);
        PG8_WAIT_V(6); PG8_BAR;
    }
    for (;;) {
        const bool has_next = S.next(ui + 1, nxt);
        const char* nA = has_next ? (const char*)g.A + (size_t)nxt.pm * tstep : cA; const char* nB = has_next ? (const char*)g.Bt + (size_t)nxt.pn * tstep : cB;
        for (int t = 0; t < nt; t += 2) {
            const bool last = (t == nt - 2);

            const char* a1 = cA + (size_t)(t + 1) * kstep;
            const char* a2 = last ? nA : cA + (size_t)(t + 2) * kstep; const char* b2 = last ? nB : cB + (size_t)(t + 2) * kstep;
            const char* a3 = a2 + kstep; const char* b3 = b2 + kstep;
            if (last && has_next) S.a_ready(nxt);
            if constexpr (SP2) {
            PG8_LDB(B0, 0, 0); PG8_LDB(B1, 0, 1); PG8_SCHED; PG8_LDA(At, 0, 0); PG8_STAGE(PG8_SA(1, 1), a1 + hstep, voffA);
            PG8_WAIT_V(8); PG8_WAIT_L(0); PG8_BAR; PG8_MMA(0, 0, At, B0); PG8_MMA(0, 1, At, B1); PG8_BAR; PG8_SCHED;
            PG8_LDA(At, 0, 1); PG8_STAGE(PG8_SB(0, 0), b2, voffB); PG8_STAGE(PG8_SB(0, 1), b2 + hstep, voffB); PG8_STAGE(PG8_SA(0, 0), a2, voffA);
            PG8_WAIT_V(8); PG8_WAIT_L(0); PG8_BAR; PG8_MMA(1, 0, At, B0); PG8_MMA(1, 1, At, B1); PG8_BAR; PG8_SCHED;
            PG8_LDB(B0, 1, 0); PG8_LDB(B1, 1, 1); PG8_SCHED; PG8_LDA(At, 1, 0); PG8_STAGE(PG8_SA(0, 1), a2 + hstep, voffA);
            PG8_WAIT_V(8); PG8_WAIT_L(0); PG8_BAR; PG8_MMA(0, 0, At, B0); PG8_MMA(0, 1, At, B1); PG8_BAR; PG8_SCHED;
            PG8_LDA(At, 1, 1); PG8_STAGE(PG8_SB(1, 0), b3, voffB); PG8_STAGE(PG8_SB(1, 1), b3 + hstep, voffB); PG8_STAGE(PG8_SA(1, 0), a3, voffA);
            PG8_WAIT_V(8); PG8_WAIT_L(0); PG8_BAR; PG8_MMA(1, 0, At, B0); PG8_MMA(1, 1, At, B1); PG8_BAR; PG8_SCHED;
            } else {
            PG8_LDB(B0, 0, 0); PG8_SCHED; PG8_LDA(At, 0, 0); PG8_STAGE(PG8_SA(1, 1), a1 + hstep, voffA);
            PG8_WAIT_L(8); PG8_BAR; PG8_WAIT_L(0); PG8_MMA(0, 0, At, B0); PG8_BAR; PG8_SCHED;
            PG8_LDB(B1, 0, 1); PG8_STAGE(PG8_SB(0, 0), b2, voffB);
            PG8_BAR; PG8_WAIT_L(0); PG8_MMA(0, 1, At, B1); PG8_BAR;
            PG8_LDA(At, 0, 1); PG8_STAGE(PG8_SA(0, 0), a2, voffA);
            PG8_BAR; PG8_WAIT_L(0); PG8_MMA(1, 0, At, B0); PG8_BAR; PG8_SCHED;
            PG8_STAGE(PG8_SB(0, 1), b2 + hstep, voffB);
            PG8_WAIT_V(6); PG8_BAR; PG8_MMA(1, 1, At, B1); PG8_BAR;
            PG8_LDB(B0, 1, 0); PG8_SCHED; PG8_LDA(At, 1, 0); PG8_STAGE(PG8_SA(0, 1), a2 + hstep, voffA);
            PG8_WAIT_L(8); PG8_BAR; PG8_WAIT_L(0); PG8_MMA(0, 0, At, B0); PG8_BAR; PG8_SCHED;
            PG8_LDB(B1, 1, 1); PG8_STAGE(PG8_SB(1, 0), b3, voffB);
            PG8_BAR; PG8_WAIT_L(0); PG8_MMA(0, 1, At, B1); PG8_BAR;
            PG8_LDA(At, 1, 1); PG8_STAGE(PG8_SA(1, 0), a3, voffA);
            PG8_BAR; PG8_WAIT_L(0); PG8_MMA(1, 0, At, B0); PG8_BAR; PG8_SCHED;
            PG8_STAGE(PG8_SB(1, 1), b3 + hstep, voffB);
            PG8_WAIT_V(6); PG8_BAR; PG8_MMA(1, 1, At, B1); PG8_BAR;
            }
            if constexpr (Epi::ROWTAB) { if (t == 0 && wid < 4) {
                int ln_; asm volatile("v_mbcnt_lo_u32_b32 %0, -1, 0\n\tv_mbcnt_hi_u32_b32 %0, -1, %0" : "=v"(ln_)); const unsigned voff = (unsigned)(ln_ + wid * 64) * 16u; const char* sb = (const char*)E.ss + (size_t)cur.pm * 4096;
                const unsigned ldst = (unsigned)__builtin_amdgcn_readfirstlane((int)(unsigned)(size_t)(lds + STAGE_BYTES) + wid * 1024); unsigned keep;
                asm volatile("s_mov_b32 %0, m0\n\ts_mov_b32 m0, %3\n\ts_nop 0\n\tglobal_load_lds_dwordx4 %1, %2\n\ts_mov_b32 m0, %0" : "=&s"(keep) : "v"(voff), "s"(sb), "s"(ldst) : "memory"); } }
        }
        if constexpr (ALIGN_EPI) { if (wr == 0) PG8_BAR; }
        if constexpr (!Epi::AFTER_DRAIN) { if constexpr (Epi::ROWTAB) E(acc, cur, wr, wc, fr, fq, (const PG8_LAS float*)(lds + STAGE_BYTES)); else E(acc, cur, wr, wc, fr, fq); S.done(cur); }
        if (!has_next) break;
#pragma unroll
        for (int a = 0; a < 2; ++a)
#pragma unroll
            for (int b = 0; b < 2; ++b)
#pragma unroll
                for (int m = 0; m < 4; ++m)
#pragma unroll
                    for (int n = 0; n < 2; ++n) acc[a][b][m][n] = (f32x4){0.f, 0.f, 0.f, 0.f};
        cur = nxt; cA = nA; cB = nB; ++ui;
        if constexpr (ALIGN_EPI) { if (wr == 1) PG8_BAR; }
    }
    PG8_WAIT_V(0);
    if constexpr (!ALIGN_EPI) { if (wr == 0) PG8_BAR; }
    PG8_BAR;
    if constexpr (Epi::AFTER_DRAIN) { E.fused(acc, cur, wr, wc, fr, fq, lds, wid, lane); S.done(cur); }
#undef PG8_SA
#undef PG8_SB
#undef PG8_STAGE
#undef PG8_LDA
#undef PG8_LDB
#undef PG8_MMA
#undef PG8_WAIT_V
#undef PG8_WAIT_L
#undef PG8_BAR
#undef PG8_SCHED
}
}
#include <hip/hip_bf16.h>
#include <cmath>
namespace attn_body {
using bf16=__hip_bfloat16;
using bf16x8=__attribute__((ext_vector_type(8)))short;
using s16x4=__attribute__((ext_vector_type(4)))short;
using f32x16=__attribute__((ext_vector_type(16)))float;
using u32x4=__attribute__((ext_vector_type(4)))unsigned;
constexpr int BATCH=4,NHEAD=16,SEQ=4096,D=64,DM=2816,OP=1024;
constexpr int NW=8,QBLK=32,QB=QBLK*NW,KVBLK=64,NQB=SEQ/QB;
constexpr int ATTN_PITCH=DM, ATTN_UNIT_ROWS=QB;
__device__ __forceinline__ int crow(int r,int hi){return (r&3)+8*(r>>2)+4*hi;}
#define SBAR() __builtin_amdgcn_sched_barrier(0)
typedef __attribute__((address_space(3))) const float* lds_cfptr;
__device__ __forceinline__ void cmask(f32x16&p0,f32x16&p1,int jb,int qrel,int hi,lds_cfptr bt){
  const float NEG=-INFINITY; const int d00=qrel-(64*jb+4*hi);
  #pragma unroll
  for(int r=0;r<16;++r){const int d0=d00-((r&3)+8*(r>>2)), d1=d0-32;
    p0[r]+=bt[d0<0?0:d0]; p1[r]+=bt[d1<0?0:d1]; if(d0<0)p0[r]=NEG; if(d1<0)p1[r]=NEG;
    if((r&3)==3)__builtin_amdgcn_sched_barrier(0);}
}

constexpr int NSLOT=3, SLOTB=8192;
constexpr int LDS_K=0, LDS_V=NSLOT*SLOTB, LDS_WS=2*NSLOT*SLOTB, LDS_OST=LDS_WS+NW*64*4, LDS_BT=LDS_OST+NW*4096, LDS_BYTES=LDS_BT+1536;
constexpr float C2=0.125f*1.4426950408889634f;
__device__ __forceinline__ void glds16(const void*gsrc,unsigned lds_dst){unsigned keep;
  asm volatile("s_mov_b32 %0, m0\n\ts_mov_b32 m0, %2\n\ts_nop 0\n\tglobal_load_lds_dwordx4 %1, off\n\ts_mov_b32 m0, %0":"=&s"(keep):"v"(gsrc),"s"(lds_dst):"memory");}
__device__ __forceinline__ float max3f(float a,float b,float c){float r;asm("v_max3_f32 %0, %1, %2, %3":"=v"(r):"v"(a),"v"(b),"v"(c));return r;}
__device__ __forceinline__ float max2f(float a,float b){float r;asm("v_max_f32_e32 %0, %1, %2":"=v"(r):"v"(a),"v"(b));return r;}
__device__ __forceinline__ float fadd_s(float a,float b){float r;asm("v_add_f32_e32 %0, %1, %2":"=v"(r):"v"(a),"v"(b));return r;}
__device__ __forceinline__ float fsub_s(float a,float b){float r;asm("v_sub_f32_e32 %0, %1, %2":"=v"(r):"v"(a),"v"(b));return r;}
typedef float f32x2_t __attribute__((ext_vector_type(2))); typedef __bf16 bf16x2_t __attribute__((ext_vector_type(2)));
__device__ __forceinline__ unsigned cvtpk_s(float lo,float hi){f32x2_t v={lo,hi};bf16x2_t b=__builtin_convertvector(v,bf16x2_t);return __builtin_bit_cast(unsigned,b);}
#define WAIT_BAR(N) asm volatile("s_waitcnt vmcnt(" #N ") lgkmcnt(0)\n\ts_barrier":::"memory")

__device__ __forceinline__ void qkt(f32x16&p0,f32x16&p1,const char*Kslot,const bf16x8*qr,const f32x16&negm,int r32,int hi){
  const char*kb=Kslot+hi*1024+r32*16;
  #pragma unroll
  for(int d0=0;d0<4;++d0){
    const bf16x8 b0=*reinterpret_cast<const bf16x8*>(kb+d0*2048);
    const bf16x8 b1=*reinterpret_cast<const bf16x8*>(kb+d0*2048+512);
    if(d0==0){p0=__builtin_amdgcn_mfma_f32_32x32x16_bf16(b0,qr[0],negm,0,0,0);p1=__builtin_amdgcn_mfma_f32_32x32x16_bf16(b1,qr[0],negm,0,0,0);}
    else{p0=__builtin_amdgcn_mfma_f32_32x32x16_bf16(b0,qr[d0],p0,0,0,0);p1=__builtin_amdgcn_mfma_f32_32x32x16_bf16(b1,qr[d0],p1,0,0,0);}}
}
typedef __attribute__((address_space(3))) const char* lds_cptr;
typedef short v4i16_t __attribute__((ext_vector_type(4)));
__device__ __forceinline__ void kload8(bf16x8*kf,lds_cptr kp){
  kf[0]=*(const __attribute__((address_space(3))) bf16x8*)(kp);      kf[1]=*(const __attribute__((address_space(3))) bf16x8*)(kp+512);
  kf[2]=*(const __attribute__((address_space(3))) bf16x8*)(kp+2048); kf[3]=*(const __attribute__((address_space(3))) bf16x8*)(kp+2560);
  kf[4]=*(const __attribute__((address_space(3))) bf16x8*)(kp+4096); kf[5]=*(const __attribute__((address_space(3))) bf16x8*)(kp+4608);
  kf[6]=*(const __attribute__((address_space(3))) bf16x8*)(kp+6144); kf[7]=*(const __attribute__((address_space(3))) bf16x8*)(kp+6656);
}
__device__ __forceinline__ void kload2(bf16x8*kf,lds_cptr kp,int j){ kf[2*j]=*(const __attribute__((address_space(3))) bf16x8*)(kp+j*2048); kf[2*j+1]=*(const __attribute__((address_space(3))) bf16x8*)(kp+j*2048+512); }
__device__ __forceinline__ s16x4 vtr(lds_cptr p){ return __builtin_bit_cast(s16x4,__builtin_amdgcn_ds_read_tr16_b64_v4i16((__attribute__((address_space(3))) v4i16_t*)p)); }
__device__ __forceinline__ float rowmax(const f32x16&p0,const f32x16&p1){
  float a=max3f(p0[0],p0[1],p1[0]),b=max3f(p0[2],p0[3],p1[1]);a=max3f(a,p1[2],p1[3]);
  #pragma unroll
  for(int r=4;r<16;r+=4){a=max3f(a,p0[r],p0[r+1]);b=max3f(b,p0[r+2],p0[r+3]);a=max3f(a,p1[r],p1[r+1]);b=max3f(b,p1[r+2],p1[r+3]);}
  const float m=max2f(a,b);
  auto rr=__builtin_amdgcn_permlane32_swap(__float_as_uint(m),__float_as_uint(m),false,false);
  return max2f(__uint_as_float(rr[0]),__uint_as_float(rr[1]));
}
__device__ __forceinline__ void pv(f32x16*o,int vb,bf16x8 pa0,bf16x8 pa1,bf16x8 pa2,bf16x8 pa3){
  #pragma unroll
  for(int d0=0;d0<2;++d0){s16x4 lo[4],hi[4];
    #pragma unroll
    for(int ks=0;ks<4;++ks){
      asm volatile("ds_read_b64_tr_b16 %0,%1 offset:%c2":"=&v"(lo[ks]):"v"(vb),"i"(d0*4096+ks*1024):"memory");
      asm volatile("ds_read_b64_tr_b16 %0,%1 offset:%c2":"=&v"(hi[ks]):"v"(vb),"i"(d0*4096+ks*1024+512):"memory");}
    asm volatile("s_waitcnt lgkmcnt(0)":::"memory");SBAR();
    #define PK(k) (bf16x8){lo[k][0],lo[k][1],lo[k][2],lo[k][3],hi[k][0],hi[k][1],hi[k][2],hi[k][3]}
    o[d0]=__builtin_amdgcn_mfma_f32_32x32x16_bf16(pa0,PK(0),o[d0],0,0,0);
    o[d0]=__builtin_amdgcn_mfma_f32_32x32x16_bf16(pa1,PK(1),o[d0],0,0,0);
    o[d0]=__builtin_amdgcn_mfma_f32_32x32x16_bf16(pa2,PK(2),o[d0],0,0,0);
    o[d0]=__builtin_amdgcn_mfma_f32_32x32x16_bf16(pa3,PK(3),o[d0],0,0,0);
    #undef PK
  }
}

#ifndef ATTN_STORE16
#define ATTN_STORE16(p,v) (*(u32x4*)(p)=(v))
#endif
template<int THRL> __device__ __forceinline__ void attn_unit(int b,int g,int qb,const bf16*__restrict__ Zb,bf16*O,const float*__restrict__ btab,char*shm){
  int tid_=threadIdx.x; asm volatile("":"+v"(tid_)); const int tid=tid_,lane=tid&63,r32=lane&31,hi=lane>>5; const int wid=__builtin_amdgcn_readfirstlane(tid>>6);
  const long rowbase=(long)b*SEQ; const int q0=qb*QB;
  const int hm=g>>1;
  const float btv=(tid<384)?btab[hm*384+tid]:0.f;
  const bf16*Qw=Zb+(rowbase+q0+wid*QBLK)*DM+hm*D;
  const bf16*Kh=Zb+rowbase*DM+512+hm*D,*Vh=Zb+rowbase*DM+1024+(g>>2)*128+(g&1)*64;
  const unsigned lds0=(unsigned)(uintptr_t)shm;
  float*wsf=(float*)(shm+LDS_WS)+wid*64;
  const bf16*ksrc=Kh+(long)lane*DM+wid*8;
  const bf16*vsrc=Vh+(long)(16*(wid&3)+(lane>>2))*DM+(wid>>2)*32+(lane&3)*8;
  const unsigned kdst=lds0+LDS_K+wid*1024, vdst=lds0+LDS_V+wid*1024;
  #define DMA_K(t,slot) glds16(ksrc+(long)(t)*KVBLK*DM,(unsigned)__builtin_amdgcn_readfirstlane(kdst+(slot)))
  #define DMA_V(t,slot) glds16(vsrc+(long)(t)*KVBLK*DM,(unsigned)__builtin_amdgcn_readfirstlane(vdst+(slot)))
  const int vb0=(int)(lds0+LDS_V)+((lane>>4)&1)*32+(lane&3)*8+(4*hi+((lane&15)>>2))*64;
  const char*Kbase=shm+LDS_K; bf16x8 kf[8];
  const lds_cptr shm3=(lds_cptr)shm; const lds_cptr kp0=shm3+LDS_K+hi*1024+r32*16; const lds_cptr vp0=shm3+LDS_V+((lane>>4)&1)*32+(lane&3)*8+(4*hi+((lane&15)>>2))*64;
  const int NT=(q0+QB)/KVBLK;
  DMA_K(0,0);DMA_V(0,0);DMA_K(1,SLOTB);
  bf16x8 qr[4];
  #pragma unroll
  for(int d0=0;d0<4;++d0)qr[d0]=*reinterpret_cast<const bf16x8*>(&Qw[(long)r32*DM+d0*16+hi*8]);
  const lds_cfptr btl=(lds_cfptr)((lds_cptr)shm+LDS_BT); if(tid<384)((__attribute__((address_space(3))) float*)((__attribute__((address_space(3))) char*)shm+LDS_BT))[tid]=btv;
  float mhat=0.f,l_reg=0.f;f32x16 o[2];o[0]=f32x16{};o[1]=f32x16{};f32x16 negm=f32x16{};asm volatile("":"+v"(negm));
  const int qrel=wid*QBLK+r32;
  #define CMASK(P0,P1,t) do{int jb_=(t)-(NT-4); if(jb_>=-2)cmask(P0,P1,jb_,qrel,hi,btl);}while(0)
  bool resc=false;
  #define START(P0,P1) do{ const float rm=rowmax(P0,P1); resc=false; \
    { const float dl=rm; mhat=fadd_s(mhat,dl); \
      _Pragma("unroll") for(int r=0;r<16;++r){P0[r]=fsub_s(P0[r],dl);P1[r]=fsub_s(P1[r],dl);} \
      _Pragma("unroll") for(int r=0;r<16;++r)negm[r]=-mhat; asm volatile("":"+v"(negm)); } \
    _Pragma("unroll") for(int r=0;r<16;++r)P0[r]=__builtin_amdgcn_exp2f(P0[r]); }while(0)
  #define RESC() do{ if(resc){ asm volatile("s_waitcnt lgkmcnt(0)":::"memory"); \
      _Pragma("unroll") for(int d_=0;d_<2;++d_) _Pragma("unroll") for(int r=0;r<16;++r)o[d_][r]*=wsf[crow(r,hi)]; } }while(0)
  f32x16 pA0,pA1,pB0,pB1;
  int sl_prev=0,sl_cur=0,sl_next=SLOTB;
  #define ROT() do{sl_prev=sl_cur;sl_cur=sl_next;sl_next=(sl_next==(NSLOT-1)*SLOTB)?0:sl_next+SLOTB;}while(0)
  DMA_K(2,2*SLOTB);
  WAIT_BAR(3);
  qkt(pA0,pA1,Kbase,qr,negm,r32,hi);asm volatile("s_nop 15\n\ts_nop 7":"+v"(pA0),"+v"(pA1));CMASK(pA0,pA1,0);
  START(pA0,pA1);
  _Pragma("unroll") for(int r=0;r<16;++r)pA1[r]=__builtin_amdgcn_exp2f(pA1[r]);
  WAIT_BAR(0);
  DMA_K(3,0);DMA_V(1,SLOTB);
  ROT();
  kload8(kf,kp0+sl_cur);
  WAIT_BAR(2);
  s16x4 vlo[8],vhi[8]; u32x4 pw0,pw1,pw2,pw3;
  #define PKW(P,B) cvtpk_s(P[B],P[B+1])
  #define PAF(k) __builtin_bit_cast(bf16x8,pw##k)
  #define VFR(i) (bf16x8){vlo[i][0],vlo[i][1],vlo[i][2],vlo[i][3],vhi[i][0],vhi[i][1],vhi[i][2],vhi[i][3]}
  #define PIN(x) asm volatile("":"+v"(x))
  #define MX3(a,b,c) __builtin_fmaxf(__builtin_fmaxf((a),(b)),(c))
  #define GAPA(MF,A0,A1,A2,A3,W0,W1,PW) do{ MF; sacc+=A0; sacc+=A1; sacc+=A2; sacc+=A3; PIN(sacc); W0; W1; PIN(PW); SBAR(); }while(0)
  #define EX(v) __builtin_amdgcn_exp2f(v)
  #define GAPB(MF,X,B) do{ MF; X[B]=EX(X[B]); X[B+1]=EX(X[B+1]); X[B+2]=EX(X[B+2]); X[B+3]=EX(X[B+3]); PIN(X); SBAR(); }while(0)
  #define VRD(i) do{ vlo[i]=vtr(vp_+(((i)>>2)*4096+((i)&3)*1024)); vhi[i]=vtr(vp_+(((i)>>2)*4096+((i)&3)*1024+512)); }while(0)
  #define KRD(G,j) do{ if(G){ kload2(kf,kp0+sl_next,j); SBAR(); } }while(0)
  #define STEP(C0,C1,P0,P1,t,GK,GV,GL) do{ SBAR(); \
    const lds_cptr vp_=vp0+sl_prev; \
    VRD(0); SBAR(); float sacc=(P0[0]+P0[1]); \
    GAPA(C0=__builtin_amdgcn_mfma_f32_32x32x16_bf16(kf[0],qr[0],negm,0,0,0), P0[2],P0[3],P0[4],P0[5],     pw0[0]=PKW(P0,0), pw0[1]=PKW(P0,2), pw0); \
    VRD(4); SBAR(); GAPA(C1=__builtin_amdgcn_mfma_f32_32x32x16_bf16(kf[1],qr[0],negm,0,0,0), P0[6],P0[7],P0[8],P0[9],     pw0[2]=PKW(P0,4), pw0[3]=PKW(P0,6), pw0); \
    VRD(1); SBAR(); GAPA(C0=__builtin_amdgcn_mfma_f32_32x32x16_bf16(kf[2],qr[1],C0,0,0,0),   P0[10],P0[11],P0[12],P0[13], pw1[0]=PKW(P0,8), pw1[1]=PKW(P0,10), pw1); \
    VRD(5); SBAR(); GAPA(C1=__builtin_amdgcn_mfma_f32_32x32x16_bf16(kf[3],qr[1],C1,0,0,0),   P0[14],P0[15],P1[0],P1[1],   pw1[2]=PKW(P0,12),pw1[3]=PKW(P0,14), pw1); \
    VRD(2); SBAR(); GAPA(C0=__builtin_amdgcn_mfma_f32_32x32x16_bf16(kf[4],qr[2],C0,0,0,0),   P1[2],P1[3],P1[4],P1[5],     pw2[0]=PKW(P1,0), pw2[1]=PKW(P1,2), pw2); \
    VRD(6); SBAR(); GAPA(C1=__builtin_amdgcn_mfma_f32_32x32x16_bf16(kf[5],qr[2],C1,0,0,0),   P1[6],P1[7],P1[8],P1[9],     pw2[2]=PKW(P1,4), pw2[3]=PKW(P1,6), pw2); \
    VRD(3); SBAR(); GAPA(C0=__builtin_amdgcn_mfma_f32_32x32x16_bf16(kf[6],qr[3],C0,0,0,0),   P1[10],P1[11],P1[12],P1[13], pw3[0]=PKW(P1,8), pw3[1]=PKW(P1,10), pw3); \
    VRD(7); SBAR(); GAPA(C1=__builtin_amdgcn_mfma_f32_32x32x16_bf16(kf[7],qr[3],C1,0,0,0),   P1[14],P1[15],0.f,0.f,       pw3[2]=PKW(P1,12),pw3[3]=PKW(P1,14), pw3); \
    l_reg+=sacc; \
    if(GK){DMA_K((t)+3,sl_cur);} if(GV){DMA_V((t)+1,sl_next);} \
    CMASK(C0,C1,t); \
    { float a=MX3(C0[0],C0[1],C1[0]),b=MX3(C0[2],C0[3],C1[1]); a=MX3(a,C1[2],C1[3]); \
      _Pragma("unroll") for(int r=4;r<16;r+=4){a=MX3(a,C0[r],C0[r+1]);b=MX3(b,C0[r+2],C0[r+3]);a=MX3(a,C1[r],C1[r+1]);b=MX3(b,C1[r+2],C1[r+3]);} \
      float rm=__builtin_fmaxf(a,b); { auto rr=__builtin_amdgcn_permlane32_swap(__float_as_uint(rm),__float_as_uint(rm),false,false); rm=__builtin_fmaxf(__uint_as_float(rr[0]),__uint_as_float(rr[1])); } \
      resc=false; \
      if(__builtin_expect(__any(rm>(float)THRL),0)){ const float dl=__builtin_fmaxf(rm,0.f); mhat+=dl; \
        _Pragma("unroll") for(int r=0;r<16;++r){C0[r]-=dl;C1[r]-=dl;} \
        _Pragma("unroll") for(int r=0;r<16;++r)negm[r]=-mhat; asm volatile("":"+v"(negm)); \
        const float f=__builtin_amdgcn_exp2f(-dl); l_reg*=f; if(hi==0)wsf[r32]=f; resc=true; } } \
    SBAR(); \
    GAPB(o[0]=__builtin_amdgcn_mfma_f32_32x32x16_bf16(PAF(0),VFR(0),o[0],0,0,0), C0,0); \
    GAPB(o[1]=__builtin_amdgcn_mfma_f32_32x32x16_bf16(PAF(0),VFR(4),o[1],0,0,0), C0,4); \
    KRD(GL,0); GAPB(o[0]=__builtin_amdgcn_mfma_f32_32x32x16_bf16(PAF(1),VFR(1),o[0],0,0,0), C0,8); \
    KRD(GL,1); GAPB(o[1]=__builtin_amdgcn_mfma_f32_32x32x16_bf16(PAF(1),VFR(5),o[1],0,0,0), C0,12); \
    KRD(GL,2); GAPB(o[0]=__builtin_amdgcn_mfma_f32_32x32x16_bf16(PAF(2),VFR(2),o[0],0,0,0), C1,0); \
    KRD(GL,3); GAPB(o[1]=__builtin_amdgcn_mfma_f32_32x32x16_bf16(PAF(2),VFR(6),o[1],0,0,0), C1,4); \
    GAPB(o[0]=__builtin_amdgcn_mfma_f32_32x32x16_bf16(PAF(3),VFR(3),o[0],0,0,0), C1,8); \
    GAPB(o[1]=__builtin_amdgcn_mfma_f32_32x32x16_bf16(PAF(3),VFR(7),o[1],0,0,0), C1,12); \
    }while(0)
  int t=1;
  #undef CMASK
  #define CMASK(P0,P1,t) do{int jb_=(t)-(NT-4); if(jb_>=-2)cmask(P0,P1,jb_,qrel,hi,btl);}while(0)
  for(;t+5<NT;t+=2){
    STEP(pB0,pB1,pA0,pA1,t,true,true,true);     WAIT_BAR(2); RESC(); ROT();
    STEP(pA0,pA1,pB0,pB1,t+1,true,true,true);   WAIT_BAR(2); RESC(); ROT();
  }
  #undef CMASK
  #define CMASK(P0,P1,t) do{int jb_=(t)-(NT-4); if(jb_>=-2)cmask(P0,P1,jb_,qrel,hi,btl);}while(0)
  #define ENDW(tt) do{ if((tt)+3<NT){WAIT_BAR(2);} else if((tt)+2<NT){WAIT_BAR(1);} else {WAIT_BAR(0);} }while(0)
  for(;t+1<NT;t+=2){
    STEP(pB0,pB1,pA0,pA1,t,(t+3<NT),(t+1<NT),(t+1<NT));       ENDW(t);   RESC(); ROT();
    STEP(pA0,pA1,pB0,pB1,t+1,(t+4<NT),(t+2<NT),(t+2<NT));     ENDW(t+1); RESC(); ROT();
  }
  STEP(pB0,pB1,pA0,pA1,NT-1,false,false,false); RESC();
  { float sacc=pB0[0]+pB0[1]; _Pragma("unroll") for(int r=2;r<16;++r)sacc+=pB0[r]; _Pragma("unroll") for(int r=0;r<16;++r)sacc+=pB1[r]; l_reg+=sacc;
    pw0=(u32x4){PKW(pB0,0),PKW(pB0,2),PKW(pB0,4),PKW(pB0,6)};pw1=(u32x4){PKW(pB0,8),PKW(pB0,10),PKW(pB0,12),PKW(pB0,14)};pw2=(u32x4){PKW(pB1,0),PKW(pB1,2),PKW(pB1,4),PKW(pB1,6)};pw3=(u32x4){PKW(pB1,8),PKW(pB1,10),PKW(pB1,12),PKW(pB1,14)};
    SBAR(); pv(o,vb0+sl_cur,PAF(0),PAF(1),PAF(2),PAF(3)); }
  #undef PKW
  #undef PAF
  #undef VFR
  #undef PIN
  #undef MX3
  #undef GAPA
  #undef GAPB
  #undef EX
  #undef VRD
  #undef KRD
  #undef STEP
  #undef ENDW
  {auto rr=__builtin_amdgcn_permlane32_swap(__float_as_uint(l_reg),__float_as_uint(l_reg),false,false);l_reg=__uint_as_float(rr[0])+__uint_as_float(rr[1]);}
  if(hi==0)wsf[32+r32]=l_reg;asm volatile("s_waitcnt lgkmcnt(0)":::"memory");
  float rli[16];
  #pragma unroll
  for(int r=0;r<16;++r)rli[r]=__builtin_amdgcn_rcpf(wsf[32+crow(r,hi)]);
  bf16*Ow=O+(rowbase+q0+wid*QBLK)*OP+g*D;
  { bf16*stg=(bf16*)(shm+LDS_OST)+wid*2048;
    #pragma unroll
    for(int r=0;r<16;++r){const int orow=crow(r,hi);
      #pragma unroll
      for(int d0=0;d0<2;++d0)stg[orow*64+d0*32+r32]=__float2bfloat16(o[d0][r]*rli[r]);}
    asm volatile("s_waitcnt lgkmcnt(0)":::"memory");
    #pragma unroll
    for(int i=0;i<4;++i){const int row=i*8+(lane>>3),ch=lane&7; const u32x4 v=*(const u32x4*)(stg+row*64+ch*8); ATTN_STORE16(Ow+(long)row*OP+ch*8,v);} }
  asm volatile("s_waitcnt lgkmcnt(0)\n\ts_barrier":::"memory");
  #undef DMA_K
  #undef DMA_V
  #undef CMASK
  #undef START
  #undef RESC
  #undef ROT
}
constexpr int ATTN_LDS_BYTES=LDS_BYTES;
struct AttnTensors { const bf16* Z; bf16* O; const float* btab; };
struct AttnUnit { int bh; int qb; };
struct StaticOrder {
  int vcu;
  __device__ __forceinline__ explicit StaticOrder(int grid,int block):vcu((block%8)*(grid/8)+block/8){}
  __device__ __forceinline__ bool next(int i,AttnUnit&u)const{ if(i>=4)return false; const int s=vcu&3; u.bh=vcu>>2; u.qb=(i==0)?15-s:(i==1)?8+s:(i==2)?7-s:s; return true; }
  __device__ __forceinline__ void a_ready(const AttnUnit&)const{}
  __device__ __forceinline__ void done(const AttnUnit&)const{}
};
template<class Sched,int THRL=8> __device__ __forceinline__ void attn_phase(char*lds,const AttnTensors&T,const Sched&S){
  AttnUnit u;
  for(int i=0;S.next(i,u);++i){ S.a_ready(u); attn_unit<THRL>(u.bh/NHEAD,u.bh%NHEAD,u.qb,T.Z,T.O,T.btab,lds); S.done(u); }
}
#undef SBAR
#undef WAIT_BAR
}
namespace attn128 {
using bf16=__hip_bfloat16;
using bf16x8=__attribute__((ext_vector_type(8)))short;
using s16x4=__attribute__((ext_vector_type(4)))short;
using f32x16=__attribute__((ext_vector_type(16)))float;
using u32x4=__attribute__((ext_vector_type(4)))unsigned;
constexpr int BATCH=4,NHEAD=16,SEQ=4096,D=64,DM=2816,OP=1024;
constexpr int NW=8,QBLK=32,QB=QBLK*NW,KVBLK=64,NQB=SEQ/QB;
constexpr int ATTN_PITCH=DM, ATTN_UNIT_ROWS=QB;
__device__ __forceinline__ int crow(int r,int hi){return (r&3)+8*(r>>2)+4*hi;}
#define SBAR() __builtin_amdgcn_sched_barrier(0)
typedef __attribute__((address_space(3))) const float* lds_cfptr;
__device__ __forceinline__ void cmask(f32x16&p0,f32x16&p1,int jb,int qrel,int hi,lds_cfptr bt){
  const float NEG=-INFINITY; const int d00=qrel-(64*jb+4*hi);
  #pragma unroll
  for(int r=0;r<16;++r){const int d0=d00-((r&3)+8*(r>>2)), d1=d0-32;
    p0[r]+=bt[d0<0?0:d0]; p1[r]+=bt[d1<0?0:d1]; if(d0<0)p0[r]=NEG; if(d1<0)p1[r]=NEG;
    if((r&3)==3)__builtin_amdgcn_sched_barrier(0);}
}

constexpr int NSLOT=3, SLOTB=8192;
constexpr int LDS_K=0, LDS_V=NSLOT*SLOTB, LDS_WS=3*NSLOT*SLOTB, LDS_OST=LDS_WS+NW*64*4, LDS_BT=LDS_OST+NW*4096, LDS_BYTES=LDS_BT+1536;
constexpr float C2=0.125f*1.4426950408889634f;
__device__ __forceinline__ void glds16(const void*gsrc,unsigned lds_dst){unsigned keep;
  asm volatile("s_mov_b32 %0, m0\n\ts_mov_b32 m0, %2\n\ts_nop 0\n\tglobal_load_lds_dwordx4 %1, off\n\ts_mov_b32 m0, %0":"=&s"(keep):"v"(gsrc),"s"(lds_dst):"memory");}
__device__ __forceinline__ float max3f(float a,float b,float c){float r;asm("v_max3_f32 %0, %1, %2, %3":"=v"(r):"v"(a),"v"(b),"v"(c));return r;}
__device__ __forceinline__ float max2f(float a,float b){float r;asm("v_max_f32_e32 %0, %1, %2":"=v"(r):"v"(a),"v"(b));return r;}
__device__ __forceinline__ float fadd_s(float a,float b){float r;asm("v_add_f32_e32 %0, %1, %2":"=v"(r):"v"(a),"v"(b));return r;}
__device__ __forceinline__ float fsub_s(float a,float b){float r;asm("v_sub_f32_e32 %0, %1, %2":"=v"(r):"v"(a),"v"(b));return r;}
typedef float f32x2_t __attribute__((ext_vector_type(2))); typedef __bf16 bf16x2_t __attribute__((ext_vector_type(2)));
__device__ __forceinline__ unsigned cvtpk_s(float lo,float hi){f32x2_t v={lo,hi};bf16x2_t b=__builtin_convertvector(v,bf16x2_t);return __builtin_bit_cast(unsigned,b);}
#define WAIT_BAR(N) asm volatile("s_waitcnt vmcnt(" #N ") lgkmcnt(0)\n\ts_barrier":::"memory")

__device__ __forceinline__ void qkt(f32x16&p0,f32x16&p1,const char*Kslot,const bf16x8*qr,int r32,int hi){
  const char*kb=Kslot+hi*1024+r32*16;
  #pragma unroll
  for(int d0=0;d0<4;++d0){
    const bf16x8 b0=*reinterpret_cast<const bf16x8*>(kb+d0*2048);
    const bf16x8 b1=*reinterpret_cast<const bf16x8*>(kb+d0*2048+512);
    if(d0==0){p0=__builtin_amdgcn_mfma_f32_32x32x16_bf16(b0,qr[0],f32x16{},0,0,0);p1=__builtin_amdgcn_mfma_f32_32x32x16_bf16(b1,qr[0],f32x16{},0,0,0);}
    else{p0=__builtin_amdgcn_mfma_f32_32x32x16_bf16(b0,qr[d0],p0,0,0,0);p1=__builtin_amdgcn_mfma_f32_32x32x16_bf16(b1,qr[d0],p1,0,0,0);}}
}
typedef __attribute__((address_space(3))) const char* lds_cptr;
typedef short v4i16_t __attribute__((ext_vector_type(4)));
__device__ __forceinline__ void kload8(bf16x8*kf,lds_cptr kp){
  kf[0]=*(const __attribute__((address_space(3))) bf16x8*)(kp);      kf[1]=*(const __attribute__((address_space(3))) bf16x8*)(kp+512);
  kf[2]=*(const __attribute__((address_space(3))) bf16x8*)(kp+2048); kf[3]=*(const __attribute__((address_space(3))) bf16x8*)(kp+2560);
  kf[4]=*(const __attribute__((address_space(3))) bf16x8*)(kp+4096); kf[5]=*(const __attribute__((address_space(3))) bf16x8*)(kp+4608);
  kf[6]=*(const __attribute__((address_space(3))) bf16x8*)(kp+6144); kf[7]=*(const __attribute__((address_space(3))) bf16x8*)(kp+6656);
}
__device__ __forceinline__ void kload2(bf16x8*kf,lds_cptr kp,int j){ kf[2*j]=*(const __attribute__((address_space(3))) bf16x8*)(kp+j*2048); kf[2*j+1]=*(const __attribute__((address_space(3))) bf16x8*)(kp+j*2048+512); }
__device__ __forceinline__ s16x4 vtr(lds_cptr p){ return __builtin_bit_cast(s16x4,__builtin_amdgcn_ds_read_tr16_b64_v4i16((__attribute__((address_space(3))) v4i16_t*)p)); }
__device__ __forceinline__ float rowmax(const f32x16&p0,const f32x16&p1){
  float a=max3f(p0[0],p0[1],p1[0]),b=max3f(p0[2],p0[3],p1[1]);a=max3f(a,p1[2],p1[3]);
  #pragma unroll
  for(int r=4;r<16;r+=4){a=max3f(a,p0[r],p0[r+1]);b=max3f(b,p0[r+2],p0[r+3]);a=max3f(a,p1[r],p1[r+1]);b=max3f(b,p1[r+2],p1[r+3]);}
  const float m=max2f(a,b);
  auto rr=__builtin_amdgcn_permlane32_swap(__float_as_uint(m),__float_as_uint(m),false,false);
  return max2f(__uint_as_float(rr[0]),__uint_as_float(rr[1]));
}
__device__ __forceinline__ void pv(f32x16*o,int vb,bf16x8 pa0,bf16x8 pa1,bf16x8 pa2,bf16x8 pa3){
  #pragma unroll
  for(int d0=0;d0<4;++d0){s16x4 lo[4],hi[4];
    #pragma unroll
    for(int ks=0;ks<4;++ks){
      asm volatile("ds_read_b64_tr_b16 %0,%1 offset:%c2":"=&v"(lo[ks]):"v"(vb),"i"(d0*4096+ks*1024):"memory");
      asm volatile("ds_read_b64_tr_b16 %0,%1 offset:%c2":"=&v"(hi[ks]):"v"(vb),"i"(d0*4096+ks*1024+512):"memory");}
    asm volatile("s_waitcnt lgkmcnt(0)":::"memory");SBAR();
    #define PK(k) (bf16x8){lo[k][0],lo[k][1],lo[k][2],lo[k][3],hi[k][0],hi[k][1],hi[k][2],hi[k][3]}
    o[d0]=__builtin_amdgcn_mfma_f32_32x32x16_bf16(pa0,PK(0),o[d0],0,0,0);
    o[d0]=__builtin_amdgcn_mfma_f32_32x32x16_bf16(pa1,PK(1),o[d0],0,0,0);
    o[d0]=__builtin_amdgcn_mfma_f32_32x32x16_bf16(pa2,PK(2),o[d0],0,0,0);
    o[d0]=__builtin_amdgcn_mfma_f32_32x32x16_bf16(pa3,PK(3),o[d0],0,0,0);
    #undef PK
  }
}

#undef ATTN_STORE16
#define ATTN_STORE16(p,v) __builtin_amdgcn_raw_buffer_store_b128((v), __builtin_amdgcn_make_buffer_rsrc((void*)O, 0, 32 << 20, 0x00020000), (unsigned)((const char*)(p) - (const char*)O), 0, 16)
template<int THRL> __device__ __forceinline__ void attn_unit(int b,int hm,int qb,const bf16*__restrict__ Zb,bf16*O,const float*__restrict__ btab,char*shm){
  int tid_=threadIdx.x; asm volatile("":"+v"(tid_)); const int tid=tid_,lane=tid&63,r32=lane&31,hi=lane>>5; const int wid=__builtin_amdgcn_readfirstlane(tid>>6);
  const long rowbase=(long)b*SEQ; const int q0=qb*QB;
  const float btv=(tid<384)?btab[hm*384+tid]:0.f;
  const bf16*Qw=Zb+(rowbase+q0+wid*QBLK)*DM+hm*D;
  const bf16*Kh=Zb+rowbase*DM+512+hm*D,*Vh=Zb+rowbase*DM+1024+(hm>>1)*128;
  const unsigned lds0=(unsigned)(uintptr_t)shm;
  float*wsf=(float*)(shm+LDS_WS)+wid*64;
  const bf16*ksrc=Kh+(long)lane*DM+wid*8;
  const bf16*vsrc=Vh+(long)(16*(wid&3)+(lane>>2))*DM+(wid>>2)*32+(lane&3)*8;
  const unsigned kdst=lds0+LDS_K+wid*1024, vdst=lds0+LDS_V+wid*1024;
  #define DMA_K(t,slot) glds16(ksrc+(long)(t)*KVBLK*DM,(unsigned)__builtin_amdgcn_readfirstlane(kdst+(slot)))
  #define DMA_V(t,slot) do{ glds16(vsrc+(long)(t)*KVBLK*DM,(unsigned)__builtin_amdgcn_readfirstlane(vdst+2*(slot))); glds16(vsrc+(long)(t)*KVBLK*DM+64,(unsigned)__builtin_amdgcn_readfirstlane(vdst+2*(slot)+8192)); }while(0)
  const int vb0=(int)(lds0+LDS_V)+((lane>>4)&1)*32+(lane&3)*8+(4*hi+((lane&15)>>2))*64;
  const char*Kbase=shm+LDS_K; bf16x8 kf[8];
  const lds_cptr shm3=(lds_cptr)shm; const lds_cptr kp0=shm3+LDS_K+hi*1024+r32*16; const lds_cptr vp0=shm3+LDS_V+((lane>>4)&1)*32+(lane&3)*8+(4*hi+((lane&15)>>2))*64;
  const int NT=(q0+QB)/KVBLK;
  DMA_K(0,0);DMA_V(0,0);DMA_K(1,SLOTB);
  bf16x8 qr[4];
  #pragma unroll
  for(int d0=0;d0<4;++d0)qr[d0]=*reinterpret_cast<const bf16x8*>(&Qw[(long)r32*DM+d0*16+hi*8]);
  const lds_cfptr btl=(lds_cfptr)((lds_cptr)shm+LDS_BT); if(tid<384)((__attribute__((address_space(3))) float*)((__attribute__((address_space(3))) char*)shm+LDS_BT))[tid]=btv;
  float mhat=0.f,l_reg=0.f;f32x16 o[4];o[0]=f32x16{};o[1]=f32x16{};o[2]=f32x16{};o[3]=f32x16{};
  const int qrel=wid*QBLK+r32;
  #define CMASK(P0,P1,t) do{int jb_=(t)-(NT-4); if(jb_>=-2)cmask(P0,P1,jb_,qrel,hi,btl);}while(0)
  bool resc=false;
  #define START(P0,P1) do{ const float rm=rowmax(P0,P1); resc=false; mhat=rm; \
    _Pragma("unroll") for(int r=0;r<16;++r)P0[r]=__builtin_amdgcn_exp2f(P0[r]-mhat); }while(0)
  #define RESC() do{ if(resc){ asm volatile("s_waitcnt lgkmcnt(0)":::"memory"); \
      _Pragma("unroll") for(int d_=0;d_<4;++d_) _Pragma("unroll") for(int r=0;r<16;++r)o[d_][r]*=wsf[crow(r,hi)]; } }while(0)
  f32x16 pA0,pA1,pB0,pB1;
  int sl_prev=0,sl_cur=0,sl_next=SLOTB;
  #define ROT() do{sl_prev=sl_cur;sl_cur=sl_next;sl_next=(sl_next==(NSLOT-1)*SLOTB)?0:sl_next+SLOTB;}while(0)
  DMA_K(2,2*SLOTB);
  WAIT_BAR(4);
  qkt(pA0,pA1,Kbase,qr,r32,hi);asm volatile("s_nop 15\n\ts_nop 7":"+v"(pA0),"+v"(pA1));CMASK(pA0,pA1,0);
  START(pA0,pA1);
  _Pragma("unroll") for(int r=0;r<16;++r)pA1[r]=__builtin_amdgcn_exp2f(pA1[r]-mhat);
  WAIT_BAR(0);
  DMA_K(3,0);DMA_V(1,SLOTB);
  ROT();
  kload8(kf,kp0+sl_cur);
  WAIT_BAR(3);
  s16x4 vlo[8],vhi[8]; u32x4 pw0,pw1,pw2,pw3;
  #define PKW(P,B) cvtpk_s(P[B],P[B+1])
  #define PAF(k) __builtin_bit_cast(bf16x8,pw##k)
  #define VFR(i) (bf16x8){vlo[i][0],vlo[i][1],vlo[i][2],vlo[i][3],vhi[i][0],vhi[i][1],vhi[i][2],vhi[i][3]}
  #define PIN(x) asm volatile("":"+v"(x))
  #define MX3(a,b,c) __builtin_fmaxf(__builtin_fmaxf((a),(b)),(c))
  #define GAPA(MF,A0,A1,A2,A3,W0,W1,PW) do{ MF; sacc+=A0; sacc+=A1; sacc+=A2; sacc+=A3; PIN(sacc); W0; W1; PIN(PW); SBAR(); }while(0)
  #define EX(v) __builtin_amdgcn_exp2f(v)
  #define GAPB(MF,X,B) do{ MF; X[B]=EX(X[B]-mhat); X[B+1]=EX(X[B+1]-mhat); X[B+2]=EX(X[B+2]-mhat); X[B+3]=EX(X[B+3]-mhat); PIN(X); SBAR(); }while(0)
  #define VRD2(i) do{ vlo[i]=vtr(vp_+(8192+((i)>>2)*4096+((i)&3)*1024)); vhi[i]=vtr(vp_+(8192+((i)>>2)*4096+((i)&3)*1024+512)); SBAR(); }while(0)
  #define GAPE(MF,X,B) do{ MF; X[B]=EX(X[B]-mhat); X[B+1]=EX(X[B+1]-mhat); PIN(X); SBAR(); }while(0)
  #define VRD(i) do{ vlo[i]=vtr(vp_+(((i)>>2)*4096+((i)&3)*1024)); vhi[i]=vtr(vp_+(((i)>>2)*4096+((i)&3)*1024+512)); }while(0)
  #define KRD(G,j) do{ if(G){ kload2(kf,kp0+sl_next,j); SBAR(); } }while(0)
  #define STEP(C0,C1,P0,P1,t,GK,GV,GL) do{ SBAR(); \
    const lds_cptr vp_=vp0+2*sl_prev; \
    VRD(0); SBAR(); float sacc=(P0[0]+P0[1]); \
    GAPA(C0=__builtin_amdgcn_mfma_f32_32x32x16_bf16(kf[0],qr[0],f32x16{},0,0,0), P0[2],P0[3],P0[4],P0[5],     pw0[0]=PKW(P0,0), pw0[1]=PKW(P0,2), pw0); \
    VRD(4); SBAR(); GAPA(C1=__builtin_amdgcn_mfma_f32_32x32x16_bf16(kf[1],qr[0],f32x16{},0,0,0), P0[6],P0[7],P0[8],P0[9],     pw0[2]=PKW(P0,4), pw0[3]=PKW(P0,6), pw0); \
    VRD(1); SBAR(); GAPA(C0=__builtin_amdgcn_mfma_f32_32x32x16_bf16(kf[2],qr[1],C0,0,0,0),   P0[10],P0[11],P0[12],P0[13], pw1[0]=PKW(P0,8), pw1[1]=PKW(P0,10), pw1); \
    VRD(5); SBAR(); GAPA(C1=__builtin_amdgcn_mfma_f32_32x32x16_bf16(kf[3],qr[1],C1,0,0,0),   P0[14],P0[15],P1[0],P1[1],   pw1[2]=PKW(P0,12),pw1[3]=PKW(P0,14), pw1); \
    VRD(2); SBAR(); GAPA(C0=__builtin_amdgcn_mfma_f32_32x32x16_bf16(kf[4],qr[2],C0,0,0,0),   P1[2],P1[3],P1[4],P1[5],     pw2[0]=PKW(P1,0), pw2[1]=PKW(P1,2), pw2); \
    VRD(6); SBAR(); GAPA(C1=__builtin_amdgcn_mfma_f32_32x32x16_bf16(kf[5],qr[2],C1,0,0,0),   P1[6],P1[7],P1[8],P1[9],     pw2[2]=PKW(P1,4), pw2[3]=PKW(P1,6), pw2); \
    VRD(3); SBAR(); GAPA(C0=__builtin_amdgcn_mfma_f32_32x32x16_bf16(kf[6],qr[3],C0,0,0,0),   P1[10],P1[11],P1[12],P1[13], pw3[0]=PKW(P1,8), pw3[1]=PKW(P1,10), pw3); \
    VRD(7); SBAR(); GAPA(C1=__builtin_amdgcn_mfma_f32_32x32x16_bf16(kf[7],qr[3],C1,0,0,0),   P1[14],P1[15],0.f,0.f,       pw3[2]=PKW(P1,12),pw3[3]=PKW(P1,14), pw3); \
    l_reg+=sacc; \
    if(GK){DMA_K((t)+3,sl_cur);} if(GV){DMA_V((t)+1,sl_next);} \
    CMASK(C0,C1,t); \
    { float a=MX3(C0[0],C0[1],C1[0]),b=MX3(C0[2],C0[3],C1[1]); a=MX3(a,C1[2],C1[3]); \
      _Pragma("unroll") for(int r=4;r<16;r+=4){a=MX3(a,C0[r],C0[r+1]);b=MX3(b,C0[r+2],C0[r+3]);a=MX3(a,C1[r],C1[r+1]);b=MX3(b,C1[r+2],C1[r+3]);} \
      float rm=__builtin_fmaxf(a,b); { auto rr=__builtin_amdgcn_permlane32_swap(__float_as_uint(rm),__float_as_uint(rm),false,false); rm=__builtin_fmaxf(__uint_as_float(rr[0]),__uint_as_float(rr[1])); } \
      resc=false; \
      rm-=mhat; \
      if(__builtin_expect(__any(rm>(float)THRL),0)){ const float dl=__builtin_fmaxf(rm,0.f); mhat+=dl; \
        const float f=__builtin_amdgcn_exp2f(-dl); l_reg*=f; if(hi==0)wsf[r32]=f; resc=true; } } \
    SBAR(); \
    GAPE(o[0]=__builtin_amdgcn_mfma_f32_32x32x16_bf16(PAF(0),VFR(0),o[0],0,0,0), C0,0); VRD2(0); \
    GAPE(o[1]=__builtin_amdgcn_mfma_f32_32x32x16_bf16(PAF(0),VFR(4),o[1],0,0,0), C0,2); VRD2(4); \
    GAPE(o[0]=__builtin_amdgcn_mfma_f32_32x32x16_bf16(PAF(1),VFR(1),o[0],0,0,0), C0,4); VRD2(1); \
    GAPE(o[1]=__builtin_amdgcn_mfma_f32_32x32x16_bf16(PAF(1),VFR(5),o[1],0,0,0), C0,6); VRD2(5); \
    GAPE(o[0]=__builtin_amdgcn_mfma_f32_32x32x16_bf16(PAF(2),VFR(2),o[0],0,0,0), C0,8); VRD2(2); \
    GAPE(o[1]=__builtin_amdgcn_mfma_f32_32x32x16_bf16(PAF(2),VFR(6),o[1],0,0,0), C0,10); VRD2(6); \
    GAPE(o[0]=__builtin_amdgcn_mfma_f32_32x32x16_bf16(PAF(3),VFR(3),o[0],0,0,0), C0,12); VRD2(3); \
    GAPE(o[1]=__builtin_amdgcn_mfma_f32_32x32x16_bf16(PAF(3),VFR(7),o[1],0,0,0), C0,14); VRD2(7); \
    KRD(GL,0); GAPE(o[2]=__builtin_amdgcn_mfma_f32_32x32x16_bf16(PAF(0),VFR(0),o[2],0,0,0), C1,0); \
    KRD(GL,1); GAPE(o[3]=__builtin_amdgcn_mfma_f32_32x32x16_bf16(PAF(0),VFR(4),o[3],0,0,0), C1,2); \
    KRD(GL,2); GAPE(o[2]=__builtin_amdgcn_mfma_f32_32x32x16_bf16(PAF(1),VFR(1),o[2],0,0,0), C1,4); \
    KRD(GL,3); GAPE(o[3]=__builtin_amdgcn_mfma_f32_32x32x16_bf16(PAF(1),VFR(5),o[3],0,0,0), C1,6); \
    GAPE(o[2]=__builtin_amdgcn_mfma_f32_32x32x16_bf16(PAF(2),VFR(2),o[2],0,0,0), C1,8); \
    GAPE(o[3]=__builtin_amdgcn_mfma_f32_32x32x16_bf16(PAF(2),VFR(6),o[3],0,0,0), C1,10); \
    GAPE(o[2]=__builtin_amdgcn_mfma_f32_32x32x16_bf16(PAF(3),VFR(3),o[2],0,0,0), C1,12); \
    GAPE(o[3]=__builtin_amdgcn_mfma_f32_32x32x16_bf16(PAF(3),VFR(7),o[3],0,0,0), C1,14); \
    }while(0)
  int t=1;
  #undef CMASK
  #define CMASK(P0,P1,t) do{int jb_=(t)-(NT-4); if(jb_>=-2)cmask(P0,P1,jb_,qrel,hi,btl);}while(0)
  for(;t+5<NT;t+=2){
    STEP(pB0,pB1,pA0,pA1,t,true,true,true);     WAIT_BAR(3); RESC(); ROT();
    STEP(pA0,pA1,pB0,pB1,t+1,true,true,true);   WAIT_BAR(3); RESC(); ROT();
  }
  #undef CMASK
  #define CMASK(P0,P1,t) do{int jb_=(t)-(NT-4); if(jb_>=-2)cmask(P0,P1,jb_,qrel,hi,btl);}while(0)
  #define ENDW(tt) do{ if((tt)+3<NT){WAIT_BAR(3);} else if((tt)+2<NT){WAIT_BAR(2);} else {WAIT_BAR(0);} }while(0)
  for(;t+1<NT;t+=2){
    STEP(pB0,pB1,pA0,pA1,t,(t+3<NT),(t+1<NT),(t+1<NT));       ENDW(t);   RESC(); ROT();
    STEP(pA0,pA1,pB0,pB1,t+1,(t+4<NT),(t+2<NT),(t+2<NT));     ENDW(t+1); RESC(); ROT();
  }
  STEP(pB0,pB1,pA0,pA1,NT-1,false,false,false); RESC();
  { float sacc=pB0[0]+pB0[1]; _Pragma("unroll") for(int r=2;r<16;++r)sacc+=pB0[r]; _Pragma("unroll") for(int r=0;r<16;++r)sacc+=pB1[r]; l_reg+=sacc;
    pw0=(u32x4){PKW(pB0,0),PKW(pB0,2),PKW(pB0,4),PKW(pB0,6)};pw1=(u32x4){PKW(pB0,8),PKW(pB0,10),PKW(pB0,12),PKW(pB0,14)};pw2=(u32x4){PKW(pB1,0),PKW(pB1,2),PKW(pB1,4),PKW(pB1,6)};pw3=(u32x4){PKW(pB1,8),PKW(pB1,10),PKW(pB1,12),PKW(pB1,14)};
    SBAR(); pv(o,vb0+2*sl_cur,PAF(0),PAF(1),PAF(2),PAF(3)); }
  #undef PKW
  #undef PAF
  #undef VFR
  #undef PIN
  #undef MX3
  #undef GAPA
  #undef GAPB
  #undef EX
  #undef VRD
  #undef VRD2
  #undef GAPE
  #undef KRD
  #undef STEP
  #undef ENDW
  {auto rr=__builtin_amdgcn_permlane32_swap(__float_as_uint(l_reg),__float_as_uint(l_reg),false,false);l_reg=__uint_as_float(rr[0])+__uint_as_float(rr[1]);}
  if(hi==0)wsf[32+r32]=l_reg;asm volatile("s_waitcnt lgkmcnt(0)":::"memory");
  float rli[16];
  #pragma unroll
  for(int r=0;r<16;++r)rli[r]=__builtin_amdgcn_rcpf(wsf[32+crow(r,hi)]);
  bf16*Ow=O+(rowbase+q0+wid*QBLK)*OP+hm*128;
  { bf16*stg=(bf16*)(shm+LDS_OST)+wid*2048;
    #pragma unroll
    for(int hf=0;hf<2;++hf){
      #pragma unroll
      for(int r=0;r<16;++r){const int orow=crow(r,hi);
        #pragma unroll
        for(int d0=0;d0<2;++d0)stg[orow*64+d0*32+r32]=__float2bfloat16(o[2*hf+d0][r]*rli[r]);}
      asm volatile("s_waitcnt lgkmcnt(0)":::"memory");
      #pragma unroll
      for(int i=0;i<4;++i){const int row=i*8+(lane>>3),ch=lane&7; const u32x4 v=*(const u32x4*)(stg+row*64+ch*8); ATTN_STORE16(Ow+(long)row*OP+hf*64+ch*8,v);}
      asm volatile("s_waitcnt lgkmcnt(0)":::"memory"); } }
  asm volatile("s_waitcnt lgkmcnt(0)\n\ts_barrier":::"memory");
  #undef DMA_K
  #undef DMA_V
  #undef CMASK
  #undef START
  #undef RESC
  #undef ROT
}
constexpr int ATTN_LDS_BYTES=LDS_BYTES;
struct AttnTensors { const bf16* Z; bf16* O; const float* btab; };
struct AttnUnit { int bh; int qb; };
struct StaticOrder {
  int vcu;
  __device__ __forceinline__ explicit StaticOrder(int grid,int block):vcu((block%8)*(grid/8)+block/8){}
  __device__ __forceinline__ bool next(int i,AttnUnit&u)const{ if(i>=2)return false; const int s=vcu&7; u.bh=vcu>>3; u.qb=(i==0)?15-s:s; return true; }
  __device__ __forceinline__ void a_ready(const AttnUnit&)const{}
  __device__ __forceinline__ void done(const AttnUnit&)const{}
};
template<class Sched,int THRL=8> __device__ __forceinline__ void attn_phase(char*lds,const AttnTensors&T,const Sched&S){
  AttnUnit u;
  for(int i=0;S.next(i,u);++i){ S.a_ready(u); attn_unit<THRL>(u.bh>>3,u.bh&7,u.qb,T.Z,T.O,T.btab,lds); S.done(u); }
}
#undef SBAR
#undef WAIT_BAR
}
namespace swa {
constexpr float THR = 8.f; constexpr bool WSKIP = false;
constexpr float SCALE = 0.6931471805599453f;
constexpr int D = 128, DK = 64, ZPITCH = 2816, OPITCH = 1024;
constexpr int NW = 8, QBLK = 32, KVBLK = 64, QB = NW * QBLK;
constexpr int SHM_V = KVBLK * D * 2, SHM_K = KVBLK * DK * 2;
constexpr int LDS_BT = 2 * SHM_V + 2 * SHM_K + NW * 64 * 4, LDS_BYTES = LDS_BT + 1536;

using bf16 = __hip_bfloat16;
typedef __attribute__((address_space(3))) const float* lds_cfptr;
typedef short bf16x8 __attribute__((ext_vector_type(8)));
typedef short s16x4 __attribute__((ext_vector_type(4)));
typedef float f32x16 __attribute__((ext_vector_type(16)));
typedef float f32x4 __attribute__((ext_vector_type(4)));
typedef unsigned u32x4 __attribute__((ext_vector_type(4)));
template <class A, class Bt> struct same_t { static constexpr bool v = false; };
template <class A> struct same_t<A, A> { static constexpr bool v = true; };

#define KSWZ(row, colB) ((row) * 128 + ((colB) ^ ((((row) >> 1) & 7) << 4)))
#define SBAR() __builtin_amdgcn_sched_barrier(0)
__device__ __forceinline__ int v_st(int k, int c) { const int kk = (k & ~0xC) | ((k & 4) << 1) | ((k & 8) >> 1); return ((kk >> 3) * 4 + (c >> 5)) * 512 + ((kk & 7) * 32 + (c & 31)) * 2; }
__device__ __forceinline__ int v_rd_base(int lane) { return ((lane & 3) << 3) | (((lane >> 2) & 3) << 6) | (((lane >> 4) & 1) << 5) | (((lane >> 5) & 1) << 8); }
constexpr int v_rd_off(int d0, int ks, int half) { return d0 * 512 + ks * 4096 + half * 2048; }
__device__ __forceinline__ int crow(int r, int hi) { return (r & 3) + 8 * (r >> 2) + 4 * hi; }
__device__ __forceinline__ unsigned cvtpk(float lo, float hi) {
    unsigned r; asm volatile("v_cvt_pk_bf16_f32 %0, %1, %2" : "=v"(r) : "v"(lo), "v"(hi)); return r;
}
__device__ __forceinline__ bf16x8 pack8(f32x4 a, f32x4 b) {
    u32x4 w = {cvtpk(a[0], a[1]), cvtpk(a[2], a[3]), cvtpk(b[0], b[1]), cvtpk(b[2], b[3])};
    return *reinterpret_cast<bf16x8*>(&w);
}
template <class T> __device__ __forceinline__ bf16x8 load8(const T* p) {
    if constexpr (same_t<T, float>::v) { return pack8(*(const f32x4*)p, *(const f32x4*)(p + 4)); }
    else { return *reinterpret_cast<const bf16x8*>(p); }
}
__device__ __forceinline__ void mask_tile(f32x16& p0, f32x16& p1, int dq, lds_cfptr bt) {
    const float NEG = -__builtin_inff();
#pragma unroll
    for (int r = 0; r < 16; ++r) {
        const int c = (r & 3) + 8 * (r >> 2); const int d0 = dq - c, d1 = d0 - 32;
        p0[r] += bt[d0 < 0 ? 0 : d0]; p1[r] += bt[d1 < 0 ? 0 : d1];
        if (d0 < 0) p0[r] = NEG; if (d1 < 0) p1[r] = NEG;
        if ((r & 3) == 3) __builtin_amdgcn_sched_barrier(0);
    }
}
__device__ __forceinline__ void partialSM(f32x16& p0, f32x16& p1, float& m_reg, float& mn, float& alpha) {
    float pmax = p0[0]; for (int r = 1; r < 16; ++r) pmax = fmaxf(pmax, p0[r]); for (int r = 0; r < 16; ++r) pmax = fmaxf(pmax, p1[r]);
    { auto rr = __builtin_amdgcn_permlane32_swap(__float_as_uint(pmax), __float_as_uint(pmax), false, false);
      pmax = fmaxf(__uint_as_float(rr[0]), __uint_as_float(rr[1])); }
    constexpr float C2 = 1.4426950408889634f * SCALE;
    if (__builtin_expect(__all((pmax - m_reg) * SCALE <= THR), 1)) { mn = m_reg; alpha = 1.f; }
    else { mn = fmaxf(m_reg, pmax); alpha = __builtin_amdgcn_exp2f((m_reg - mn) * C2); m_reg = mn; }
    const float mnL = -mn * C2;
    for (int r = 0; r < 16; ++r) p0[r] = fmaf(p0[r], C2, mnL); for (int r = 0; r < 16; ++r) p1[r] = fmaf(p1[r], C2, mnL);
    for (int r = 0; r < 16; ++r) p0[r] = __builtin_amdgcn_exp2f(p0[r]);
}
__device__ __forceinline__ void finishSM(f32x16& p0, f32x16& p1, float alpha, float& l_reg, bf16x8& pa0, bf16x8& pa1, bf16x8& pa2, bf16x8& pa3) {
    for (int r = 0; r < 16; ++r) p1[r] = __builtin_amdgcn_exp2f(p1[r]);
    float ps = 0; for (int r = 0; r < 16; ++r) ps += p0[r]; for (int r = 0; r < 16; ++r) ps += p1[r];
    { auto rr = __builtin_amdgcn_permlane32_swap(__float_as_uint(ps), __float_as_uint(ps), false, false);
      ps = __uint_as_float(rr[0]) + __uint_as_float(rr[1]); }
    l_reg = l_reg * alpha + ps;
#define PK4(P, B_, OUT) do { unsigned a0 = cvtpk(P[B_+0], P[B_+1]), a1 = cvtpk(P[B_+2], P[B_+3]);                          \
        unsigned b0 = cvtpk(P[B_+4], P[B_+5]), b1 = cvtpk(P[B_+6], P[B_+7]);                                             \
        auto r0 = __builtin_amdgcn_permlane32_swap(a0, b0, false, false); auto r1 = __builtin_amdgcn_permlane32_swap(a1, b1, false, false); \
        u32x4 w = {r0[0], r1[0], r0[1], r1[1]}; OUT = *reinterpret_cast<bf16x8*>(&w); } while (0)
    PK4(p0, 0, pa0); PK4(p0, 8, pa1); PK4(p1, 0, pa2); PK4(p1, 8, pa3);
#undef PK4
}
template <int KB, bool SK>
__device__ __forceinline__ void qkt(f32x16& p0, f32x16& p1, const char* K_lds, int r32, int hi, const bf16x8* qr, bool act) {
    if (SK && !act) { const float NEG = -__builtin_inff();
#pragma unroll
        for (int r = 0; r < 16; ++r) { p0[r] = NEG; p1[r] = NEG; } return; }
    p0 = f32x16{}; p1 = f32x16{};
    const char* kb[4];
#pragma unroll
    for (int dd = 0; dd < 4; ++dd) kb[dd] = K_lds + KB * SHM_K + KSWZ(r32, (dd * 16 + hi * 8) * 2);
#pragma unroll
    for (int d0 = 0; d0 < 4; ++d0) { const char* a = kb[d0];
        bf16x8 b0 = *reinterpret_cast<const bf16x8*>(a);
        bf16x8 b1 = *reinterpret_cast<const bf16x8*>(a + 32 * 128);
        p0 = __builtin_amdgcn_mfma_f32_32x32x16_bf16(b0, qr[d0], p0, 0, 0, 0);
        p1 = __builtin_amdgcn_mfma_f32_32x32x16_bf16(b1, qr[d0], p1, 0, 0, 0); }
}
typedef __attribute__((address_space(3))) const char* lds_cptr;
typedef short v4i16_t __attribute__((ext_vector_type(4)));
__device__ __forceinline__ s16x4 vtr(lds_cptr p) { return __builtin_bit_cast(s16x4, __builtin_amdgcn_ds_read_tr16_b64_v4i16((__attribute__((address_space(3))) v4i16_t*)p)); }
template <int VB, bool SK>
__device__ __forceinline__ void pv_tile(f32x16* o, lds_cptr vp, bf16x8 pa0, bf16x8 pa1, bf16x8 pa2, bf16x8 pa3, bool act) {
    if (SK && !act) return;
    s16x4 fa[8], fb[8];
#define PV_RD(F, d0) do { _Pragma("unroll") for (int ks = 0; ks < 4; ++ks) { F[2 * ks] = vtr(vp + (VB * SHM_V + (d0) * 512 + ks * 4096)); F[2 * ks + 1] = vtr(vp + (VB * SHM_V + (d0) * 512 + ks * 4096 + 2048)); } } while (0)
#define PV_FR(F, k) (bf16x8){F[2 * (k)][0], F[2 * (k)][1], F[2 * (k)][2], F[2 * (k)][3], F[2 * (k) + 1][0], F[2 * (k) + 1][1], F[2 * (k) + 1][2], F[2 * (k) + 1][3]}
#define PV_MF(O, F) do { O = __builtin_amdgcn_mfma_f32_32x32x16_bf16(pa0, PV_FR(F, 0), O, 0, 0, 0); O = __builtin_amdgcn_mfma_f32_32x32x16_bf16(pa1, PV_FR(F, 1), O, 0, 0, 0); \
                         O = __builtin_amdgcn_mfma_f32_32x32x16_bf16(pa2, PV_FR(F, 2), O, 0, 0, 0); O = __builtin_amdgcn_mfma_f32_32x32x16_bf16(pa3, PV_FR(F, 3), O, 0, 0, 0); } while (0)
    PV_RD(fa, 0); SBAR(); PV_RD(fb, 1); SBAR();
    PV_MF(o[0], fa); SBAR(); PV_RD(fa, 2); SBAR();
    PV_MF(o[1], fb); SBAR(); PV_RD(fb, 3); SBAR();
    PV_MF(o[2], fa); SBAR();
    PV_MF(o[3], fb);
#undef PV_RD
#undef PV_FR
#undef PV_MF
}

template <class TIn, class TOut> struct BlockRef { const TIn* Q; const TIn* K; const TIn* V; TOut* O; int P0; };
template <class TIn> struct Seam {
    bf16x8 qr[4];
    bf16x8 st_v0, st_v1, st_k0;
    bf16x8 sb_v0, sb_v1, sb_k0;
};
__device__ __forceinline__ int swa_jlo(int P0, int W) { const int lowk = P0 - W + 1; return lowk > 0 ? lowk / KVBLK : 0; }
#define ROW(p, k0, rr) ((p) + (size_t)((k0) + (rr)) * ZPITCH + sc)
#define ROWK(p, k0) ((p) + (size_t)((k0) + ksr) * ZPITCH + ksc)
#define VMW() asm volatile("s_waitcnt vmcnt(0)" ::: "memory")
#define VMWN(n) asm volatile("s_waitcnt vmcnt(%0)" :: "i"(n) : "memory")
#define SLOAD_H(Kp, Vp, k0) do { S.st_v0 = load8<TIn>(ROW(Vp, k0, sr)); S.st_v1 = load8<TIn>(ROW(Vp, k0, 32 + sr));              \
                         S.st_k0 = load8<TIn>(ROWK(Kp, k0)); } while (0)
#define SWRITE_HK(bf) do { *(bf16x8*)(K_lds + (bf) * SHM_K + kws) = S.st_k0; } while (0)
#define SWRITE_HV(bf) do { *(bf16x8*)(V_lds + (bf) * SHM_V + vst0) = S.st_v0; *(bf16x8*)(V_lds + (bf) * SHM_V + vst1) = S.st_v1; } while (0)
#define SWRITE_H(bf) do { SWRITE_HV(bf); SWRITE_HK(bf); } while (0)
#define SLOAD_HB(Kp, Vp, k0) do { S.sb_v0 = load8<TIn>(ROW(Vp, k0, sr)); S.sb_v1 = load8<TIn>(ROW(Vp, k0, 32 + sr)); S.sb_k0 = load8<TIn>(ROWK(Kp, k0)); } while (0)
#define SWRITE_HB(bf) do { *(bf16x8*)(V_lds + (bf) * SHM_V + vst0) = S.sb_v0; *(bf16x8*)(V_lds + (bf) * SHM_V + vst1) = S.sb_v1; *(bf16x8*)(K_lds + (bf) * SHM_K + kws) = S.sb_k0; } while (0)
template <class TIn, class TOut>
__device__ __forceinline__ void causal_swa_prime(const BlockRef<TIn, TOut>& cur, const float* btab_hm, char* lds, Seam<TIn>& S) {
    int tid_ = threadIdx.x; asm volatile("" : "+v"(tid_)); const int tid = tid_, wid = __builtin_amdgcn_readfirstlane(tid >> 6), lane = tid & 63, r32 = lane & 31, hi = lane >> 5;
    const int sr = tid >> 4, sc = (tid & 15) * 8, ksr = tid >> 3, ksc = (tid & 7) * 8, kws = KSWZ(ksr, ksc * 2); char* K_lds = lds + 2 * SHM_V;
    const int kb0 = 0;
    if (tid < 384) ((__attribute__((address_space(3))) float*)((__attribute__((address_space(3))) char*)lds + LDS_BT))[tid] = btab_hm[tid];
    for (int d0 = 0; d0 < 4; ++d0) S.qr[d0] = load8<TIn>(cur.Q + (size_t)(wid * QBLK + r32) * ZPITCH + d0 * 16 + hi * 8);
    SLOAD_H(cur.K, cur.V, kb0); VMW(); SWRITE_HK(0);
    __syncthreads();
}
template <class TIn, class TOut>
__device__ __forceinline__ void causal_swa_block(const BlockRef<TIn, TOut>& cur, const BlockRef<TIn, TOut>& nxt, int skv, char* lds, Seam<TIn>& S) {
    int tid_ = threadIdx.x; asm volatile("" : "+v"(tid_)); const int tid = tid_, wid = __builtin_amdgcn_readfirstlane(tid >> 6), lane = tid & 63, r32 = lane & 31, hi = lane >> 5;
    const int j_lo = 0;
    int j_hi = (cur.P0 + QB - 1) / KVBLK + 1; if (j_hi > skv / KVBLK) j_hi = skv / KVBLK;
    const int NT = j_hi - j_lo;
    const int kbn = 0;
    const int qlo = cur.P0 + wid * QBLK, qm = qlo + r32 - 4 * hi;
    char* V_lds = lds; char* K_lds = lds + 2 * SHM_V;
    float* ws = (float*)(lds + 2 * SHM_V + 2 * SHM_K) + wid * 64; float* li_l = ws, * al_l = ws + 32;
    const lds_cfptr btl = (lds_cfptr)((__attribute__((address_space(3))) const char*)lds + LDS_BT);
    float m_reg = -1e30f, l_reg = 0; f32x16 o[4] = {};
    const int sr = tid >> 4, sc = (tid & 15) * 8, vst0 = v_st(sr, sc), vst1 = v_st(32 + sr, sc);
    const int ksr = tid >> 3, ksc = (tid & 7) * 8, kws = KSWZ(ksr, ksc * 2);
    const lds_cptr vb0 = (lds_cptr)V_lds + v_rd_base(lane);
    const TIn* Kh = cur.K; const TIn* Vh = cur.V;
#define RESC(a) do { if (__any((a) < 1.f)) { if (hi == 0) al_l[r32] = (a); asm volatile("s_waitcnt lgkmcnt(0)" ::: "memory");              \
                     for (int d_ = 0; d_ < 4; ++d_) for (int r = 0; r < 16; ++r) o[d_][r] *= al_l[crow(r, hi)]; } } while (0)
#define KBASE(t) ((j_lo + (t)) * KVBLK)
#define ACT(t) true
#define MASKT(P0_, P1_, t) do { const int kb_ = KBASE(t); if (kb_ + KVBLK - 1 > qlo - 113) mask_tile(P0_, P1_, qm - kb_, btl); } while (0)
    constexpr int NQL = 4;
    constexpr bool SK = false;
#define SEAM_K0() do { VMWN(NQL); SWRITE_HK(0); SBAR(); } while (0)
    f32x16 pA0, pA1, pB0, pB1; float mnA, mnB, alA, alB; bf16x8 pa0, pa1, pa2, pa3;
    SWRITE_HV(0); SBAR();
    if (NT > 1) { SLOAD_H(Kh, Vh, KBASE(1)); SBAR(); if (NT > 2) { SLOAD_HB(Kh, Vh, KBASE(2)); } }
    SBAR(); qkt<0, SK>(pA0, pA1, K_lds, r32, hi, S.qr, ACT(0));
    MASKT(pA0, pA1, 0); partialSM(pA0, pA1, m_reg, mnA, alA);
    if (NT > 1) { if (NT > 2) { VMWN(3); } else { VMW(); } SWRITE_H(1); }
    __syncthreads();
#define HALF_STEP(PX0, PX1, mnX, alX, PY0, PY1, alY, t, KB, VB, SB, LD2, WR1) do {                                            \
        SBAR(); qkt<KB, SK>(PX0, PX1, K_lds, r32, hi, S.qr, ACT(t));                                             \
        finishSM(PY0, PY1, alY, l_reg, pa0, pa1, pa2, pa3); SBAR();                                                           \
        if ((t) + 2 < NT) { LD2(Kh, Vh, KBASE((t) + 2)); SBAR(); }                                                            \
        pv_tile<VB, SK>(o, vb0, pa0, pa1, pa2, pa3, ACT((t) - 1)); MASKT(PX0, PX1, (t)); partialSM(PX0, PX1, m_reg, mnX, alX);                                        \
        __syncthreads();                                                                                                      \
        if ((t) + 1 < NT) { if ((t) + 2 < NT) { VMWN(3); } else { VMW(); } WR1(SB); }                                          \
        RESC(alX); __syncthreads(); } while (0)
    for (int t = 1; t + 1 < NT; t += 2) {
        HALF_STEP(pB0, pB1, mnB, alB, pA0, pA1, alA, t, 1, 0, 0, SLOAD_H, SWRITE_HB);
        HALF_STEP(pA0, pA1, mnA, alA, pB0, pB1, alB, t + 1, 0, 1, 1, SLOAD_HB, SWRITE_H);
    }
    const bool even = (NT & 1) == 0;
    if (even) { SBAR(); qkt<1, SK>(pB0, pB1, K_lds, r32, hi, S.qr, ACT(NT - 1)); SBAR(); }
    { SLOAD_H(nxt.K, nxt.V, kbn); SBAR();
#pragma unroll
        for (int d0 = 0; d0 < 4; ++d0) S.qr[d0] = load8<TIn>(nxt.Q + (size_t)(wid * QBLK + r32) * ZPITCH + d0 * 16 + hi * 8); }
    SBAR();
    finishSM(pA0, pA1, alA, l_reg, pa0, pa1, pa2, pa3); SBAR();
    pv_tile<0, SK>(o, vb0, pa0, pa1, pa2, pa3, ACT(even ? NT - 2 : NT - 1));
    if (even) { MASKT(pB0, pB1, NT - 1); partialSM(pB0, pB1, m_reg, mnB, alB); __syncthreads(); RESC(alB);
        finishSM(pB0, pB1, alB, l_reg, pa0, pa1, pa2, pa3); SBAR(); pv_tile<1, SK>(o, vb0, pa0, pa1, pa2, pa3, ACT(NT - 1)); }
    SBAR(); SEAM_K0();
    if (hi == 0) li_l[r32] = l_reg; asm volatile("s_waitcnt lgkmcnt(0)" ::: "memory");
    float rli[16];
#pragma unroll
    for (int r = 0; r < 16; ++r) rli[r] = __builtin_amdgcn_rcpf(li_l[crow(r, hi)]);
    TOut* Ow = cur.O + (size_t)(wid * QBLK) * OPITCH;
#pragma unroll
    for (int r = 0; r < 16; ++r) { const int orow = crow(r, hi);
#pragma unroll
        for (int d0 = 0; d0 < 4; ++d0) { const float v = o[d0][r] * rli[r];
            const float vn = __shfl_xor(v, 1);
            if ((r32 & 1) == 0) *(unsigned*)(Ow + (size_t)orow * OPITCH + d0 * 32 + r32) = cvtpk(v, vn); } }
    __syncthreads();
#undef RESC
#undef KBASE
#undef ACT
#undef MASKT
#undef SEAM_K0
#undef HALF_STEP
}
#undef ROW
#undef ROWK
#undef VMW
#undef VMWN
#undef SLOAD_H
#undef SWRITE_HK
#undef SWRITE_HV
#undef SWRITE_H
#undef SLOAD_HB
#undef SWRITE_HB


__device__ __forceinline__ BlockRef<bf16, bf16> unit_ref(const bf16* Z, bf16* OB, int b, int hm, int qb) {
    BlockRef<bf16, bf16> r; const size_t row0 = (size_t)b * 4096;
    r.Q = Z + (row0 + (size_t)qb * QB) * ZPITCH + hm * DK; r.K = Z + row0 * ZPITCH + 512 + hm * DK; r.V = Z + row0 * ZPITCH + 1024 + (hm >> 1) * D;
    r.O = OB + (row0 + (size_t)qb * QB) * OPITCH + hm * D; r.P0 = qb * QB; return r;
}
__device__ __forceinline__ void attn_swa_phase(const bf16* Z, bf16* OB, const float* btab, char* lds, int G) {
    const int bx = blockIdx.x; const int vcu = (G % 8 == 0) ? (bx % 8) * (G / 8) + bx / 8 : bx;
    for (int L = vcu; L < 256; L += G) {
        const int bh = L >> 3, x = L & 7, b = bh >> 3, hm = bh & 7;
        const BlockRef<bf16, bf16> first = unit_ref(Z, OB, b, hm, 15 - x), second = unit_ref(Z, OB, b, hm, x);
        Seam<bf16> S;
        causal_swa_prime<bf16, bf16>(first, btab + hm * 384, lds, S);
        causal_swa_block<bf16, bf16>(first, second, 4096, lds, S);
        causal_swa_block<bf16, bf16>(second, second, 4096, lds, S);
    }
}

}
#ifndef PROBE_REP_MASK
#define PROBE_REP_MASK 0
#endif
#ifndef PROBE_EXTRA_SYNC
#define PROBE_EXTRA_SYNC 0
#endif
#ifndef PG8_ALIGN_MULTI
#define PG8_ALIGN_MULTI true
#endif
#ifndef HIDE_CONV
#define HIDE_CONV 1
#endif
#ifndef RES_BF16
#define RES_BF16 1
#endif
#ifndef USE_CG_SYNC
#define USE_CG_SYNC 0
#endif
#ifndef USE_ATTN128
#define USE_ATTN128 1
#endif
#ifndef USE_SWA_ATTN
#define USE_SWA_ATTN 1
#endif
#ifndef USE_NAIVE_ATTN
#define USE_NAIVE_ATTN 0
#endif
constexpr int NWAVES = 8, NTHR = 512;
constexpr int BATCH = 4, SEQ = 4096, DM = 1024, DEPTH = 4, DFF = 2816, INW = 2816, MTOK = BATCH * SEQ;
constexpr int ZP = 2816;
constexpr int ZQ = 0, ZK = 512, ZV = 1024, ZSB = 1536, ZSC = 1792, ZSX = 2048, ZLX = 2304, ZLG = 2560;
constexpr float LOG2E = 1.4426950408889634f;
constexpr float QSCALE = 0.125f * LOG2E;
constexpr int NCH = 64;

constexpr size_t MiB = 1u << 20;
constexpr size_t WS_LAM = 0;
constexpr size_t WS_BTAB = 4096;
constexpr size_t WS_PTOT = 64 * 1024;
constexpr size_t WS_HTOT = 320 * 1024;
constexpr size_t WS_SS = 640 * 1024;
constexpr size_t WS_BAR = 1 * MiB, BAR_BYTES = 16384;
constexpr size_t WS_W = 2 * MiB;
constexpr size_t WL_1C = 0, WL_1D = 11 * MiB, WL_IN = WL_1D + 11 * MiB / 2, WL_2C = WL_IN + 11 * MiB / 2, WL_2D = WL_2C + 11 * MiB, WL_OUT = WL_2D + 11 * MiB / 2, WL_STRIDE = WL_OUT + 2 * MiB;
static_assert(WL_STRIDE == 40 * MiB + MiB / 2, "layer weight stride");
constexpr size_t WS_XB = 164 * MiB, WS_ACT = 196 * MiB, WS_OB = 284 * MiB, WS_Y = 316 * MiB, WS_HL = 348 * MiB, WS_PL = 364 * MiB, WS_END = 380 * MiB;
static_assert(WS_W + 4 * WL_STRIDE <= WS_XB, "weights fit");

constexpr int RING_BYTES = 131072, LDS_BYTES = 147456, LDSCTL_OFF = LDS_BYTES - 256, MISC_OFF = LDSCTL_OFF + 64;

#define LAS __attribute__((address_space(3)))
typedef unsigned short bf16;
typedef unsigned v4u __attribute__((ext_vector_type(4)));
typedef unsigned v2u __attribute__((ext_vector_type(2)));
typedef float f32x4 __attribute__((ext_vector_type(4)));

__device__ __forceinline__ unsigned f2bf(float f) { unsigned u = __builtin_bit_cast(unsigned, f); return (u + 0x7fffu + ((u >> 16) & 1u)) >> 16; }
__device__ __forceinline__ unsigned pk2(float lo, float hi) { return f2bf(lo) | (f2bf(hi) << 16); }
__device__ __forceinline__ float bf2f(unsigned short b) { return __builtin_bit_cast(float, (unsigned)b << 16); }
__device__ __forceinline__ float bflo(unsigned w) { return __builtin_bit_cast(float, w << 16); }
__device__ __forceinline__ float bfhi(unsigned w) { return __builtin_bit_cast(float, w & 0xffff0000u); }
__device__ __forceinline__ float wave_sum(float v) {
#pragma unroll
    for (int o = 1; o < 64; o <<= 1) v += shx(v, o);
    return v;
}

#define XB_TMO      128
#define XB_XCNT(j)  (256  + 64 * (j))
#define XB_XSUB(j)  (1280 + 64 * (j))
#define XB_XGEN(j)  (2304 + 64 * (j))
#define XB_TOP      3328
#define XB_TOPGEN   3392
#define XCD_BAR_WORDS 3456
#define XB_SPIN_CAP (1u << 18)

__device__ __forceinline__ unsigned xb_ld(unsigned* p)              { return __hip_atomic_load(p, __ATOMIC_RELAXED, __HIP_MEMORY_SCOPE_AGENT); }
__device__ __forceinline__ unsigned xb_add(unsigned* p, unsigned v) { return __hip_atomic_fetch_add(p, v, __ATOMIC_RELAXED, __HIP_MEMORY_SCOPE_AGENT); }
__device__ __forceinline__ unsigned xb_xcc_id() { return (unsigned)__builtin_amdgcn_s_getreg((3 << 11) | 20) & 0xFu; }
#define XB_SPIN(cond, bar) do { unsigned _sp = 0; while (cond) { __builtin_amdgcn_s_sleep(1); \
    if ((++_sp & 255u) == 0u) { if (xb_ld(&(bar)[XB_TMO])) break; if (_sp > XB_SPIN_CAP) { atomicAdd(&(bar)[XB_TMO], 1u); break; } } } } while (0)

struct XcdBarrier {
    unsigned* bar; unsigned x;
    volatile LAS unsigned* st;
};

__device__ __forceinline__ XcdBarrier xcd_barrier_post(unsigned* bar, volatile LAS unsigned* st) {
    XcdBarrier b; b.bar = bar; b.x = xb_xcc_id(); b.st = st;
    if (threadIdx.x == 0) (void)xb_add(&bar[XB_XCNT(b.x)], 1u);
    return b;
}
__device__ __forceinline__ void xcd_barrier_complete(unsigned* bar, unsigned x, unsigned& nloc, unsigned& nx) {
    const unsigned G = gridDim.x * gridDim.y * gridDim.z;
    unsigned sum, cnt, mine, sp = 0u;
    for (;;) {
        sum = 0u; cnt = 0u; mine = 0u;
#pragma unroll
        for (unsigned j = 0; j < 16; ++j) { const unsigned c = xb_ld(&bar[XB_XCNT(j)]); sum += c; cnt += (c > 0u) ? 1u : 0u; mine = (j == x) ? c : mine; }
        if (sum == G) break;
        __builtin_amdgcn_s_sleep(1);
        if ((++sp & 255u) == 0u) { if (xb_ld(&bar[XB_TMO])) break; if (sp > XB_SPIN_CAP) { atomicAdd(&bar[XB_TMO], 1u); break; } }
    }
    nloc = mine > 0u ? mine : 1u; nx = cnt > 0u ? cnt : 1u;
}

__device__ __forceinline__ void xcd_barrier(const XcdBarrier& b) {
    asm volatile("s_waitcnt vmcnt(0)" ::: "memory");
    __syncthreads();
    if (threadIdx.x == 0) {
        unsigned* bar = b.bar;
        __builtin_amdgcn_s_waitcnt(0);
        unsigned nloc = b.st[0], nx = b.st[1];
        if (nloc == 0u) { xcd_barrier_complete(bar, b.x, nloc, nx); b.st[0] = nloc; b.st[1] = nx; }
        const unsigned old = xb_add(&bar[XB_XSUB(b.x)], 1u);
        const unsigned gen = old / nloc;
        if (old + 1u == (gen + 1u) * nloc) {
            __builtin_amdgcn_fence(__ATOMIC_RELEASE, "agent");
            asm volatile("s_waitcnt vmcnt(0)" ::: "memory");
            const unsigned og = xb_add(&bar[XB_TOP], 1u);
            const unsigned tg = og / nx;
            if (og + 1u == (tg + 1u) * nx) xb_add(&bar[XB_TOPGEN], 1u);
            else XB_SPIN(xb_ld(&bar[XB_TOPGEN]) == tg, bar);
            __builtin_amdgcn_fence(__ATOMIC_ACQUIRE, "agent");
            xb_add(&bar[XB_XGEN(b.x)], 1u);
            asm volatile("s_waitcnt vmcnt(0)" ::: "memory");
        } else {
            XB_SPIN(xb_ld(&bar[XB_XGEN(b.x)]) == gen, bar);
            __builtin_amdgcn_fence(__ATOMIC_ACQUIRE, "agent");
            asm volatile("s_waitcnt vmcnt(0)" ::: "memory");
        }
    }
    __syncthreads();
}

struct Args { const float* in[27]; float* out; unsigned char* ws; int ph_lo, ph_hi; };
typedef const __attribute__((address_space(4))) Args* ArgsP;
enum { I_X = 0, I_RELB, I_F1N, I_F1G, I_F1U, I_F1D, I_MIXN, I_WIN, I_WOUT, I_LQ1, I_LK1, I_LQ2, I_LK2, I_SUBG, I_SCW, I_LCW, I_LCB, I_WA, I_BA, I_WX, I_BX, I_LLAM, I_F2N, I_F2G, I_F2U, I_F2D, I_FIN };

struct TrItem { const float* W; const float* gain; bf16* WT; int K, N, k0, n0, drow0; };
__device__ __forceinline__ bool tr_item(ArgsP a, int it, TrItem& t) {
    constexpr int IT_BIG = 704, IT_OUT = 256, IT_LAYER = 7 * IT_BIG + IT_OUT;
    if (it >= DEPTH * IT_LAYER) return false;
    const int l = it / IT_LAYER, r = it % IT_LAYER;
    unsigned char* wl = a->ws + WS_W + (size_t)l * WL_STRIDE;
    const size_t wofs = (size_t)l * DM * DFF;
    int mode = 0, ii; t.gain = nullptr; t.K = DM; t.N = DFF;
    if (r >= 7 * IT_BIG) { t.W = a->in[I_WOUT] + (size_t)l * DM * DM; t.N = DM; t.WT = (bf16*)(wl + WL_OUT); ii = r - 7 * IT_BIG; }
    else {
        const int mat = r / IT_BIG; ii = r % IT_BIG;
        if (mat == 0)      { t.W = a->in[I_F1G] + wofs; t.gain = a->in[I_F1N] + l * DM; t.WT = (bf16*)(wl + WL_1C); mode = 1; }
        else if (mat == 1) { t.W = a->in[I_F1U] + wofs; t.gain = a->in[I_F1N] + l * DM; t.WT = (bf16*)(wl + WL_1C); mode = 2; }
        else if (mat == 2) { t.W = a->in[I_F1D] + wofs; t.K = DFF; t.N = DM; t.WT = (bf16*)(wl + WL_1D); }
        else if (mat == 3) { t.W = a->in[I_WIN] + wofs; t.gain = a->in[I_MIXN] + l * DM; t.WT = (bf16*)(wl + WL_IN); }
        else if (mat == 4) { t.W = a->in[I_F2G] + wofs; t.gain = a->in[I_F2N] + l * DM; t.WT = (bf16*)(wl + WL_2C); mode = 1; }
        else if (mat == 5) { t.W = a->in[I_F2U] + wofs; t.gain = a->in[I_F2N] + l * DM; t.WT = (bf16*)(wl + WL_2C); mode = 2; }
        else               { t.W = a->in[I_F2D] + wofs; t.K = DFF; t.N = DM; t.WT = (bf16*)(wl + WL_2D); }
    }
    const int nblk = t.N / 64, kb = ii / nblk, nb = ii % nblk; t.k0 = 64 * kb; t.n0 = 64 * nb;
    t.drow0 = (mode == 0) ? t.n0 : ((t.n0 >> 7) * 256 + (t.n0 & 127) + (mode == 2 ? 128 : 0));
    return true;
}

__device__ __forceinline__ void convert_items(ArgsP a, LAS unsigned char* lds, int it0, int it1, int w, int nw) {
    asm volatile("" : "+s"(a));
    int tid_ = threadIdx.x; asm volatile("" : "+v"(tid_)); const int tid = tid_, lane = tid & 63, wave = __builtin_amdgcn_readfirstlane(tid >> 6);
    LAS float* scr = (LAS float*)(lds + wave * 16640);
    static_assert(8 * 16640 <= LDSCTL_OFF, "conversion tiles vs LDS control words");
    TrItem cur, nxt; float v[64];
    int it = it0 + w;
    bool have = (it < it1) && tr_item(a, it, cur);
    if (have) {
#pragma unroll
        for (int i = 0; i < 64; ++i) v[i] = __builtin_nontemporal_load(cur.W + (size_t)(cur.k0 + i) * cur.N + cur.n0 + lane);
    }
    for (; have; it += nw) {
        if (cur.gain) {
#pragma unroll
            for (int i = 0; i < 64; ++i) scr[i * 65 + lane] = v[i] * cur.gain[cur.k0 + i];
        } else {
#pragma unroll
            for (int i = 0; i < 64; ++i) scr[i * 65 + lane] = v[i];
        }
        const bool hn = (it + nw < it1) && tr_item(a, it + nw, nxt);
        if (hn) {
#pragma unroll
            for (int i = 0; i < 64; ++i) v[i] = __builtin_nontemporal_load(nxt.W + (size_t)(nxt.k0 + i) * nxt.N + nxt.n0 + lane);
        }
        asm volatile("s_waitcnt lgkmcnt(0)" ::: "memory");
        const int c = lane & 7;
#pragma unroll
        for (int j = 0; j < 8; ++j) { const int n = (lane >> 3) + 8 * j; const LAS float* s = scr + (8 * c) * 65 + n;
            v4u o; o.x = pg8::cvt_pk_bf16(s[0 * 65], s[1 * 65]); o.y = pg8::cvt_pk_bf16(s[2 * 65], s[3 * 65]); o.z = pg8::cvt_pk_bf16(s[4 * 65], s[5 * 65]); o.w = pg8::cvt_pk_bf16(s[6 * 65], s[7 * 65]);
            *(v4u*)(cur.WT + (size_t)(cur.drow0 + n) * cur.K + cur.k0 + 8 * c) = o; }
        asm volatile("s_waitcnt lgkmcnt(0)" ::: "memory");
        cur = nxt; have = hn;
    }
}
constexpr int CONV_ITEMS_LAYER = 7 * 704 + 256;

__device__ __forceinline__ void prologue_phase(ArgsP a, LAS unsigned char* lds, int G) {
    asm volatile("" : "+s"(a));
    int tid_ = threadIdx.x; asm volatile("" : "+v"(tid_)); const int tid = tid_, lane = tid & 63, wave = __builtin_amdgcn_readfirstlane(tid >> 6);
    const int gw = blockIdx.x * NWAVES + wave, NGW = G * NWAVES;
    unsigned char* ws = a->ws;
    convert_items(a, lds, 0, (HIDE_CONV ? 1 : DEPTH) * CONV_ITEMS_LAYER, gw, NGW);
    const float* x = a->in[I_X]; bf16* XB = (bf16*)(ws + WS_XB); float* SS = (float*)(ws + WS_SS);
    for (int m = gw; m < MTOK; m += NGW) {
        const f32x4* xr = (const f32x4*)(x + (size_t)m * DM) + lane; float s = 0.f;
        unsigned long long* o8 = (unsigned long long*)(XB + (size_t)m * DM) + lane;
#pragma unroll
        for (int j = 0; j < 4; ++j) { const f32x4 v = xr[64 * j]; s += (v[0] * v[0] + v[1] * v[1]) + (v[2] * v[2] + v[3] * v[3]);
            o8[64 * j] = (unsigned long long)pk2(v[0], v[1]) | ((unsigned long long)pk2(v[2], v[3]) << 32); }
        s = wave_sum(s);
        if (lane < 4) SS[(size_t)m * 4 + lane] = (lane == 0) ? s : 0.f;
    }
    if (blockIdx.x == 0) {
        float* btab = (float*)(ws + WS_BTAB); const float* rb = a->in[I_RELB];
        for (int i = tid; i < 8 * 384; i += NTHR) { const int hm = i / 384, d = i % 384;
            int bk; if (d < 16) bk = d; else { bk = 16 + (int)(logf((float)d / 16.0f) / logf(8.0f) * 16.0f); bk = bk < 31 ? bk : 31; }
            btab[i] = (rb[bk * 8 + hm] - rb[31 * 8 + hm]) * LOG2E; }
        if (wave < DEPTH) { const int l = wave;
            const float s1 = wave_sum(a->in[I_LQ1][l * 64 + lane] * a->in[I_LK1][l * 64 + lane]);
            const float s2 = wave_sum(a->in[I_LQ2][l * 64 + lane] * a->in[I_LK2][l * 64 + lane]);
            const float lam_init = 0.8f - 0.6f * expf(-0.3f * (float)l);
            if (lane == 0) ((float*)(ws + WS_LAM))[l] = expf(s1) - expf(s2) + lam_init; }
    }
}

__device__ __forceinline__ void lru_local_phase(ArgsP a, LAS unsigned char* lds, int G, int l) {
    asm volatile("" : "+s"(a));
    int tid_ = threadIdx.x; asm volatile("" : "+v"(tid_)); const int tid = tid_, j = tid & 255, tg = tid >> 8, n = j >> 6, jj = j & 63;
    unsigned char* ws = a->ws;
    const bf16* Z = (const bf16*)(ws + WS_ACT);
    float* HL = (float*)(ws + WS_HL); float* PL = (float*)(ws + WS_PL); float* PT = (float*)(ws + WS_PTOT); float* HT = (float*)(ws + WS_HTOT);
    constexpr int XP = 264;
    LAS unsigned short* XH = (LAS unsigned short*)lds;
    LAS float* S0 = (LAS float*)(lds + 64 * XP * 2);
    const float* cw = a->in[I_LCW] + l * 4 * 256; const float cb = a->in[I_LCB][l * 256 + j];
    const float w0 = cw[j], w1 = cw[256 + j], w2 = cw[512 + j], w3 = cw[768 + j];
    const float* wa = a->in[I_WA] + ((size_t)l * 4 + n) * 4096 + jj; const float* wx = a->in[I_WX] + ((size_t)l * 4 + n) * 4096 + jj;
    const float ba = a->in[I_BA][l * 256 + j], bx = a->in[I_BX][l * 256 + j];
    const float lam = a->in[I_LLAM][l * 256 + j];
    const float sp8 = -8.0f * log1pf(expf(-lam));
    for (int it = blockIdx.x; it < BATCH * NCH; it += G) {
        const int b = it / NCH, c = it % NCH; const int t0 = c * 64 + tg * 32;
        const bf16* zx = Z + ((size_t)b * SEQ) * ZP + ZLX + j;
        __syncthreads();
        float xr[32];
        {
            float xm3 = (t0 >= 3) ? bf2f(zx[(size_t)(t0 - 3) * ZP]) : 0.f, xm2 = (t0 >= 2) ? bf2f(zx[(size_t)(t0 - 2) * ZP]) : 0.f, xm1 = (t0 >= 1) ? bf2f(zx[(size_t)(t0 - 1) * ZP]) : 0.f;
#pragma unroll
            for (int t = 0; t < 32; ++t) { const float x0 = bf2f(zx[(size_t)(t0 + t) * ZP]); xr[t] = cb + w0 * xm3 + w1 * xm2 + w2 * xm1 + w3 * x0; xm3 = xm2; xm2 = xm1; xm1 = x0; }
#pragma unroll
            for (int t = 0; t < 32; ++t) XH[(tg * 32 + t) * XP + j] = (unsigned short)f2bf(xr[t]);
        }
        __syncthreads();
        float ar[32], ai[32];
        {
            typedef float f32x16_t __attribute__((ext_vector_type(16))); typedef short bf16x8_t __attribute__((ext_vector_type(8)));
            const int lane = tid & 63, c = lane & 31, hi = lane >> 5;
            f32x16_t aR[2], aI[2];
#pragma unroll
            for (int cb2 = 0; cb2 < 2; ++cb2) { const float b0 = a->in[I_BA][l * 256 + n * 64 + cb2 * 32 + c], b1 = a->in[I_BX][l * 256 + n * 64 + cb2 * 32 + c];
#pragma unroll
                for (int r = 0; r < 16; ++r) { aR[cb2][r] = b0; aI[cb2][r] = b1; } }
            const float* wan = a->in[I_WA] + ((size_t)l * 4 + n) * 4096; const float* wxn = a->in[I_WX] + ((size_t)l * 4 + n) * 4096;
#pragma unroll
            for (int ks = 0; ks < 4; ++ks) {
                const bf16x8_t af = *(const LAS bf16x8_t*)(XH + (tg * 32 + c) * XP + n * 64 + ks * 16 + hi * 8);
#pragma unroll
                for (int cb2 = 0; cb2 < 2; ++cb2) {
                    const float* wp = wan + (ks * 16 + hi * 8) * 64 + cb2 * 32 + c; const float* xp = wxn + (ks * 16 + hi * 8) * 64 + cb2 * 32 + c;
                    v4u fa, fx;
                    fa.x = pk2(wp[0], wp[64]); fa.y = pk2(wp[128], wp[192]); fa.z = pk2(wp[256], wp[320]); fa.w = pk2(wp[384], wp[448]);
                    fx.x = pk2(xp[0], xp[64]); fx.y = pk2(xp[128], xp[192]); fx.z = pk2(xp[256], xp[320]); fx.w = pk2(xp[384], xp[448]);
                    aR[cb2] = __builtin_amdgcn_mfma_f32_32x32x16_bf16(af, __builtin_bit_cast(bf16x8_t, fa), aR[cb2], 0, 0, 0);
                    aI[cb2] = __builtin_amdgcn_mfma_f32_32x32x16_bf16(af, __builtin_bit_cast(bf16x8_t, fx), aI[cb2], 0, 0, 0);
                }
            }
#pragma unroll
            for (int r = 0; r < 16; ++r) {
                const auto sr = __builtin_amdgcn_permlane32_swap(__float_as_uint(aR[0][r]), __float_as_uint(aR[1][r]), false, false);
                const auto si = __builtin_amdgcn_permlane32_swap(__float_as_uint(aI[0][r]), __float_as_uint(aI[1][r]), false, false);
                const int tlo = (r & 3) + 8 * (r >> 2);
                ar[tlo] = __uint_as_float(sr[0]); ar[tlo + 4] = __uint_as_float(sr[1]);
                ai[tlo] = __uint_as_float(si[0]); ai[tlo + 4] = __uint_as_float(si[1]);
            }
        }
        float h = 0.f, P = 1.f;
#pragma unroll
        for (int t = 0; t < 32; ++t) {
            const float r = __builtin_amdgcn_rcpf(1.0f + __builtin_amdgcn_exp2f(-LOG2E * ar[t])), ig = __builtin_amdgcn_rcpf(1.0f + __builtin_amdgcn_exp2f(-LOG2E * ai[t]));
            const float log_a = sp8 * r; const float av = __builtin_amdgcn_exp2f(LOG2E * log_a);
            const float z = 2.0f * log_a;
            const float em1 = z * (1.0f + z * (0.5f + z * ((1.0f / 6.0f) + z * ((1.0f / 24.0f) + z * ((1.0f / 120.0f) + z * ((1.0f / 720.0f) + z * (1.0f / 5040.0f)))))));
            const float mult = __builtin_amdgcn_sqrtf(-em1);
            const float bv = mult * (ig * xr[t]);
            h = av * h + bv; P = P * av; ar[t] = P; ai[t] = h;
        }
        if (tg == 0) { S0[j * 2] = P; S0[j * 2 + 1] = h; }
        __syncthreads();
        if (tg == 1) { const float P0 = S0[j * 2], H0 = S0[j * 2 + 1];
#pragma unroll
            for (int t = 0; t < 32; ++t) { ai[t] += ar[t] * H0; ar[t] *= P0; }
            PT[((size_t)b * NCH + c) * 256 + j] = ar[31]; HT[((size_t)b * NCH + c) * 256 + j] = ai[31]; }
        const size_t g0 = ((size_t)b * SEQ + t0) * 256 + j;
#pragma unroll
        for (int t = 0; t < 32; ++t) { HL[g0 + (size_t)t * 256] = ai[t]; PL[g0 + (size_t)t * 256] = ar[t]; }
    }
    __syncthreads();
}

__device__ __forceinline__ void attn_naive_phase(ArgsP a, LAS unsigned char* lds, int G) {
    asm volatile("" : "+s"(a));
    int tid_ = threadIdx.x; asm volatile("" : "+v"(tid_)); const int tid = tid_, i = tid >> 3, s = tid & 7;
    unsigned char* ws = a->ws;
    const bf16* Z = (const bf16*)(ws + WS_ACT); bf16* OB = (bf16*)(ws + WS_OB); const float* btab = (const float*)(ws + WS_BTAB);
    LAS float* Ks = (LAS float*)lds;
    LAS float* Vs = Ks + 64 * 65;
    LAS float* Ps = Vs + 64 * 128;
    LAS float* bt = Ps + 64 * 65;
    for (int u = blockIdx.x; u < 2048; u += G) {
        const int bhm = u & 31, cgp = (u >> 5) & 7, rnd = u >> 8; const int qb = 8 * rnd + ((rnd & 1) ? 7 - cgp : cgp);
        const int b = bhm >> 3, hm = bhm & 7, h = hm >> 1; const int q0 = qb * 64;
        __syncthreads();
        if (tid < 384) bt[tid] = btab[hm * 384 + tid];
        float q[64];
        { const v4u* qp = (const v4u*)(Z + ((size_t)b * SEQ + q0 + i) * ZP + ZQ + hm * 64);
#pragma unroll
          for (int c = 0; c < 8; ++c) { const v4u w = qp[c]; q[c * 8] = bflo(w.x); q[c * 8 + 1] = bfhi(w.x); q[c * 8 + 2] = bflo(w.y); q[c * 8 + 3] = bfhi(w.y); q[c * 8 + 4] = bflo(w.z); q[c * 8 + 5] = bfhi(w.z); q[c * 8 + 6] = bflo(w.w); q[c * 8 + 7] = bfhi(w.w); } }
        float o[16]; float mrun = -1e30f, lrun = 0.f;
#pragma unroll
        for (int e = 0; e < 16; ++e) o[e] = 0.f;
        for (int kt = 0; kt <= qb; ++kt) {
            __syncthreads();
            { const int key = tid >> 3, c8 = tid & 7; const bf16* zr = Z + ((size_t)b * SEQ + kt * 64 + key) * ZP;
              const v4u kw = *(const v4u*)(zr + ZK + hm * 64 + c8 * 8);
              LAS float* kd = Ks + key * 65 + c8 * 8;
              kd[0] = bflo(kw.x); kd[1] = bfhi(kw.x); kd[2] = bflo(kw.y); kd[3] = bfhi(kw.y); kd[4] = bflo(kw.z); kd[5] = bfhi(kw.z); kd[6] = bflo(kw.w); kd[7] = bfhi(kw.w);
              const v4u v0 = *(const v4u*)(zr + ZV + h * 128 + c8 * 16), v1 = *(const v4u*)(zr + ZV + h * 128 + c8 * 16 + 8);
              LAS float* vd = Vs + key * 128 + c8 * 16;
              *(LAS f32x4*)(vd) = (f32x4){bflo(v0.x), bfhi(v0.x), bflo(v0.y), bfhi(v0.y)}; *(LAS f32x4*)(vd + 4) = (f32x4){bflo(v0.z), bfhi(v0.z), bflo(v0.w), bfhi(v0.w)};
              *(LAS f32x4*)(vd + 8) = (f32x4){bflo(v1.x), bfhi(v1.x), bflo(v1.y), bfhi(v1.y)}; *(LAS f32x4*)(vd + 12) = (f32x4){bflo(v1.z), bfhi(v1.z), bflo(v1.w), bfhi(v1.w)}; }
            __syncthreads();
            float sc[8]; float mx = -1e30f;
#pragma unroll
            for (int kk = 0; kk < 8; ++kk) { const int key = s * 8 + kk; const LAS float* kp = Ks + key * 65; float d = 0.f;
#pragma unroll
                for (int e = 0; e < 64; ++e) d += q[e] * kp[e];
                const int dist = (q0 + i) - (kt * 64 + key); const int di = dist < 0 ? 0 : (dist > 383 ? 383 : dist);
                d += bt[di]; if (dist < 0) d = -1e30f; sc[kk] = d; mx = fmaxf(mx, d); }
            mx = fmaxf(mx, shx(mx, 1)); mx = fmaxf(mx, shx(mx, 2)); mx = fmaxf(mx, shx(mx, 4));
            const float mnew = fmaxf(mrun, mx); const float corr = __builtin_amdgcn_exp2f(mrun - mnew); mrun = mnew;
            float ps = 0.f;
#pragma unroll
            for (int kk = 0; kk < 8; ++kk) { const float p = __builtin_amdgcn_exp2f(sc[kk] - mnew); ps += p; Ps[i * 65 + s * 8 + kk] = p; }
            ps += shx(ps, 1); ps += shx(ps, 2); ps += shx(ps, 4);
            lrun = lrun * corr + ps;
#pragma unroll
            for (int e = 0; e < 16; ++e) o[e] *= corr;
            asm volatile("s_waitcnt lgkmcnt(0)" ::: "memory");
            for (int key = 0; key < 64; ++key) { const float p = Ps[i * 65 + key]; const LAS float* vp = Vs + key * 128 + s * 16;
#pragma unroll
                for (int e4 = 0; e4 < 4; ++e4) { const f32x4 vv = *(const LAS f32x4*)(vp + e4 * 4);
#pragma unroll
                    for (int e = 0; e < 4; ++e) o[e4 * 4 + e] += p * vv[e]; } }
        }
        const float rl = 1.0f / lrun;
        v4u w0, w1;
        w0.x = pk2(o[0] * rl, o[1] * rl); w0.y = pk2(o[2] * rl, o[3] * rl); w0.z = pk2(o[4] * rl, o[5] * rl); w0.w = pk2(o[6] * rl, o[7] * rl);
        w1.x = pk2(o[8] * rl, o[9] * rl); w1.y = pk2(o[10] * rl, o[11] * rl); w1.z = pk2(o[12] * rl, o[13] * rl); w1.w = pk2(o[14] * rl, o[15] * rl);
        bf16* op = OB + ((size_t)b * SEQ + q0 + i) * DM + hm * 128 + s * 16;
        *(v4u*)op = w0; *(v4u*)(op + 8) = w1;
    }
    __syncthreads();
}

__device__ __forceinline__ float gelu_tanh(float x) {
    const float u = 0.7978845608028654f * (x + 0.044715f * x * x * x);
    const float e = __builtin_amdgcn_exp2f(-2.0f * LOG2E * u);
    return x * __builtin_amdgcn_rcpf(1.0f + e);
}
__device__ __forceinline__ void finalize_phase(ArgsP a, LAS unsigned char* lds, int G, int l) {
    asm volatile("" : "+s"(a));
    int tid_ = threadIdx.x; asm volatile("" : "+v"(tid_)); const int tid = tid_, lane = tid & 63, wave = tid >> 6;
    unsigned char* ws = a->ws;
    const bf16* Z = (const bf16*)(ws + WS_ACT); const bf16* OB = (const bf16*)(ws + WS_OB); bf16* Y = (bf16*)(ws + WS_Y);
    const float* HL = (const float*)(ws + WS_HL); const float* PL = (const float*)(ws + WS_PL); const float* PT = (const float*)(ws + WS_PTOT); const float* HT = (const float*)(ws + WS_HTOT);
    LAS float* Hin = (LAS float*)lds;
    const float lam = ((const float*)(ws + WS_LAM))[l];
    const float lam_init = 0.8f - 0.6f * expf(-0.3f * (float)l);
    const float osc = 1.0f - lam_init;
    const int dh = (lane & 15) * 8;
    float sg[8];
#pragma unroll
    for (int e = 0; e < 8; ++e) sg[e] = a->in[I_SUBG][l * 128 + dh + e] * osc;
    const int ch = lane * 4;
    float scw[3][4];
#pragma unroll
    for (int k = 0; k < 3; ++k)
#pragma unroll
        for (int e = 0; e < 4; ++e) scw[k][e] = a->in[I_SCW][(l * 3 + k) * 256 + ch + e];
    for (int it = blockIdx.x; it < BATCH * NCH; it += G) {
        const int b = it / NCH, c = it % NCH;
        __syncthreads();
        {
            const int chn = tid & 255, hf = tid >> 8, cm = c >> 1, c_lo = hf ? cm : 0, c_hi = hf ? c : cm;
            float H = 0.f, Pp = 1.f; const float* pt = PT + (size_t)b * NCH * 256 + chn; const float* ht = HT + (size_t)b * NCH * 256 + chn;
            int cc = c_lo;
            for (; cc + 8 <= c_hi; cc += 8) { float p[8], h[8];
#pragma unroll
                for (int e = 0; e < 8; ++e) { p[e] = pt[(cc + e) * 256]; h[e] = ht[(cc + e) * 256]; }
#pragma unroll
                for (int e = 0; e < 8; ++e) { H = p[e] * H + h[e]; Pp *= p[e]; } }
            for (; cc < c_hi; ++cc) { const float p = pt[cc * 256], h = ht[cc * 256]; H = p * H + h; Pp *= p; }
            if (hf == 0) Hin[chn] = H;
            __syncthreads();
            if (hf == 1) Hin[chn] = Pp * Hin[chn] + H;
        }
        __syncthreads();
        const f32x4 hin = *(const LAS f32x4*)(Hin + ch);
        for (int r = wave; r < 64; r += NWAVES) {
            const int t = c * 64 + r; const size_t row = (size_t)b * SEQ + t;
            { const int h = lane >> 4; const bf16* op = OB + row * DM + h * 256 + dh;
              const v4u w1 = *(const v4u*)op, w2 = *(const v4u*)(op + 128);
              float d[8];
              d[0] = bflo(w1.x) - lam * bflo(w2.x); d[1] = bfhi(w1.x) - lam * bfhi(w2.x); d[2] = bflo(w1.y) - lam * bflo(w2.y); d[3] = bfhi(w1.y) - lam * bfhi(w2.y);
              d[4] = bflo(w1.z) - lam * bflo(w2.z); d[5] = bfhi(w1.z) - lam * bfhi(w2.z); d[6] = bflo(w1.w) - lam * bflo(w2.w); d[7] = bfhi(w1.w) - lam * bfhi(w2.w);
              float ssq = 0.f;
#pragma unroll
              for (int e = 0; e < 8; ++e) ssq += d[e] * d[e];
              ssq += shx(ssq, 1); ssq += shx(ssq, 2); ssq += shx(ssq, 4); ssq += shx(ssq, 8);
              const float rs = __builtin_amdgcn_rsqf(ssq * (1.0f / 128.0f) + 1e-5f);
              v4u o; o.x = pk2(d[0] * rs * sg[0], d[1] * rs * sg[1]); o.y = pk2(d[2] * rs * sg[2], d[3] * rs * sg[3]); o.z = pk2(d[4] * rs * sg[4], d[5] * rs * sg[5]); o.w = pk2(d[6] * rs * sg[6], d[7] * rs * sg[7]);
              *(v4u*)(Y + row * DM + h * 128 + dh) = o; }
            { const bf16* zr = Z + row * ZP; float acc[4] = {0.f, 0.f, 0.f, 0.f};
#pragma unroll
              for (int k = 0; k < 3; ++k) { const int tt = t - 2 + k; if (tt >= 0) { const bf16* zz = zr - (size_t)(2 - k) * ZP;
                  const v2u cw = *(const v2u*)(zz + ZSC + ch), xw = *(const v2u*)(zz + ZSX + ch);
                  acc[0] += scw[k][0] * (bflo(cw.x) * bflo(xw.x)); acc[1] += scw[k][1] * (bfhi(cw.x) * bfhi(xw.x)); acc[2] += scw[k][2] * (bflo(cw.y) * bflo(xw.y)); acc[3] += scw[k][3] * (bfhi(cw.y) * bfhi(xw.y)); } }
              const v2u bw = *(const v2u*)(zr + ZSB + ch);
              v2u o; o.x = pk2(bflo(bw.x) * acc[0], bfhi(bw.x) * acc[1]); o.y = pk2(bflo(bw.y) * acc[2], bfhi(bw.y) * acc[3]);
              *(v2u*)(Y + row * DM + 512 + ch) = o;
              const f32x4 hl = *(const f32x4*)(HL + row * 256 + ch), pl = *(const f32x4*)(PL + row * 256 + ch);
              const v2u gw = *(const v2u*)(zr + ZLG + ch);
              v2u o2; o2.x = pk2(gelu_tanh(bflo(gw.x)) * (hl[0] + pl[0] * hin[0]), gelu_tanh(bfhi(gw.x)) * (hl[1] + pl[1] * hin[1]));
              o2.y = pk2(gelu_tanh(bflo(gw.y)) * (hl[2] + pl[2] * hin[2]), gelu_tanh(bfhi(gw.y)) * (hl[3] + pl[3] * hin[3]));
              *(v2u*)(Y + row * DM + 768 + ch) = o2; }
        }
    }
    __syncthreads();
}

__device__ __forceinline__ void final_norm_phase(ArgsP a, int G) {
    asm volatile("" : "+s"(a));
    int tid_ = threadIdx.x; asm volatile("" : "+v"(tid_)); const int tid = tid_, lane = tid & 63, wave = tid >> 6;
    const int gw = blockIdx.x * NWAVES + wave, NGW = G * NWAVES;
    const float* SS = (const float*)(a->ws + WS_SS); const float* g = a->in[I_FIN];
    f32x4 gv[4];
#pragma unroll
    for (int j = 0; j < 4; ++j) gv[j] = ((const f32x4*)g)[lane + 64 * j];
    for (int m = gw; m < MTOK; m += NGW) {
        const f32x4 s4 = *(const f32x4*)(SS + (size_t)m * 4);
        const float rs = 1.0f / sqrtf(((s4[0] + s4[1]) + (s4[2] + s4[3])) * (1.0f / 1024.0f) + 1e-6f);
#if RES_BF16
        const v2u* xb = (const v2u*)((const bf16*)(a->ws + WS_XB) + (size_t)m * DM) + lane; f32x4* xr = (f32x4*)(a->out + (size_t)m * DM) + lane;
#pragma unroll
        for (int j = 0; j < 4; ++j) { const v2u w = xb[64 * j]; const f32x4 v = (f32x4){bflo(w.x), bfhi(w.x), bflo(w.y), bfhi(w.y)}; xr[64 * j] = v * rs * gv[j]; }
#else
        f32x4* xr = (f32x4*)(a->out + (size_t)m * DM) + lane;
#pragma unroll
        for (int j = 0; j < 4; ++j) { const f32x4 v = xr[64 * j]; xr[64 * j] = v * rs * gv[j]; }
#endif
    }
}

constexpr int N_PHASES = 2 + 8 * DEPTH;
__global__ void __launch_bounds__(NTHR, 2) hymba_fwd(Args args) {
    extern __shared__ __attribute__((aligned(16))) unsigned char lds_raw[];
    LAS unsigned char* lds = (LAS unsigned char*)lds_raw;
    cg::grid_group grid = cg::this_grid();
    const int G = gridDim.x;
    ArgsP ap = (ArgsP)__builtin_amdgcn_kernarg_segment_ptr();
    if (threadIdx.x < 64) ((LAS unsigned*)(lds + LDSCTL_OFF))[threadIdx.x] = 0u;
    __syncthreads();
    const XcdBarrier bar = xcd_barrier_post((unsigned*)(ap->ws + WS_BAR), (volatile LAS unsigned*)(lds + MISC_OFF) + 8);
    const int ph_lo = ap->ph_lo, ph_hi = ap->ph_hi;
    for (int ph = ph_lo; ph < ph_hi; ++ph) {
        ArgsP a = ap; asm volatile("" : "+s"(a));
        unsigned char* ws = a->ws;
        bf16* XB = (bf16*)(ws + WS_XB); bf16* ACT = (bf16*)(ws + WS_ACT); bf16* Y = (bf16*)(ws + WS_Y); float* SS = (float*)(ws + WS_SS);
        int reps = 1;
        if (PROBE_REP_MASK) { if (ph == 0) reps = ((PROBE_REP_MASK >> 8) & 1) ? 2 : 1; else if (ph < N_PHASES - 1) reps = ((PROBE_REP_MASK >> ((ph - 1) & 7)) & 1) ? 2 : 1; }
        for (int rep = 0; rep < reps; ++rep) {
        if (ph == 0) { prologue_phase(a, lds, G); if ((PROBE_REP_MASK >> 12) & 1) prologue_phase(a, lds, G); }
        else if (ph == N_PHASES - 1) final_norm_phase(a, G);
        else {
            const int l = (ph - 1) >> 3, s = (ph - 1) & 7;
            const unsigned char* wl = ws + WS_W + (size_t)l * WL_STRIDE;
            if (s == 0 || s == 6) {
                pg8::Gemm g{XB, (const bf16*)(wl + (s == 0 ? WL_1C : WL_2C)), MTOK, 2 * DFF, DM}; pg8::StaticOrder S; S.init(MTOK, 2 * DFF, G, (int)blockIdx.x);
                pg8::EpiSwiglu E{ACT, DFF, SS};
                pg8::gemm_phase<pg8::EpiSwiglu, pg8::StaticOrder, PG8_ALIGN_MULTI, true>(lds, g, S, E);
                if (HIDE_CONV && l + 1 < DEPTH) {
                    const int nidle = G - (1408 % G);
                    if (G == 256 && (int)blockIdx.x >= G - nidle) {
                        const int i0 = (l + 1) * CONV_ITEMS_LAYER + (s == 0 ? 0 : CONV_ITEMS_LAYER / 2), i1 = (l + 1) * CONV_ITEMS_LAYER + (s == 0 ? CONV_ITEMS_LAYER / 2 : CONV_ITEMS_LAYER);
                        convert_items(a, lds, i0, i1, ((int)blockIdx.x - (G - nidle)) * NWAVES + __builtin_amdgcn_readfirstlane((int)threadIdx.x >> 6), nidle * NWAVES);
                    }
                }
            } else if (s == 1 || s == 5 || s == 7) {
                const bool isout = (s == 5);
                pg8::Gemm g{isout ? Y : ACT, (const bf16*)(wl + (s == 1 ? WL_1D : (s == 5 ? WL_OUT : WL_2D))), MTOK, DM, isout ? DM : DFF}; pg8::StaticOrder S; S.init(MTOK, DM, G, (int)blockIdx.x);
#if RES_BF16
                pg8::EpiRes16 E{XB, SS, isout ? 1.0f : 0.5f};
                pg8::gemm_phase<pg8::EpiRes16, pg8::StaticOrder, false, true>(lds, g, S, E);
#else
                pg8::EpiRes E{(l == 0 && s == 1) ? a->in[I_X] : a->out, a->out, XB, SS, isout ? 1.0f : 0.5f};
                pg8::gemm_phase<pg8::EpiRes, pg8::StaticOrder, false, true>(lds, g, S, E);
#endif
            } else if (s == 2) {
                pg8::Gemm g{XB, (const bf16*)(wl + WL_IN), MTOK, INW, DM}; pg8::StaticOrder S; S.init(MTOK, INW, G, (int)blockIdx.x);
                pg8::EpiZ E{ACT, ZP, SS, QSCALE};
                pg8::gemm_phase<pg8::EpiZ, pg8::StaticOrder, PG8_ALIGN_MULTI, true>(lds, g, S, E);
            } else if (s == 3) {
                lru_local_phase(a, lds, G, l);
                if ((PROBE_REP_MASK >> 9) & 1) lru_local_phase(a, lds, G, l);
#if USE_NAIVE_ATTN
                attn_naive_phase(a, lds, G);
#elif USE_ATTN128
                { static_assert(attn128::ATTN_LDS_BYTES <= RING_BYTES, "attention LDS");
                  const attn128::AttnTensors AT{(const attn128::bf16*)ACT, (attn128::bf16*)(ws + WS_OB), (const float*)(ws + WS_BTAB)};
                  const attn128::StaticOrder S(G, (int)blockIdx.x);
                  attn128::attn_phase<attn128::StaticOrder>((char*)lds_raw, AT, S);
                  if ((PROBE_REP_MASK >> 10) & 1) attn128::attn_phase<attn128::StaticOrder>((char*)lds_raw, AT, S); }
#elif USE_SWA_ATTN
                { static_assert(swa::LDS_BYTES <= RING_BYTES, "attention LDS");
                  swa::attn_swa_phase((const swa::bf16*)ACT, (swa::bf16*)(ws + WS_OB), (const float*)(ws + WS_BTAB), (char*)lds_raw, G);
                  if ((PROBE_REP_MASK >> 10) & 1) swa::attn_swa_phase((const swa::bf16*)ACT, (swa::bf16*)(ws + WS_OB), (const float*)(ws + WS_BTAB), (char*)lds_raw, G); }
#else
                { static_assert(attn_body::ATTN_LDS_BYTES <= RING_BYTES, "attention LDS");
                  const attn_body::AttnTensors AT{(const attn_body::bf16*)ACT, (attn_body::bf16*)(ws + WS_OB), (const float*)(ws + WS_BTAB)};
                  const attn_body::StaticOrder S(G, (int)blockIdx.x);
                  attn_body::attn_phase<attn_body::StaticOrder>((char*)lds_raw, AT, S);
                  if ((PROBE_REP_MASK >> 10) & 1) attn_body::attn_phase<attn_body::StaticOrder>((char*)lds_raw, AT, S); }
#endif
            } else {
                finalize_phase(a, lds, G, l);
                if ((PROBE_REP_MASK >> 11) & 1) finalize_phase(a, lds, G, l);
            }
        }
        if (rep + 1 < reps) xcd_barrier(bar);
        }
        if (ph + 1 < ph_hi) { if (USE_CG_SYNC || ph_lo < 0) grid.sync(); else xcd_barrier(bar); }
        if (PROBE_EXTRA_SYNC) for (int e = 0; e < PROBE_EXTRA_SYNC; ++e) xcd_barrier(bar);
    }
}

#ifndef MK_PER_PHASE
#define MK_PER_PHASE 0
#endif
extern "C" void kernel_launch(void* const* d_in, const int* in_sizes, int n_in, void* d_out, int out_size, void* d_ws, size_t ws_size, hipStream_t stream) {
    static int grid = 0;
    if (grid == 0) {
        if (n_in != 27 || in_sizes[0] != MTOK * DM || out_size != MTOK * DM || ws_size < WS_END) { fprintf(stderr, "kernel_launch: unexpected shapes / workspace (n_in %d, ws %zu)\n", n_in, ws_size); grid = -1; return; }
        int dev = 0, cus = 0, per_cu = 0;
        hipGetDevice(&dev); hipDeviceGetAttribute(&cus, hipDeviceAttributeMultiprocessorCount, dev);
        if (hipFuncSetAttribute((const void*)hymba_fwd, hipFuncAttributeMaxDynamicSharedMemorySize, LDS_BYTES) != hipSuccess) { fprintf(stderr, "kernel_launch: hipFuncSetAttribute failed\n"); grid = -1; return; }
        hipOccupancyMaxActiveBlocksPerMultiprocessor(&per_cu, (const void*)hymba_fwd, NTHR, LDS_BYTES);
        (void)hipGetLastError();
        if (cus != 256 || per_cu < 1) fprintf(stderr, "kernel_launch: note: cus %d per_cu %d (built for 256 x 1)\n", cus, per_cu);
        grid = 256;
    }
    if (grid < 0) return;
    if (hipMemsetAsync((char*)d_ws + WS_BAR, 0, BAR_BYTES, stream) != hipSuccess) { fprintf(stderr, "kernel_launch: memset failed\n"); return; }
    Args a{};
    for (int i = 0; i < 27; ++i) a.in[i] = (const float*)d_in[i];
    a.out = (float*)d_out; a.ws = (unsigned char*)d_ws;
#if MK_PER_PHASE
    for (int p = 0; p < N_PHASES; ++p) { a.ph_lo = p; a.ph_hi = p + 1; hipLaunchKernelGGL(hymba_fwd, dim3(grid), dim3(NTHR), LDS_BYTES, stream, a); }
#else
    a.ph_lo = 0; a.ph_hi = N_PHASES;
    void* kargs[] = {&a};
    hipError_t e = hipLaunchCooperativeKernel((const void*)hymba_fwd, dim3(grid), dim3(NTHR), kargs, LDS_BYTES, stream);
    if (e != hipSuccess) fprintf(stderr, "kernel_launch: cooperative launch failed: %s\n", hipGetErrorString(e));
#endif
}
```
